# Optimizing an MI355X kernel written in HIP

```python
import math
import jax, jax.numpy as jnp
from jax import lax
import numpy as np

D_MODEL = 1024
BATCH = 8
SEQ = 2048
DEPTH = 2

F32 = jnp.float32
EPS = 1e-6
N_SUB = 3
D_FF = ((8 * D_MODEL // 3 + 127) // 128) * 128
FFN_RES_WEIGHT = 0.5
D_MIX = D_MODEL
POOL_WINDOWS = (2, 4, 8, 16)
N_POOL = len(POOL_WINDOWS)
POOL_WIDTH = D_MIX // 2
POOL_GD = POOL_WIDTH // N_POOL
SGU_WIDTH = D_MIX // 2
SGU_HEADS = 4
SGU_HD = SGU_WIDTH // SGU_HEADS
CHUNK = 128
SSM_WIDTH = D_MIX
SSM_GROUP = 16
SSM_GROUPS = SSM_WIDTH // SSM_GROUP
SSM_STATE = 64
DT_MIN = 1e-3
DT_MAX = 1e-1
N_EVEN = (DEPTH + 1) // 2
N_ODD = DEPTH // 2

kernel_name = 'hybrid_pool_sgu_s5_macaron_adaln'


def rmsnorm(x, g):
    xf = x.astype(F32)
    y = xf * lax.rsqrt(jnp.mean(xf * xf, axis=-1, keepdims=True) + EPS)
    return (y * g.astype(F32)).astype(x.dtype)


def sublayer(x, fn, mod_k, g_pre, g_post, res_weight):
    shift, scale, gate = mod_k[:, 0, None, :], mod_k[:, 1, None, :], mod_k[:, 2, None, :]
    h = rmsnorm(x, g_pre) * (1.0 + scale) + shift
    y = rmsnorm(fn(h), g_post)
    return x + res_weight * gate * y


def swiglu(h, w_in, w_out):
    a, b = jnp.split(h @ w_in, 2, axis=-1)
    return (jax.nn.silu(a) * b) @ w_out


def pool_mixer(a, w_group, ch_scale):
    s_len = a.shape[1]
    cs = jnp.cumsum(a.astype(F32), axis=1)
    pos = jnp.arange(1, s_len + 1, dtype=F32)[None, :, None]
    diffs = []
    for g, w in enumerate(POOL_WINDOWS):
        sl = slice(g * POOL_GD, (g + 1) * POOL_GD)
        c_g = cs[..., sl]
        lagged = jnp.pad(c_g, ((0, 0), (w, 0), (0, 0)))[:, :s_len]
        mean = (c_g - lagged) / jnp.minimum(pos, float(w))
        diffs.append(mean - a[..., sl].astype(F32))
    d = jnp.stack(diffs, axis=2).astype(a.dtype)
    y = jnp.einsum('bsgi,gio->bsgo', d, w_group)
    return y.reshape(a.shape) * ch_scale


def sgu_mixer(z, ln_g, ln_b, w_s, b_s):
    u, v = jnp.split(z, 2, axis=-1)
    bsz, s_len, _ = u.shape
    vf = v.astype(F32).reshape(bsz, s_len, SGU_HEADS, SGU_HD)
    mu = jnp.mean(vf, axis=-1, keepdims=True)
    var = jnp.mean(jnp.square(vf - mu), axis=-1, keepdims=True)
    vn = ((vf - mu) * lax.rsqrt(var + EPS)).reshape(bsz, s_len, SGU_WIDTH) * ln_g + ln_b
    vn = vn.astype(u.dtype).reshape(bsz, s_len // CHUNK, CHUNK, SGU_HEADS, SGU_HD)
    causal = jnp.tril(jnp.ones((CHUNK, CHUNK), dtype=bool))
    w = jnp.where(causal[None], w_s, 0.0)
    s = jnp.einsum('hts,bcshd->bcthd', w, vn) + b_s.T[None, None, :, :, None]
    return u * s.reshape(bsz, s_len, SGU_WIDTH)


def s5_mixer(u, lam_re, lam_im, b_re, b_im, c_re, c_im, d_skip, log_dt, w_glu):
    bsz, s_len, _ = u.shape
    lam = lax.complex(lam_re.astype(F32), lam_im.astype(F32))
    dt = jnp.exp(log_dt.astype(F32))[:, None]
    lam_bar = jnp.exp(lam * dt)
    bmat = lax.complex(b_re.astype(F32), b_im.astype(F32))
    b_bar = ((lam_bar - 1.0) / lam)[..., None] * bmat
    cmat = lax.complex(c_re.astype(F32), c_im.astype(F32))
    uf = u.astype(F32)
    ug = uf.reshape(bsz, s_len, SSM_GROUPS, SSM_GROUP).astype(jnp.complex64)
    bu = jnp.einsum('gpn,bsgn->bsgp', b_bar, ug)
    a_seq = jnp.broadcast_to(lam_bar, (1, s_len) + lam_bar.shape)

    def combine(left, right):
        a_l, x_l = left
        a_r, x_r = right
        return a_r * a_l, a_r * x_l + x_r

    _, states = lax.associative_scan(combine, (a_seq, bu), axis=1)
    y = jnp.einsum('gnp,bsgp->bsgn', cmat, states).real.reshape(bsz, s_len, SSM_WIDTH)
    y = y + d_skip.astype(F32) * uf
    g = jax.nn.gelu(y).astype(u.dtype)
    a, b = jnp.split(g @ w_glu, 2, axis=-1)
    return a * jax.nn.sigmoid(b)


def setup_inputs(seed: int = 0) -> dict:
    key = jax.random.key(seed)
    ks = iter(jax.random.split(key, 32))

    def nrm(shape, scale):
        return jax.random.normal(next(ks), shape, F32) * scale

    D = D_MODEL
    x = nrm((BATCH, SEQ, D), 1.0)
    c = nrm((BATCH, D), 1.0)
    ada_w = nrm((DEPTH, D, N_SUB * 3 * D), 0.5 * D ** -0.5)
    ada_b = nrm((DEPTH, N_SUB * 3 * D), 0.02)
    norm_pre = 1.0 + nrm((DEPTH, N_SUB, D), 0.02)
    norm_post = 1.0 + nrm((DEPTH, N_SUB, D), 0.02)
    ffn_w_in = nrm((DEPTH, 2, D, 2 * D_FF), D ** -0.5)
    ffn_w_out = nrm((DEPTH, 2, D_FF, D), D_FF ** -0.5)
    ab_w_in = nrm((N_EVEN, D, POOL_WIDTH + 2 * SGU_WIDTH), D ** -0.5)
    pool_w = nrm((N_EVEN, N_POOL, POOL_GD, POOL_GD), POOL_GD ** -0.5)
    pool_scale = 1.0 + nrm((N_EVEN, POOL_WIDTH), 0.1)
    sgu_ln_g = 1.0 + nrm((N_EVEN, SGU_WIDTH), 0.02)
    sgu_ln_b = nrm((N_EVEN, SGU_WIDTH), 0.02)
    sgu_w = nrm((N_EVEN, SGU_HEADS, CHUNK, CHUNK), 0.5 * CHUNK ** -0.5)
    sgu_b = 1.0 + nrm((N_EVEN, SGU_HEADS, CHUNK), 0.02)
    ab_w_out = nrm((N_EVEN, POOL_WIDTH + SGU_WIDTH, D), (POOL_WIDTH + SGU_WIDTH) ** -0.5)
    ssm_w_in = nrm((N_ODD, D, SSM_WIDTH), D ** -0.5)
    n_idx = jnp.arange(SSM_STATE, dtype=F32)
    ssm_lam_re = -0.5 + nrm((N_ODD, SSM_GROUPS, SSM_STATE), 0.01)
    ssm_lam_im = jnp.pi * n_idx + nrm((N_ODD, SSM_GROUPS, SSM_STATE), 0.01)
    ssm_b_re = nrm((N_ODD, SSM_GROUPS, SSM_STATE, SSM_GROUP), (2 * SSM_GROUP) ** -0.5)
    ssm_b_im = nrm((N_ODD, SSM_GROUPS, SSM_STATE, SSM_GROUP), (2 * SSM_GROUP) ** -0.5)
    ssm_c_re = nrm((N_ODD, SSM_GROUPS, SSM_GROUP, SSM_STATE), SSM_STATE ** -0.5)
    ssm_c_im = nrm((N_ODD, SSM_GROUPS, SSM_GROUP, SSM_STATE), SSM_STATE ** -0.5)
    ssm_d = nrm((N_ODD, SSM_WIDTH), 1.0)
    ssm_log_dt = jax.random.uniform(next(ks), (N_ODD, SSM_GROUPS), F32,
                                    math.log(DT_MIN), math.log(DT_MAX))
    ssm_w_glu = nrm((N_ODD, SSM_WIDTH, 2 * D), SSM_WIDTH ** -0.5)
    return {'x': x, 'c': c, 'ada_w': ada_w, 'ada_b': ada_b,
            'norm_pre': norm_pre, 'norm_post': norm_post,
            'ffn_w_in': ffn_w_in, 'ffn_w_out': ffn_w_out,
            'ab_w_in': ab_w_in, 'pool_w': pool_w, 'pool_scale': pool_scale,
            'sgu_ln_g': sgu_ln_g, 'sgu_ln_b': sgu_ln_b, 'sgu_w': sgu_w, 'sgu_b': sgu_b,
            'ab_w_out': ab_w_out, 'ssm_w_in': ssm_w_in,
            'ssm_lam_re': ssm_lam_re, 'ssm_lam_im': ssm_lam_im,
            'ssm_b_re': ssm_b_re, 'ssm_b_im': ssm_b_im,
            'ssm_c_re': ssm_c_re, 'ssm_c_im': ssm_c_im,
            'ssm_d': ssm_d, 'ssm_log_dt': ssm_log_dt, 'ssm_w_glu': ssm_w_glu}


def reference(x, c, ada_w, ada_b, norm_pre, norm_post, ffn_w_in, ffn_w_out,
              ab_w_in, pool_w, pool_scale, sgu_ln_g, sgu_ln_b, sgu_w, sgu_b, ab_w_out,
              ssm_w_in, ssm_lam_re, ssm_lam_im, ssm_b_re, ssm_b_im, ssm_c_re, ssm_c_im,
              ssm_d, ssm_log_dt, ssm_w_glu):
    cond = jax.nn.silu(c)
    for l in range(DEPTH):
        mod = (cond @ ada_w[l] + ada_b[l]).reshape(-1, N_SUB, 3, D_MODEL)
        i = l // 2

        x = sublayer(x, lambda h: swiglu(h, ffn_w_in[l, 0], ffn_w_out[l, 0]),
                     mod[:, 0], norm_pre[l, 0], norm_post[l, 0], FFN_RES_WEIGHT)

        if l % 2 == 0:
            def mix(h):
                z = h @ ab_w_in[i]
                y_a = pool_mixer(z[..., :POOL_WIDTH], pool_w[i], pool_scale[i])
                y_b = sgu_mixer(jax.nn.gelu(z[..., POOL_WIDTH:]), sgu_ln_g[i], sgu_ln_b[i],
                                sgu_w[i], sgu_b[i])
                return jnp.concatenate([y_a, y_b], axis=-1) @ ab_w_out[i]
        else:
            def mix(h):
                return s5_mixer(h @ ssm_w_in[i], ssm_lam_re[i], ssm_lam_im[i],
                                ssm_b_re[i], ssm_b_im[i], ssm_c_re[i], ssm_c_im[i],
                                ssm_d[i], ssm_log_dt[i], ssm_w_glu[i])
        x = sublayer(x, mix, mod[:, 1], norm_pre[l, 1], norm_post[l, 1], 1.0)

        x = sublayer(x, lambda h: swiglu(h, ffn_w_in[l, 1], ffn_w_out[l, 1]),
                     mod[:, 2], norm_pre[l, 2], norm_post[l, 2], FFN_RES_WEIGHT)
    return x
```

```cpp
#include <hip/hip_runtime.h>
#include <hip/hip_cooperative_groups.h>
#include <cstdio>
#include <cstdint>
namespace cg = cooperative_groups;
namespace pg8 {
#define PG8_LAS __attribute__((address_space(3)))
typedef unsigned short bf16_t;
typedef short bf16x8 __attribute__((ext_vector_type(8)));
typedef float f32x4 __attribute__((ext_vector_type(4)));
typedef unsigned u32x4 __attribute__((ext_vector_type(4)));
constexpr int BM = 256, BK = 64, HALF = 128, HTB = HALF * BK * 2  , STAGE_BYTES = 8 * HTB, NXCD = 8, WGM = 8;

__host__ __device__ __forceinline__ int lds_byte(int r, int c) { const int st = (r >> 4) * 2 + (c >> 5), rr = r & 15, cc = c & 31, ob = rr * 64 + cc * 2; return st * 1024 + (ob ^ (((ob >> 9) & 1) << 5)); }
__host__ __device__ __forceinline__ void stage_rc(int b, int& R, int& C) { const int st = b / 1024, sb = b % 1024, swz = sb ^ (((sb >> 9) & 1) << 5); R = (st >> 1) * 16 + swz / 64; C = (st & 1) * 32 + (swz % 64) / 2; }
__host__ __device__ __forceinline__ int perm32(int rho) { const int n = rho >> 4, i = rho & 15; return 8 * (i >> 2) + 4 * n + (i & 3); }

struct Unit { int pm, pn; };
struct Gemm { const bf16_t* A; const bf16_t* Bt; int M, N, K; };

struct StaticOrder {
    int nM, nN, nwg, G, c;
    __host__ __device__ void init(int M, int N, int G_, int c_) { nM = M / BM; nN = N / BM; nwg = nM * nN; G = G_; c = c_; }
    __host__ __device__ bool next(int i, Unit& u) const {
        const long L = (long)i * G + c; if (L >= nwg) return false;
        int wgid = (int)L; { const int q = nwg / NXCD, r = nwg % NXCD, xcd = wgid % NXCD, off = wgid / NXCD; wgid = (xcd < r ? xcd * (q + 1) : r * (q + 1) + (xcd - r) * q) + off; }
        const int nig = WGM * nN, gid = wgid / nig, fm = gid * WGM, gsz = (nM - fm) < WGM ? (nM - fm) : WGM;
        u.pm = fm + ((wgid % nig) % gsz); u.pn = (wgid % nig) / gsz; return true;
    }
    __device__ __forceinline__ void a_ready(const Unit&) const {}
    __device__ __forceinline__ void done(const Unit&) const {}
};

__device__ __forceinline__ unsigned cvt_pk_bf16(float lo, float hi) { unsigned r; asm volatile("v_cvt_pk_bf16_f32 %0, %1, %2" : "=v"(r) : "v"(lo), "v"(hi)); return r; }
typedef float f32x2 __attribute__((ext_vector_type(2)));
template <class Epi, class Sched, bool ALIGN_EPI = false, bool SP2 = false>
__device__ __forceinline__ void gemm_phase(PG8_LAS unsigned char* lds, const Gemm g, const Sched& S, const Epi& E, const int tid_in) {
    const int tid = tid_in, wid = __builtin_amdgcn_readfirstlane(tid >> 6), lane = tid & 63, wr = wid >> 2, wc = wid & 3, fr = lane & 15, fq = lane >> 4;
    const int K = g.K, nt = K / BK;
    unsigned voffA[2], voffB[2];
#pragma unroll
    for (int i = 0; i < 2; ++i) { int R, C; stage_rc(tid * 16 + i * 8192, R, C); const int Rb = Epi::PERM ? ((R & ~31) + perm32(R & 31)) : R;
        voffA[i] = (unsigned)(R * K + C) * 2u; voffB[i] = (unsigned)(Rb * K + C) * 2u; }
    const size_t kstep = (size_t)(BK * 2);
    const size_t hstep = (size_t)HALF * K * 2;
    const size_t tstep = 2 * hstep;
    const unsigned ldsw = (unsigned)wid * 1024u;
    const int aoff = lds_byte(wr * 64 + fr, fq * 8), boff = lds_byte(wc * 32 + fr, fq * 8);
#define PG8_SA(b, h) (((b) * 2 + (h)) * HTB)
#define PG8_SB(b, h) ((4 + (b) * 2 + (h)) * HTB)
#define PG8_STAGE(bufoff, gbase, voff) do { _Pragma("unroll") for (int _i = 0; _i < 2; ++_i) \
        __builtin_amdgcn_global_load_lds((const unsigned*)((const char*)(gbase) + (voff)[_i]), (PG8_LAS unsigned*)(lds + (bufoff) + ldsw + _i * 8192), 16, 0, 0); } while (0)
#define PG8_LDA(dst, b, h) do { _Pragma("unroll") for (int m = 0; m < 4; ++m) _Pragma("unroll") for (int k = 0; k < 2; ++k) dst[m][k] = *(const PG8_LAS bf16x8*)(lds + PG8_SA(b, h) + aoff + m * 2048 + k * 1024); } while (0)
#define PG8_LDB(dst, b, h) do { _Pragma("unroll") for (int n = 0; n < 2; ++n) _Pragma("unroll") for (int k = 0; k < 2; ++k) dst[n][k] = *(const PG8_LAS bf16x8*)(lds + PG8_SB(b, h) + boff + n * 2048 + k * 1024); } while (0)
#define PG8_MMA(ai, bj, At, Bt) do { __builtin_amdgcn_s_setprio(1); _Pragma("unroll") for (int m = 0; m < 4; ++m) _Pragma("unroll") for (int n = 0; n < 2; ++n) _Pragma("unroll") for (int k = 0; k < 2; ++k) \
        acc[ai][bj][m][n] = __builtin_amdgcn_mfma_f32_16x16x32_bf16(Bt[n][k], At[m][k], acc[ai][bj][m][n], 0, 0, 0); __builtin_amdgcn_s_setprio(0); } while (0)
#define PG8_WAIT_V(n) asm volatile("s_waitcnt vmcnt(" #n ")" ::: "memory")
#define PG8_WAIT_L(n) asm volatile("s_waitcnt lgkmcnt(" #n ")" ::: "memory")
#define PG8_BAR __builtin_amdgcn_s_barrier()
#define PG8_SCHED __builtin_amdgcn_sched_barrier(0)
    Unit cur, nxt; int ui = 0;
    if (!S.next(0, cur)) return;
    f32x4 acc[2][2][4][2];
#pragma unroll
    for (int a = 0; a < 2; ++a)
#pragma unroll
        for (int b = 0; b < 2; ++b)
#pragma unroll
            for (int m = 0; m < 4; ++m)
#pragma unroll
                for (int n = 0; n < 2; ++n) acc[a][b][m][n] = (f32x4){0.f, 0.f, 0.f, 0.f};
    bf16x8 At[4][2], B0[2][2], B1[2][2];
    const char* cA = (const char*)g.A + (size_t)cur.pm * tstep; const char* cB = (const char*)g.Bt + (size_t)cur.pn * tstep;
    S.a_ready(cur);
    if constexpr (SP2) {
        PG8_STAGE(PG8_SB(0, 0), cB, voffB); PG8_STAGE(PG8_SB(0, 1), cB + hstep, voffB); PG8_STAGE(PG8_SA(0, 0), cA, voffA); PG8_STAGE(PG8_SA(0, 1), cA + hstep, voffA);
        if (wr == 1) PG8_BAR;
        PG8_WAIT_V(2); PG8_BAR;
        PG8_STAGE(PG8_SB(1, 0), cB + kstep, voffB); PG8_STAGE(PG8_SA(1, 0), cA + kstep, voffA); PG8_STAGE(PG8_SB(1, 1), cB + hstep + kstep, voffB);
        PG8_WAIT_V(6); PG8_BAR;
    } else {
        PG8_STAGE(PG8_SB(0, 0), cB, voffB); PG8_STAGE(PG8_SA(0, 0), cA, voffA); PG8_STAGE(PG8_SB(0, 1), cB + hstep, voffB); PG8_STAGE(PG8_SA(0, 1), cA + hstep, voffA);
        if (wr == 1) PG8_BAR;
        PG8_WAIT_V(4); PG8_BAR;
        PG8_STAGE(PG8_SB(1, 0), cB + kstep, voffB); PG8_STAGE(PG8_SA(1, 0), cA + kstep, voffA); PG8_STAGE(PG8_SB(1, 1), cB + hstep + kstep, voffB);
        PG8_WAIT_V(6); PG8_BAR;
    }
    for (;;) {
        const bool has_next = S.next(ui + 1, nxt);
        const char* nA = has_next ? (const char*)g.A + (size_t)nxt.pm * tstep : cA; const char* nB = has_next ? (const char*)g.Bt + (size_t)nxt.pn * tstep : cB;
        for (int t = 0; t < nt; t += 2) {
            const bool last = (t == nt - 2);
            const char* a1 = cA + (size_t)(t + 1) * kstep;
            const char* a2 = last ? nA : cA + (size_t)(t + 2) * kstep; const char* b2 = last ? nB : cB + (size_t)(t + 2) * kstep;
            const char* a3 = a2 + kstep; const char* b3 = b2 + kstep;
            if (last && has_next) S.a_ready(nxt);
            if constexpr (SP2) {
            PG8_LDB(B0, 0, 0); PG8_LDB(B1, 0, 1); PG8_SCHED; PG8_LDA(At, 0, 0); PG8_STAGE(PG8_SA(1, 1), a1 + hstep, voffA);
            PG8_WAIT_V(8); PG8_WAIT_L(0); PG8_BAR; PG8_MMA(0, 0, At, B0); PG8_MMA(0, 1, At, B1); PG8_BAR; PG8_SCHED;
            PG8_LDA(At, 0, 1); PG8_STAGE(PG8_SB(0, 0), b2, voffB); PG8_STAGE(PG8_SB(0, 1), b2 + hstep, voffB); PG8_STAGE(PG8_SA(0, 0), a2, voffA);
            PG8_WAIT_V(8); PG8_WAIT_L(0); PG8_BAR; PG8_MMA(1, 0, At, B0); PG8_MMA(1, 1, At, B1); PG8_BAR; PG8_SCHED;
            PG8_LDB(B0, 1, 0); PG8_LDB(B1, 1, 1); PG8_SCHED; PG8_LDA(At, 1, 0); PG8_STAGE(PG8_SA(0, 1), a2 + hstep, voffA);
            PG8_WAIT_V(8); PG8_WAIT_L(0); PG8_BAR; PG8_MMA(0, 0, At, B0); PG8_MMA(0, 1, At, B1); PG8_BAR; PG8_SCHED;
            PG8_LDA(At, 1, 1); PG8_STAGE(PG8_SB(1, 0), b3, voffB); PG8_STAGE(PG8_SB(1, 1), b3 + hstep, voffB); PG8_STAGE(PG8_SA(1, 0), a3, voffA);
            PG8_WAIT_V(8); PG8_WAIT_L(0); PG8_BAR; PG8_MMA(1, 0, At, B0); PG8_MMA(1, 1, At, B1); PG8_BAR; PG8_SCHED;
            } else {
            PG8_LDB(B0, 0, 0); PG8_SCHED; PG8_LDA(At, 0, 0); PG8_STAGE(PG8_SA(1, 1), a1 + hstep, voffA);
            PG8_WAIT_L(8); PG8_BAR; PG8_WAIT_L(0); PG8_MMA(0, 0, At, B0); PG8_BAR; PG8_SCHED;
            PG8_LDB(B1, 0, 1); PG8_STAGE(PG8_SB(0, 0), b2, voffB);
            PG8_BAR; PG8_WAIT_L(0); PG8_MMA(0, 1, At, B1); PG8_BAR;
            PG8_LDA(At, 0, 1); PG8_STAGE(PG8_SA(0, 0), a2, voffA);
            PG8_BAR; PG8_WAIT_L(0); PG8_MMA(1, 0, At, B0); PG8_BAR; PG8_SCHED;
            PG8_STAGE(PG8_SB(0, 1), b2 + hstep, voffB);
            PG8_WAIT_V(6); PG8_BAR; PG8_MMA(1, 1, At, B1); PG8_BAR;
            PG8_LDB(B0, 1, 0); PG8_SCHED; PG8_LDA(At, 1, 0); PG8_STAGE(PG8_SA(0, 1), a2 + hstep, voffA);
            PG8_WAIT_L(8); PG8_BAR; PG8_WAIT_L(0); PG8_MMA(0, 0, At, B0); PG8_BAR; PG8_SCHED;
            PG8_LDB(B1, 1, 1); PG8_STAGE(PG8_SB(1, 0), b3, voffB);
            PG8_BAR; PG8_WAIT_L(0); PG8_MMA(0, 1, At, B1); PG8_BAR;
            PG8_LDA(At, 1, 1); PG8_STAGE(PG8_SA(1, 0), a3, voffA);
            PG8_BAR; PG8_WAIT_L(0); PG8_MMA(1, 0, At, B0); PG8_BAR; PG8_SCHED;
            PG8_STAGE(PG8_SB(1, 1), b3 + hstep, voffB);
            PG8_WAIT_V(6); PG8_BAR; PG8_MMA(1, 1, At, B1); PG8_BAR;
            }
        }
        if constexpr (ALIGN_EPI) { if (wr == 0) PG8_BAR; }
        if constexpr (!Epi::AFTER_DRAIN) { E(acc, cur, wr, wc, fr, fq); S.done(cur); }
        if (!has_next) break;
#pragma unroll
        for (int a = 0; a < 2; ++a)
#pragma unroll
            for (int b = 0; b < 2; ++b)
#pragma unroll
                for (int m = 0; m < 4; ++m)
#pragma unroll
                    for (int n = 0; n < 2; ++n) acc[a][b][m][n] = (f32x4){0.f, 0.f, 0.f, 0.f};
        cur = nxt; cA = nA; cB = nB; ++ui;
        if constexpr (ALIGN_EPI) { if (wr == 1) PG8_BAR; }
    }
    PG8_WAIT_V(0);
    if constexpr (!ALIGN_EPI) { if (wr == 0) PG8_BAR; }
    PG8_BAR;
    if constexpr (Epi::AFTER_DRAIN) { E.fused(acc, cur, wr, wc, fr, fq, lds, wid, lane); S.done(cur); }
#undef PG8_SA
#undef PG8_SB
#undef PG8_STAGE
#undef PG8_LDA
#undef PG8_LDB
#undef PG8_MMA
#undef PG8_WAIT_V
#undef PG8_WAIT_L
#undef PG8_BAR
#undef PG8_SCHED
}
}
using pg8::bf16_t; using pg8::bf16x8; using pg8::f32x4; using pg8::u32x4; using pg8::cvt_pk_bf16; using pg8::f32x2;
#define LAS __attribute__((address_space(3)))
typedef unsigned u32x2 __attribute__((ext_vector_type(2)));

#ifndef MK_PER_PHASE
#define MK_PER_PHASE 0
#endif

constexpr int T_ = 16384, D_ = 1024, DFF = 2816, SEQ = 2048;
constexpr float EPS = 1e-6f;
constexpr size_t MiB = 1u << 20;
constexpr size_t WS_MOD = 0, WS_LAML = 1 * MiB, WS_MW = 2 * MiB, WS_V = 14 * MiB, WS_WIN = 18 * MiB, WS_WOUT = 62 * MiB, WS_ABIN = 84 * MiB,
                 WS_ABOUT = 87 * MiB, WS_SSMIN = 89 * MiB, WS_GLU = 91 * MiB, WS_SMALL = 95 * MiB, WS_H = 96 * MiB, WS_F = 128 * MiB, WS_ACT = 160 * MiB,
                 WS_END = 248 * MiB;
constexpr size_t WS_Z = WS_ACT, WS_YCAT = WS_ACT + 48 * MiB;
constexpr size_t WS_U = WS_ACT, WS_YI = WS_ACT + 32 * MiB, WS_XS = WS_ACT + 64 * MiB, WS_G = WS_H, WS_SST = WS_F;
constexpr int LDS_BYTES = 135168;
constexpr int NPH = 24;

struct Args { const float* in[26]; float* out; unsigned char* ws; int ph_lo, ph_hi; };

__device__ __forceinline__ float wave_sum(float v) {
#pragma unroll
    for (int o = 1; o < 64; o <<= 1) v += __shfl_xor(v, o);
    return v;
}
__device__ __forceinline__ float bf2f(unsigned b) { return __uint_as_float(b << 16); }
__device__ __forceinline__ unsigned f2bf(float f) { unsigned u = __float_as_uint(f); return (u + 0x7fffu + ((u >> 16) & 1u)) >> 16; }
__device__ __forceinline__ f32x4 ld4bf(const bf16_t* p) { const u32x2 v = *(const u32x2*)p; f32x4 r; r.x = __uint_as_float(v.x << 16); r.y = __uint_as_float(v.x & 0xffff0000u); r.z = __uint_as_float(v.y << 16); r.w = __uint_as_float(v.y & 0xffff0000u); return r; }
__device__ __forceinline__ void st4bf(bf16_t* p, f32x4 v) { u32x2 w; w.x = cvt_pk_bf16(v.x, v.y); w.y = cvt_pk_bf16(v.z, v.w); *(u32x2*)p = w; }
__device__ __forceinline__ float gelu_tanh(float x) { const float t = 1.5957691216f * (x + 0.044715f * x * x * x); return x * __builtin_amdgcn_rcpf(1.0f + __expf(-t)); }

template <int MODE> struct EpiGated {
    static constexpr bool PERM = true, AFTER_DRAIN = false;
    bf16_t* O; int ldc;
    __device__ __forceinline__ void operator()(const f32x4 (&acc)[2][2][4][2], const pg8::Unit& u, int wr, int wc, int fr, int fq) const {
        const int row0 = u.pm * 256 + wr * 64 + fr, col0 = u.pn * 128 + wc * 32 + 8 * fq;
#pragma unroll
        for (int ai = 0; ai < 2; ++ai)
#pragma unroll
            for (int m = 0; m < 4; ++m) {
                bf16_t* rowp = O + (size_t)(row0 + ai * 128 + m * 16) * ldc + col0;
                float v[8];
#pragma unroll
                for (int n = 0; n < 2; ++n)
#pragma unroll
                    for (int i = 0; i < 4; ++i) { const float a = acc[ai][0][m][n][i], b = acc[ai][1][m][n][i];
                        v[n * 4 + i] = (MODE == 0) ? a * b * __builtin_amdgcn_rcpf(1.0f + __expf(-a)) : a * __builtin_amdgcn_rcpf(1.0f + __expf(-b)); }
                u32x4 w; w.x = cvt_pk_bf16(v[0], v[1]); w.y = cvt_pk_bf16(v[2], v[3]); w.z = cvt_pk_bf16(v[4], v[5]); w.w = cvt_pk_bf16(v[6], v[7]);
                *(u32x4*)rowp = w;
            }
    }
};
struct EpiPlain {
    static constexpr bool PERM = true, AFTER_DRAIN = false;
    bf16_t* O; int ldc; int gelu_from;
    __device__ __forceinline__ void operator()(const f32x4 (&acc)[2][2][4][2], const pg8::Unit& u, int wr, int wc, int fr, int fq) const {
        const int row0 = u.pm * 256 + wr * 64 + fr, col0 = u.pn * 256 + wc * 32 + 8 * fq; const bool gl = u.pn >= gelu_from;
#pragma unroll
        for (int ai = 0; ai < 2; ++ai)
#pragma unroll
            for (int m = 0; m < 4; ++m) {
                bf16_t* rowp = O + (size_t)(row0 + ai * 128 + m * 16) * ldc + col0;
#pragma unroll
                for (int bj = 0; bj < 2; ++bj) { f32x4 v0 = acc[ai][bj][m][0], v1 = acc[ai][bj][m][1];
                    if (gl) {
#pragma unroll
                        for (int i = 0; i < 4; ++i) { v0[i] = gelu_tanh(v0[i]); v1[i] = gelu_tanh(v1[i]); } }
                    u32x4 w; w.x = cvt_pk_bf16(v0[0], v0[1]); w.y = cvt_pk_bf16(v0[2], v0[3]); w.z = cvt_pk_bf16(v1[0], v1[1]); w.w = cvt_pk_bf16(v1[2], v1[3]);
                    *(u32x4*)(rowp + bj * 128) = w; }
            }
    }
};

__device__ __forceinline__ void transpose_item(const float* W, int K, int N, bf16_t* WT, int mode, LAS float* scr, int item, int lane) {
    const int nblk = N / 32, kb = item / nblk, nb = item % nblk, k0 = 64 * kb, n0 = 32 * nb;
    int r0 = n0;
    if (mode) { const int half = N >> 1, hf = (n0 >= half) ? 1 : 0, j = n0 - hf * half; r0 = (j >> 7) * 256 + hf * 128 + (j & 127); }
#pragma unroll 8
    for (int i = 0; i < 32; ++i) { const int kk = 2 * i + (lane >> 5); scr[kk * 33 + (lane & 31)] = W[(size_t)(k0 + kk) * N + n0 + (lane & 31)]; }
    asm volatile("s_waitcnt lgkmcnt(0)" ::: "memory");
    const int c = lane & 7;
#pragma unroll
    for (int j = 0; j < 4; ++j) { const int n = (lane >> 3) + 8 * j; const LAS float* s = scr + (8 * c) * 33 + n;
        u32x4 o; o.x = cvt_pk_bf16(s[0 * 33], s[1 * 33]); o.y = cvt_pk_bf16(s[2 * 33], s[3 * 33]); o.z = cvt_pk_bf16(s[4 * 33], s[5 * 33]); o.w = cvt_pk_bf16(s[6 * 33], s[7 * 33]);
        *(u32x4*)(WT + (size_t)(r0 + n) * K + k0 + 8 * c) = o; }
    asm volatile("s_waitcnt lgkmcnt(0)" ::: "memory");
}

__device__ __forceinline__ void ssm_precompute(const int tidv, int g, const float* lam_re, const float* lam_im, const float* b_re, const float* b_im, const float* c_re, const float* c_im,
                                               const float* log_dt, bf16_t* MW, bf16_t* V, float* lamL, LAS unsigned char* L) {
    LAS float* pw = (LAS float*)L;
    LAS float* Bb = pw + 17 * 64 * 2;
    LAS float* Cc = Bb + 2048;
    LAS float* Kk = Cc + 2048;
    const int tid = tidv;
    const float dt = expf(log_dt[g]);
    for (int idx = tid; idx < 17 * 64; idx += 512) { const int j = idx >> 6, p = idx & 63; const float lr = lam_re[g * 64 + p], li = lam_im[g * 64 + p];
        const float mag = expf((float)j * dt * lr); double rev = (double)j * (double)dt * (double)li * 0.15915494309189535; rev -= rint(rev);
        const float ang = (float)(rev * 6.283185307179586); pw[idx * 2] = mag * __cosf(ang); pw[idx * 2 + 1] = mag * __sinf(ang); }
    for (int idx = tid; idx < 1024; idx += 512) { const int p = idx >> 4; const float lr = lam_re[g * 64 + p], li = lam_im[g * 64 + p];
        const float mag = expf(dt * lr); double rev = (double)dt * (double)li * 0.15915494309189535; rev -= rint(rev); const float ang = (float)(rev * 6.283185307179586);
        const float er = mag * __cosf(ang) - 1.0f, ei = mag * __sinf(ang);
        const float den = 1.0f / (lr * lr + li * li); const float qr = (er * lr + ei * li) * den, qi = (ei * lr - er * li) * den;
        const float br = b_re[g * 1024 + idx], bi = b_im[g * 1024 + idx];
        Bb[idx * 2] = qr * br - qi * bi; Bb[idx * 2 + 1] = qr * bi + qi * br; }
    for (int idx = tid; idx < 1024; idx += 512) { Cc[idx * 2] = c_re[g * 1024 + idx]; Cc[idx * 2 + 1] = c_im[g * 1024 + idx]; }
    __syncthreads();
    for (int idx = tid; idx < 4096; idx += 512) { const int j = idx >> 8, n = (idx >> 4) & 15, m = idx & 15; float s = 0.f;
        for (int p = 0; p < 64; ++p) { const float cr = Cc[(n * 64 + p) * 2], ci = Cc[(n * 64 + p) * 2 + 1], pr = pw[(j * 64 + p) * 2], pi = pw[(j * 64 + p) * 2 + 1];
            const float xr = cr * pr - ci * pi, xi = cr * pi + ci * pr; s += xr * Bb[(p * 16 + m) * 2] - xi * Bb[(p * 16 + m) * 2 + 1]; }
        Kk[idx] = s; }
    __syncthreads();
    bf16_t* MWg = MW + (size_t)g * 384 * 256; bf16_t* Vg = V + (size_t)g * 256 * 128;
    for (int q = tid; q < 32768; q += 512) { const int row = q >> 7, c2 = (q & 127) * 2; const int t = row >> 4, n = row & 15, s = c2 >> 4, m = c2 & 15;
        float v0 = 0.f, v1 = 0.f; if (s <= t) { v0 = Kk[((t - s) * 16 + n) * 16 + m]; v1 = Kk[((t - s) * 16 + n) * 16 + m + 1]; }
        *(unsigned*)(MWg + row * 256 + c2) = cvt_pk_bf16(v0, v1); }
    for (int q = tid; q < 16384; q += 512) { const int r = q >> 7, c2 = (q & 127) * 2; const int p = r >> 1, ri = r & 1, s = c2 >> 4, m = c2 & 15;
        const float pr = pw[((15 - s) * 64 + p) * 2], pi = pw[((15 - s) * 64 + p) * 2 + 1]; float v[2];
#pragma unroll
        for (int e = 0; e < 2; ++e) { const float br = Bb[(p * 16 + m + e) * 2], bi = Bb[(p * 16 + m + e) * 2 + 1]; v[e] = ri ? (pr * bi + pi * br) : (pr * br - pi * bi); }
        *(unsigned*)(MWg + (256 + r) * 256 + c2) = cvt_pk_bf16(v[0], v[1]); }
    for (int q = tid; q < 16384; q += 512) { const int row = q >> 6, p = q & 63; const int t = row >> 4, n = row & 15;
        const float cr = Cc[(n * 64 + p) * 2], ci = Cc[(n * 64 + p) * 2 + 1], pr = pw[((t + 1) * 64 + p) * 2], pi = pw[((t + 1) * 64 + p) * 2 + 1];
        *(unsigned*)(Vg + row * 128 + 2 * p) = cvt_pk_bf16(cr * pr - ci * pi, -(cr * pi + ci * pr)); }
    if (tid < 64) { lamL[(g * 64 + tid) * 2] = pw[(16 * 64 + tid) * 2]; lamL[(g * 64 + tid) * 2 + 1] = pw[(16 * 64 + tid) * 2 + 1]; }
}

__device__ __forceinline__ void p0_phase(const int tidv, const Args& a, LAS unsigned char* L) {
    const int tid = tidv, lane = tid & 63, wave = __builtin_amdgcn_readfirstlane(tid >> 6), G = gridDim.x, bx = blockIdx.x;
    unsigned char* ws = a.ws;
    for (int g = bx; g < 64; g += G) {
        ssm_precompute(tidv, g, a.in[17], a.in[18], a.in[19], a.in[20], a.in[21], a.in[22], a.in[24], (bf16_t*)(ws + WS_MW), (bf16_t*)(ws + WS_V), (float*)(ws + WS_LAML), L);
        __syncthreads(); }
    { bf16_t* pwt = (bf16_t*)(ws + WS_SMALL); bf16_t* sgw = pwt + 65536; const float* pool_w = a.in[9]; const float* sgu_w = a.in[13];
      for (int i = bx * 512 + tid; i < 65536; i += G * 512) { const int gg = i >> 14, o = (i >> 7) & 127, ii = i & 127;
          pwt[i] = (bf16_t)f2bf(pool_w[(gg * 128 + ii) * 128 + o]); sgw[i] = (ii <= o) ? (bf16_t)f2bf(sgu_w[i]) : (bf16_t)0; } }
    { LAS float* cond = (LAS float*)L; const float* c = a.in[1];
      for (int i = tid; i < 8192; i += 512) { const float v = c[i]; cond[i] = v / (1.0f + __expf(-v)); }
      __syncthreads();
      float* mod = (float*)(ws + WS_MOD); const float* ada_w = a.in[2]; const float* ada_b = a.in[3];
      for (int it = bx; it < 1152; it += G) { const int l = it / 576, r = it % 576, jc = r >> 5, kc = r & 31; const int j = jc * 512 + tid;
          float acc[8];
#pragma unroll
          for (int b = 0; b < 8; ++b) acc[b] = 0.f;
          const float* wp = ada_w + ((size_t)l * 1024 + kc * 32) * 9216 + j;
#pragma unroll 8
          for (int kk = 0; kk < 32; ++kk) { const float w = wp[(size_t)kk * 9216];
#pragma unroll
              for (int b = 0; b < 8; ++b) acc[b] += cond[b * 1024 + kc * 32 + kk] * w; }
          const float bias = (kc == 0) ? ada_b[l * 9216 + j] : 0.f;
#pragma unroll
          for (int b = 0; b < 8; ++b) atomicAdd(mod + ((size_t)l * 8 + b) * 9216 + j, acc[b] + bias); }
      __syncthreads(); }
    { LAS float* scr = (LAS float*)(L + wave * 8448); const int gw = bx * 8 + wave, NGW = G * 8;
      constexpr int I_IN = 16 * 176, I_OUT = 44 * 32, I_ABIN = 16 * 48, I_SQ = 16 * 32, I_GLU = 16 * 64;
      constexpr int NIT = 4 * I_IN + 4 * I_OUT + I_ABIN + 2 * I_SQ + I_GLU;
      for (int it = gw; it < NIT; it += NGW) { int r = it;
          if (r < 4 * I_IN) { const int w = r / I_IN; transpose_item(a.in[6] + (size_t)w * 1024 * 5632, 1024, 5632, (bf16_t*)(ws + WS_WIN) + (size_t)w * 5632 * 1024, 1, scr, r % I_IN, lane); continue; } r -= 4 * I_IN;
          if (r < 4 * I_OUT) { const int w = r / I_OUT; transpose_item(a.in[7] + (size_t)w * 2816 * 1024, 2816, 1024, (bf16_t*)(ws + WS_WOUT) + (size_t)w * 1024 * 2816, 0, scr, r % I_OUT, lane); continue; } r -= 4 * I_OUT;
          if (r < I_ABIN) { transpose_item(a.in[8], 1024, 1536, (bf16_t*)(ws + WS_ABIN), 0, scr, r, lane); continue; } r -= I_ABIN;
          if (r < I_SQ) { transpose_item(a.in[15], 1024, 1024, (bf16_t*)(ws + WS_ABOUT), 0, scr, r, lane); continue; } r -= I_SQ;
          if (r < I_SQ) { transpose_item(a.in[16], 1024, 1024, (bf16_t*)(ws + WS_SSMIN), 0, scr, r, lane); continue; } r -= I_SQ;
          transpose_item(a.in[25], 1024, 2048, (bf16_t*)(ws + WS_GLU), 1, scr, r, lane); } }
}

template <bool HAS_PREV, bool HAS_NEXT>
__device__ __forceinline__ void r_phase(const int tidv, const float* xin, const bf16_t* f, float* xout, bf16_t* h, const float* gpost, const float* modprev, float rw, const float* gpre, const float* modnext) {
    const int tid = tidv, lane = tid & 63, wave = tid >> 6; const int gw = blockIdx.x * 8 + wave, NGW = gridDim.x * 8;
    for (int rb = gw; rb < T_ / 8; rb += NGW) {
        const int r0 = rb * 8, b = r0 / SEQ;
        f32x4 A1[4], A2[4], A3[4];
#pragma unroll
        for (int c = 0; c < 4; ++c) { const int col = c * 256 + lane * 4;
            if (HAS_PREV) { const f32x4 gp = *(const f32x4*)(gpost + col), gt = *(const f32x4*)(modprev + (size_t)b * 9216 + 2048 + col); A1[c] = gp * gt * rw; }
            if (HAS_NEXT) { const f32x4 gq = *(const f32x4*)(gpre + col), sc = *(const f32x4*)(modnext + (size_t)b * 9216 + 1024 + col); A2[c] = gq * (sc + 1.0f); A3[c] = *(const f32x4*)(modnext + (size_t)b * 9216 + col); } }
        for (int r = r0; r < r0 + 8; ++r) {
            f32x4 xv[4];
#pragma unroll
            for (int c = 0; c < 4; ++c) xv[c] = *(const f32x4*)(xin + (size_t)r * D_ + c * 256 + lane * 4);
            if (HAS_PREV) { f32x4 fv[4]; float ss = 0.f;
#pragma unroll
                for (int c = 0; c < 4; ++c) { fv[c] = ld4bf(f + (size_t)r * D_ + c * 256 + lane * 4); ss += fv[c].x * fv[c].x + fv[c].y * fv[c].y + fv[c].z * fv[c].z + fv[c].w * fv[c].w; }
                const float rs = rsqrtf(wave_sum(ss) * (1.0f / D_) + EPS);
#pragma unroll
                for (int c = 0; c < 4; ++c) { xv[c] = xv[c] + A1[c] * fv[c] * rs; *(f32x4*)(xout + (size_t)r * D_ + c * 256 + lane * 4) = xv[c]; } }
            if (HAS_NEXT) { float ss = 0.f;
#pragma unroll
                for (int c = 0; c < 4; ++c) ss += xv[c].x * xv[c].x + xv[c].y * xv[c].y + xv[c].z * xv[c].z + xv[c].w * xv[c].w;
                const float rs = rsqrtf(wave_sum(ss) * (1.0f / D_) + EPS);
#pragma unroll
                for (int c = 0; c < 4; ++c) st4bf(h + (size_t)r * D_ + c * 256 + lane * 4, xv[c] * rs * A2[c] + A3[c]); }
        }
    }
}

__device__ __forceinline__ void mix0_phase(const int tidv, const bf16_t* z, const bf16_t* pool_wt, const float* pool_scale, const float* ln_g, const float* ln_b, const bf16_t* sguw, const float* sgu_b,
                                           bf16_t* ycat, LAS unsigned char* L) {
    LAS unsigned char* As = L; LAS unsigned char* Bs = L + 34816; LAS float* st = (LAS float*)(L + 69632);
    const int tid = tidv, lane = tid & 63, wave = __builtin_amdgcn_readfirstlane(tid >> 6), fr = lane & 15, fq = lane >> 4;
    for (int it = blockIdx.x; it < 1024; it += gridDim.x) {
        const int q = it >> 3, unit = it & 7, row0 = q * 128;
        __syncthreads();
        if (unit < 4) {
            const int g = unit, w = 2 << g, i4 = tid & 31, t0 = (tid >> 5) * 8, pos0 = (q & 15) * 128 + t0;
            const bf16_t* zp = z + (size_t)(row0 + t0) * 1536 + g * 128 + 4 * i4;
            f32x4 sum = {0.f, 0.f, 0.f, 0.f};
            for (int k = 1; k < w; ++k) if (pos0 - k >= 0) sum = sum + ld4bf(zp - (ptrdiff_t)k * 1536);
#pragma unroll
            for (int r = 0; r < 8; ++r) { const int pos = pos0 + r; const f32x4 cur = ld4bf(zp + (ptrdiff_t)r * 1536); sum = sum + cur;
                if (r > 0 && pos - w >= 0) sum = sum - ld4bf(zp + (ptrdiff_t)(r - w) * 1536);
                const float inv = 1.0f / (float)min(pos + 1, w); const f32x4 d = sum * inv - cur;
                u32x2 o; o.x = cvt_pk_bf16(d.x, d.y); o.y = cvt_pk_bf16(d.z, d.w); *(LAS u32x2*)(As + (t0 + r) * 272 + 8 * i4) = o; }
#pragma unroll
            for (int e = 0; e < 4; ++e) { const int idx = tid + e * 512, r = idx >> 4, c = idx & 15; *(LAS u32x4*)(Bs + r * 272 + c * 16) = *(const u32x4*)(pool_wt + g * 16384 + r * 128 + c * 8); }
        } else {
            const int hh = unit - 4;
#pragma unroll
            for (int e = 0; e < 4; ++e) { const int idx = tid + e * 512, r = idx >> 4, c = idx & 15; *(LAS u32x4*)(As + r * 272 + c * 16) = *(const u32x4*)(sguw + hh * 16384 + r * 128 + c * 8); }
            for (int i = 0; i < 16; ++i) { const int s = wave * 16 + i; const unsigned vv = *(const unsigned*)(z + (size_t)(row0 + s) * 1536 + 1024 + hh * 128 + 2 * lane);
                const float v0 = __uint_as_float(vv << 16), v1 = __uint_as_float(vv & 0xffff0000u); const float mean = wave_sum(v0 + v1) * (1.0f / 128.0f);
                const float d0 = v0 - mean, d1 = v1 - mean; const float var = wave_sum(d0 * d0 + d1 * d1) * (1.0f / 128.0f);
                if (lane == 0) { st[s * 2] = mean; st[s * 2 + 1] = rsqrtf(var + EPS); } }
            __syncthreads();
            const int d = tid & 127, sg = tid >> 7; const float gln = ln_g[hh * 128 + d], bln = ln_b[hh * 128 + d];
#pragma unroll
            for (int sb = 0; sb < 4; ++sb) { const int s0 = sg * 32 + sb * 8; float vn[8];
#pragma unroll
                for (int k = 0; k < 8; ++k) { const float v = bf2f(z[(size_t)(row0 + s0 + k) * 1536 + 1024 + hh * 128 + d]); vn[k] = (v - st[(s0 + k) * 2]) * st[(s0 + k) * 2 + 1] * gln + bln; }
                u32x4 o; o.x = cvt_pk_bf16(vn[0], vn[1]); o.y = cvt_pk_bf16(vn[2], vn[3]); o.z = cvt_pk_bf16(vn[4], vn[5]); o.w = cvt_pk_bf16(vn[6], vn[7]);
                *(LAS u32x4*)(Bs + d * 272 + s0 * 2) = o; }
        }
        __syncthreads();
        const int wr = wave >> 1, wc = wave & 1;
        f32x4 acc[2][4];
#pragma unroll
        for (int m = 0; m < 2; ++m)
#pragma unroll
            for (int n = 0; n < 4; ++n) acc[m][n] = (f32x4){0.f, 0.f, 0.f, 0.f};
#pragma unroll
        for (int kk = 0; kk < 4; ++kk) { bf16x8 Af[2];
#pragma unroll
            for (int m = 0; m < 2; ++m) Af[m] = *(const LAS bf16x8*)(As + (32 * wr + 16 * m + fr) * 272 + kk * 64 + fq * 16);
#pragma unroll
            for (int n = 0; n < 4; ++n) { const bf16x8 Bf = *(const LAS bf16x8*)(Bs + (64 * wc + 16 * n + fr) * 272 + kk * 64 + fq * 16);
#pragma unroll
                for (int m = 0; m < 2; ++m) acc[m][n] = __builtin_amdgcn_mfma_f32_16x16x32_bf16(Bf, Af[m], acc[m][n], 0, 0, 0); } }
#pragma unroll
        for (int m = 0; m < 2; ++m) { const int row = 32 * wr + 16 * m + fr;
#pragma unroll
            for (int n = 0; n < 4; ++n) { const int col = 64 * wc + 16 * n + 4 * fq;
                if (unit < 4) { const f32x4 sc = *(const f32x4*)(pool_scale + unit * 128 + col); st4bf(ycat + (size_t)(row0 + row) * 1024 + unit * 128 + col, acc[m][n] * sc); }
                else { const int hh = unit - 4; const f32x4 uu = ld4bf(z + (size_t)(row0 + row) * 1536 + 512 + hh * 128 + col); const float bs = sgu_b[hh * 128 + row];
                    st4bf(ycat + (size_t)(row0 + row) * 1024 + 512 + hh * 128 + col, uu * (acc[m][n] + bs)); } } }
    }
}

__device__ __forceinline__ void s1_phase(const int tidv, const bf16_t* u, const bf16_t* MW, bf16_t* yintra, float* Sst, LAS unsigned char* L) {
    const int tid = tidv, lane = tid & 63, wave = __builtin_amdgcn_readfirstlane(tid >> 6), fr = lane & 15, fq = lane >> 4;
    for (int it = blockIdx.x; it < 256; it += gridDim.x) {
        const int g = it >> 2, cb = it & 3, colw = cb * 256 + wave * 32;
        bf16x8 Bf[2][8];
#pragma unroll
        for (int nt = 0; nt < 2; ++nt)
#pragma unroll
            for (int kk = 0; kk < 8; ++kk) { const int col = colw + nt * 16 + fr; Bf[nt][kk] = *(const bf16x8*)(u + ((size_t)col * 16 + 2 * kk + (fq >> 1)) * 1024 + g * 16 + (fq & 1) * 8); }
        for (int rb = 0; rb < 3; ++rb) {
            __syncthreads();
#pragma unroll
            for (int e = 0; e < 8; ++e) { const int idx = tid + e * 512, r = idx >> 5, c = idx & 31; *(LAS u32x4*)(L + r * 528 + c * 16) = *(const u32x4*)(MW + ((size_t)g * 384 + rb * 128 + r) * 256 + c * 8); }
            __syncthreads();
            f32x4 acc[8][2];
#pragma unroll
            for (int mt = 0; mt < 8; ++mt) { acc[mt][0] = (f32x4){0.f, 0.f, 0.f, 0.f}; acc[mt][1] = (f32x4){0.f, 0.f, 0.f, 0.f}; }
#pragma unroll
            for (int mt = 0; mt < 8; ++mt)
#pragma unroll
                for (int kk = 0; kk < 8; ++kk) { const bf16x8 Af = *(const LAS bf16x8*)(L + (mt * 16 + fr) * 528 + kk * 64 + fq * 16);
                    acc[mt][0] = __builtin_amdgcn_mfma_f32_16x16x32_bf16(Af, Bf[0][kk], acc[mt][0], 0, 0, 0);
                    acc[mt][1] = __builtin_amdgcn_mfma_f32_16x16x32_bf16(Af, Bf[1][kk], acc[mt][1], 0, 0, 0); }
#pragma unroll
            for (int mt = 0; mt < 8; ++mt)
#pragma unroll
                for (int nt = 0; nt < 2; ++nt) { const int col = colw + nt * 16 + fr;
                    if (rb < 2) { const int t = rb * 8 + mt; st4bf(yintra + ((size_t)col * 16 + t) * 1024 + g * 16 + fq * 4, acc[mt][nt]); }
                    else *(f32x4*)(Sst + ((size_t)col * 64 + g) * 128 + mt * 16 + fq * 4) = acc[mt][nt]; }
        }
    }
}
__device__ __forceinline__ void s2_phase(const int tidv, const float* Sst, const float* lamL, bf16_t* Xs) {
    for (int gt = blockIdx.x * 512 + tidv; gt < 32768; gt += gridDim.x * 512) {
        const int b = gt >> 12, gp = gt & 4095; const float lr = lamL[gp * 2], li = lamL[gp * 2 + 1]; float xr = 0.f, xi = 0.f;
#pragma unroll 8
        for (int c = 0; c < 128; ++c) { const size_t idx = ((size_t)(b * 128 + c) * 4096 + gp) * 2; *(unsigned*)(Xs + idx) = cvt_pk_bf16(xr, xi);
            const f32x2 s = *(const f32x2*)(Sst + idx); const float nr = lr * xr - li * xi + s.x, ni = lr * xi + li * xr + s.y; xr = nr; xi = ni; }
    }
}
__device__ __forceinline__ void s3_phase(const int tidv, const bf16_t* Xs, const bf16_t* V, const bf16_t* yintra, const bf16_t* u, const float* dskip, bf16_t* gout, LAS unsigned char* L) {
    const int tid = tidv, lane = tid & 63, wave = __builtin_amdgcn_readfirstlane(tid >> 6), fr = lane & 15, fq = lane >> 4;
    for (int it = blockIdx.x; it < 256; it += gridDim.x) {
        const int g = it >> 2, cb = it & 3, colw = cb * 256 + wave * 32;
        bf16x8 Bf[2][4];
#pragma unroll
        for (int nt = 0; nt < 2; ++nt)
#pragma unroll
            for (int kk = 0; kk < 4; ++kk) { const int col = colw + nt * 16 + fr; Bf[nt][kk] = *(const bf16x8*)(Xs + ((size_t)col * 64 + g) * 128 + kk * 32 + fq * 8); }
        __syncthreads();
#pragma unroll
        for (int e = 0; e < 8; ++e) { const int idx = tid + e * 512, r = idx >> 4, c = idx & 15; *(LAS u32x4*)(L + r * 272 + c * 16) = *(const u32x4*)(V + ((size_t)g * 256 + r) * 128 + c * 8); }
        __syncthreads();
        const f32x4 ds = *(const f32x4*)(dskip + g * 16 + fq * 4);
        for (int hf = 0; hf < 2; ++hf) {
            f32x4 acc[8][2];
#pragma unroll
            for (int mt = 0; mt < 8; ++mt) { acc[mt][0] = (f32x4){0.f, 0.f, 0.f, 0.f}; acc[mt][1] = (f32x4){0.f, 0.f, 0.f, 0.f}; }
#pragma unroll
            for (int mt = 0; mt < 8; ++mt)
#pragma unroll
                for (int kk = 0; kk < 4; ++kk) { const bf16x8 Af = *(const LAS bf16x8*)(L + ((hf * 8 + mt) * 16 + fr) * 272 + kk * 64 + fq * 16);
                    acc[mt][0] = __builtin_amdgcn_mfma_f32_16x16x32_bf16(Af, Bf[0][kk], acc[mt][0], 0, 0, 0);
                    acc[mt][1] = __builtin_amdgcn_mfma_f32_16x16x32_bf16(Af, Bf[1][kk], acc[mt][1], 0, 0, 0); }
#pragma unroll
            for (int mt = 0; mt < 8; ++mt)
#pragma unroll
                for (int nt = 0; nt < 2; ++nt) { const int col = colw + nt * 16 + fr, t = hf * 8 + mt; const size_t o = ((size_t)col * 16 + t) * 1024 + g * 16 + fq * 4;
                    const f32x4 y = acc[mt][nt] + ld4bf(yintra + o) + ds * ld4bf(u + o); f32x4 r;
#pragma unroll
                    for (int i = 0; i < 4; ++i) r[i] = gelu_tanh(y[i]);
                    st4bf(gout + o, r); }
        }
    }
}

__global__ void __launch_bounds__(512, 2) mega(Args a) {
    extern __shared__ __attribute__((aligned(16))) unsigned char lds_raw[];
    LAS unsigned char* L = (LAS unsigned char*)lds_raw;
    cg::grid_group grid = cg::this_grid();
    unsigned char* ws = a.ws;
    const float* x_in = a.in[0]; float* out = a.out;
    const float* norm_pre = a.in[4]; const float* norm_post = a.in[5];
    const float* mod = (const float*)(ws + WS_MOD);
    bf16_t* H = (bf16_t*)(ws + WS_H); bf16_t* F = (bf16_t*)(ws + WS_F); bf16_t* ACT = (bf16_t*)(ws + WS_ACT);
    const int G = gridDim.x, bx = blockIdx.x;
#define MODP(l, s) (mod + (size_t)(l) * 8 * 9216 + (s) * 3072)
#define NPRE(l, s) (norm_pre + ((l) * 3 + (s)) * 1024)
#define NPOST(l, s) (norm_post + ((l) * 3 + (s)) * 1024)
    for (int ph = a.ph_lo; ph < a.ph_hi; ++ph) {
        int tidv = threadIdx.x; asm volatile("" : "+v"(tidv));
        switch (ph) {
        case 0: p0_phase(tidv, a, L); break;
        case 1: r_phase<false, true>(tidv, x_in, nullptr, nullptr, H, nullptr, nullptr, 0.f, NPRE(0, 0), MODP(0, 0)); break;
        case 4: r_phase<true, true>(tidv, x_in, F, out, H, NPOST(0, 0), MODP(0, 0), 0.5f, NPRE(0, 1), MODP(0, 1)); break;
        case 8: case 11: case 14: case 20: {
            int lp, sp, ln, sn; float rw;
            if (ph == 8) { lp = 0; sp = 1; ln = 0; sn = 2; rw = 1.0f; } else if (ph == 11) { lp = 0; sp = 2; ln = 1; sn = 0; rw = 0.5f; }
            else if (ph == 14) { lp = 1; sp = 0; ln = 1; sn = 1; rw = 0.5f; } else { lp = 1; sp = 1; ln = 1; sn = 2; rw = 1.0f; }
            r_phase<true, true>(tidv, out, F, out, H, NPOST(lp, sp), MODP(lp, sp), rw, NPRE(ln, sn), MODP(ln, sn)); } break;
        case 23: r_phase<true, false>(tidv, out, F, out, nullptr, NPOST(1, 2), MODP(1, 2), 0.5f, nullptr, nullptr); break;
        case 2: case 9: case 12: case 21: {
            const int w = (ph == 2) ? 0 : (ph == 9) ? 1 : (ph == 12) ? 2 : 3;
            pg8::Gemm g{H, (const bf16_t*)(ws + WS_WIN) + (size_t)w * 5632 * 1024, T_, 2 * DFF, D_}; pg8::StaticOrder S; S.init(T_, 2 * DFF, G, bx);
            EpiGated<0> E{ACT, DFF}; pg8::gemm_phase<EpiGated<0>, pg8::StaticOrder, true, true>(L, g, S, E, tidv); } break;
        case 3: case 10: case 13: case 22: case 5: case 7: case 15: {
            pg8::Gemm g; EpiPlain E;
            if (ph == 5) { g = pg8::Gemm{H, (const bf16_t*)(ws + WS_ABIN), T_, 1536, D_}; E = EpiPlain{(bf16_t*)(ws + WS_Z), 1536, 2}; }
            else if (ph == 7) { g = pg8::Gemm{(const bf16_t*)(ws + WS_YCAT), (const bf16_t*)(ws + WS_ABOUT), T_, D_, D_}; E = EpiPlain{F, D_, 1 << 30}; }
            else if (ph == 15) { g = pg8::Gemm{H, (const bf16_t*)(ws + WS_SSMIN), T_, D_, D_}; E = EpiPlain{(bf16_t*)(ws + WS_U), D_, 1 << 30}; }
            else { const int w = (ph == 3) ? 0 : (ph == 10) ? 1 : (ph == 13) ? 2 : 3;
                g = pg8::Gemm{ACT, (const bf16_t*)(ws + WS_WOUT) + (size_t)w * 1024 * 2816, T_, D_, DFF}; E = EpiPlain{F, D_, 1 << 30}; }
            pg8::StaticOrder S; S.init(g.M, g.N, G, bx);
            pg8::gemm_phase<EpiPlain, pg8::StaticOrder, true, true>(L, g, S, E, tidv); } break;
        case 6: mix0_phase(tidv, (const bf16_t*)(ws + WS_Z), (const bf16_t*)(ws + WS_SMALL), a.in[10], a.in[11], a.in[12], (const bf16_t*)(ws + WS_SMALL) + 65536, a.in[14], (bf16_t*)(ws + WS_YCAT), L); break;
        case 16: s1_phase(tidv, (const bf16_t*)(ws + WS_U), (const bf16_t*)(ws + WS_MW), (bf16_t*)(ws + WS_YI), (float*)(ws + WS_SST), L); break;
        case 17: s2_phase(tidv, (const float*)(ws + WS_SST), (const float*)(ws + WS_LAML), (bf16_t*)(ws + WS_XS)); break;
        case 18: s3_phase(tidv, (const bf16_t*)(ws + WS_XS), (const bf16_t*)(ws + WS_V), (const bf16_t*)(ws + WS_YI), (const bf16_t*)(ws + WS_U), a.in[23], (bf16_t*)(ws + WS_G), L); break;
        case 19: { pg8::Gemm g{(const bf16_t*)(ws + WS_G), (const bf16_t*)(ws + WS_GLU), T_, 2 * D_, D_}; pg8::StaticOrder S; S.init(T_, 2 * D_, G, bx);
            EpiGated<1> E{F, D_}; pg8::gemm_phase<EpiGated<1>, pg8::StaticOrder, true, true>(L, g, S, E, tidv); } break;
        default: break;
        }
        if (ph + 1 < a.ph_hi) grid.sync();
    }
}

extern "C" void kernel_launch(void* const* d_in, const int* in_sizes, int n_in, void* d_out, int out_size, void* d_ws, size_t ws_size, hipStream_t stream) {
    static int grid = 0;
    if (grid == 0) {
        if (n_in != 26 || in_sizes[0] != T_ * D_ || out_size != T_ * D_ || ws_size < WS_END) { fprintf(stderr, "kernel_launch: unexpected shapes (n_in %d, in0 %d, out %d, ws %zu)\n", n_in, n_in > 0 ? in_sizes[0] : -1, out_size, ws_size); grid = -1; return; }
        int dev = 0, cus = 0, per_cu = 0;
        if (hipGetDevice(&dev) != hipSuccess || hipDeviceGetAttribute(&cus, hipDeviceAttributeMultiprocessorCount, dev) != hipSuccess) { grid = -1; return; }
        if (hipFuncSetAttribute((const void*)mega, hipFuncAttributeMaxDynamicSharedMemorySize, LDS_BYTES) != hipSuccess) { fprintf(stderr, "kernel_launch: hipFuncSetAttribute failed\n"); grid = -1; return; }
        if (hipOccupancyMaxActiveBlocksPerMultiprocessor(&per_cu, (const void*)mega, 512, LDS_BYTES) != hipSuccess || per_cu < 1) { fprintf(stderr, "kernel_launch: occupancy query gave %d\n", per_cu); per_cu = 1; (void)hipGetLastError(); }
        grid = cus * per_cu;
    }
    if (grid < 0) return;
    (void)hipMemsetAsync((char*)d_ws + WS_MOD, 0, 2 * 8 * 9216 * sizeof(float), stream);
    Args a{};
    for (int i = 0; i < 26; ++i) a.in[i] = (const float*)d_in[i];
    a.out = (float*)d_out; a.ws = (unsigned char*)d_ws;
#if MK_PER_PHASE
    for (int ph = 0; ph < NPH; ++ph) { a.ph_lo = ph; a.ph_hi = ph + 1; hipLaunchKernelGGL(mega, dim3(grid), dim3(512), LDS_BYTES, stream, a); }
#else
    a.ph_lo = 0; a.ph_hi = NPH;
    void* args[] = {&a};
    hipError_t e = hipLaunchCooperativeKernel((const void*)mega, dim3(grid), dim3(512), args, LDS_BYTES, stream);
    if (e != hipSuccess) fprintf(stderr, "kernel_launch: cooperative launch failed: %s (grid %d)\n", hipGetErrorString(e), grid);
#endif
}
```

```cpp
#include <hip/hip_runtime.h>
#include <hip/hip_cooperative_groups.h>
#include <cstdio>
#include <cstdint>
namespace cg = cooperative_groups;
namespace pg8 {
#define PG8_LAS __attribute__((address_space(3)))
typedef unsigned short bf16_t;
typedef short bf16x8 __attribute__((ext_vector_type(8)));
typedef float f32x4 __attribute__((ext_vector_type(4)));
typedef unsigned u32x4 __attribute__((ext_vector_type(4)));
constexpr int BM = 256, BK = 64, HALF = 128, HTB = HALF * BK * 2  , STAGE_BYTES = 8 * HTB, NXCD = 8, WGM = 8;

__host__ __device__ __forceinline__ int lds_byte(int r, int c) { const int st = (r >> 4) * 2 + (c >> 5), rr = r & 15, cc = c & 31, ob = rr * 64 + cc * 2; return st * 1024 + (ob ^ (((ob >> 9) & 1) << 5)); }
__host__ __device__ __forceinline__ void stage_rc(int b, int& R, int& C) { const int st = b / 1024, sb = b % 1024, swz = sb ^ (((sb >> 9) & 1) << 5); R = (st >> 1) * 16 + swz / 64; C = (st & 1) * 32 + (swz % 64) / 2; }
__host__ __device__ __forceinline__ int perm32(int rho) { const int n = rho >> 4, i = rho & 15; return 8 * (i >> 2) + 4 * n + (i & 3); }

struct Unit { int pm, pn; };
struct Gemm { const bf16_t* A; const bf16_t* Bt; int M, N, K; };

struct StaticOrder {
    int nM, nN, nwg, G, c;
    __host__ __device__ void init(int M, int N, int G_, int c_) { nM = M / BM; nN = N / BM; nwg = nM * nN; G = G_; c = c_; }
    __host__ __device__ bool next(int i, Unit& u) const {
        const long L = (long)i * G + c; if (L >= nwg) return false;
        int wgid = (int)L; { const int q = nwg / NXCD, r = nwg % NXCD, xcd = wgid % NXCD, off = wgid / NXCD; wgid = (xcd < r ? xcd * (q + 1) : r * (q + 1) + (xcd - r) * q) + off; }
        const int nig = WGM * nN, gid = wgid / nig, fm = gid * WGM, gsz = (nM - fm) < WGM ? (nM - fm) : WGM;
        u.pm = fm + ((wgid % nig) % gsz); u.pn = (wgid % nig) / gsz; return true;
    }
    __device__ __forceinline__ void a_ready(const Unit&) const {}
    __device__ __forceinline__ void done(const Unit&) const {}
};

__device__ __forceinline__ unsigned cvt_pk_bf16(float lo, float hi) { unsigned r; asm volatile("v_cvt_pk_bf16_f32 %0, %1, %2" : "=v"(r) : "v"(lo), "v"(hi)); return r; }
typedef float f32x2 __attribute__((ext_vector_type(2)));
template <class Epi, class Sched, bool ALIGN_EPI = false, bool SP2 = false>
__device__ __forceinline__ void gemm_phase(PG8_LAS unsigned char* lds, const Gemm g, const Sched& S, const Epi& E, const int tid_in) {
    const int tid = tid_in, wid = __builtin_amdgcn_readfirstlane(tid >> 6), lane = tid & 63, wr = wid >> 2, wc = wid & 3, fr = lane & 15, fq = lane >> 4;
    const int K = g.K, nt = K / BK;
    unsigned voffA[2], voffB[2];
#pragma unroll
    for (int i = 0; i < 2; ++i) { int R, C; stage_rc(tid * 16 + i * 8192, R, C); const int Rb = Epi::PERM ? ((R & ~31) + perm32(R & 31)) : R;
        voffA[i] = (unsigned)(R * K + C) * 2u; voffB[i] = (unsigned)(Rb * K + C) * 2u; }
    const size_t kstep = (size_t)(BK * 2);
    const size_t hstep = (size_t)HALF * K * 2;
    const size_t tstep = 2 * hstep;
    const unsigned ldsw = (unsigned)wid * 1024u;
    const int aoff = lds_byte(wr * 64 + fr, fq * 8), boff = lds_byte(wc * 32 + fr, fq * 8);
#define PG8_SA(b, h) (((b) * 2 + (h)) * HTB)
#define PG8_SB(b, h) ((4 + (b) * 2 + (h)) * HTB)
#define PG8_STAGE(bufoff, gbase, voff) do { _Pragma("unroll") for (int _i = 0; _i < 2; ++_i) \
        __builtin_amdgcn_global_load_lds((const unsigned*)((const char*)(gbase) + (voff)[_i]), (PG8_LAS unsigned*)(lds + (bufoff) + ldsw + _i * 8192), 16, 0, 0); } while (0)
#define PG8_LDA(dst, b, h) do { _Pragma("unroll") for (int m = 0; m < 4; ++m) _Pragma("unroll") for (int k = 0; k < 2; ++k) dst[m][k] = *(const PG8_LAS bf16x8*)(lds + PG8_SA(b, h) + aoff + m * 2048 + k * 1024); } while (0)
#define PG8_LDB(dst, b, h) do { _Pragma("unroll") for (int n = 0; n < 2; ++n) _Pragma("unroll") for (int k = 0; k < 2; ++k) dst[n][k] = *(const PG8_LAS bf16x8*)(lds + PG8_SB(b, h) + boff + n * 2048 + k * 1024); } while (0)
#define PG8_MMA(ai, bj, At, Bt) do { __builtin_amdgcn_s_setprio(1); _Pragma("unroll") for (int m = 0; m < 4; ++m) _Pragma("unroll") for (int n = 0; n < 2; ++n) _Pragma("unroll") for (int k = 0; k < 2; ++k) \
        acc[ai][bj][m][n] = __builtin_amdgcn_mfma_f32_16x16x32_bf16(Bt[n][k], At[m][k], acc[ai][bj][m][n], 0, 0, 0); __builtin_amdgcn_s_setprio(0); } while (0)
#define PG8_WAIT_V(n) asm volatile("s_waitcnt vmcnt(" #n ")" ::: "memory")
#define PG8_WAIT_L(n) asm volatile("s_waitcnt lgkmcnt(" #n ")" ::: "memory")
#define PG8_BAR __builtin_amdgcn_s_barrier()
#define PG8_SCHED __builtin_amdgcn_sched_barrier(0)
    Unit cur, nxt; int ui = 0;
    if (!S.next(0, cur)) return;
    f32x4 acc[2][2][4][2];
#pragma unroll
    for (int a = 0; a < 2; ++a)
#pragma unroll
        for (int b = 0; b < 2; ++b)
#pragma unroll
            for (int m = 0; m < 4; ++m)
#pragma unroll
                for (int n = 0; n < 2; ++n) acc[a][b][m][n] = (f32x4){0.f, 0.f, 0.f, 0.f};
    bf16x8 At[4][2], B0[2][2], B1[2][2];
    const char* cA = (const char*)g.A + (size_t)cur.pm * tstep; const char* cB = (const char*)g.Bt + (size_t)cur.pn * tstep;
    S.a_ready(cur);
    if constexpr (SP2) {
        PG8_STAGE(PG8_SB(0, 0), cB, voffB); PG8_STAGE(PG8_SB(0, 1), cB + hstep, voffB); PG8_STAGE(PG8_SA(0, 0), cA, voffA); PG8_STAGE(PG8_SA(0, 1), cA + hstep, voffA);
        if (wr == 1) PG8_BAR;
        PG8_WAIT_V(2); PG8_BAR;
        PG8_STAGE(PG8_SB(1, 0), cB + kstep, voffB); PG8_STAGE(PG8_SA(1, 0), cA + kstep, voffA); PG8_STAGE(PG8_SB(1, 1), cB + hstep + kstep, voffB);
        PG8_WAIT_V(6); PG8_BAR;
    } else {
        PG8_STAGE(PG8_SB(0, 0), cB, voffB); PG8_STAGE(PG8_SA(0, 0), cA, voffA); PG8_STAGE(PG8_SB(0, 1), cB + hstep, voffB); PG8_STAGE(PG8_SA(0, 1), cA + hstep, voffA);
        if (wr == 1) PG8_BAR;
        PG8_WAIT_V(4); PG8_BAR;
        PG8_STAGE(PG8_SB(1, 0), cB + kstep, voffB); PG8_STAGE(PG8_SA(1, 0), cA + kstep, voffA); PG8_STAGE(PG8_SB(1, 1), cB + hstep + kstep, voffB);
        PG8_WAIT_V(6); PG8_BAR;
    }
    for (;;) {
        const bool has_next = S.next(ui + 1, nxt);
        const char* nA = has_next ? (const char*)g.A + (size_t)nxt.pm * tstep : cA; const char* nB = has_next ? (const char*)g.Bt + (size_t)nxt.pn * tstep : cB;
        for (int t = 0; t < nt; t += 2) {
            const bool last = (t == nt - 2);
            const char* a1 = cA + (size_t)(t + 1) * kstep;
            const char* a2 = last ? nA : cA + (size_t)(t + 2) * kstep; const char* b2 = last ? nB : cB + (size_t)(t + 2) * kstep;
            const char* a3 = a2 + kstep; const char* b3 = b2 + kstep;
            if (last && has_next) S.a_ready(nxt);
            if constexpr (SP2) {
            PG8_LDB(B0, 0, 0); PG8_LDB(B1, 0, 1); PG8_SCHED; PG8_LDA(At, 0, 0); PG8_STAGE(PG8_SA(1, 1), a1 + hstep, voffA);
            PG8_WAIT_V(8); PG8_WAIT_L(0); PG8_BAR; PG8_MMA(0, 0, At, B0); PG8_MMA(0, 1, At, B1); PG8_BAR; PG8_SCHED;
            PG8_LDA(At, 0, 1); PG8_STAGE(PG8_SB(0, 0), b2, voffB); PG8_STAGE(PG8_SB(0, 1), b2 + hstep, voffB); PG8_STAGE(PG8_SA(0, 0), a2, voffA);
            PG8_WAIT_V(8); PG8_WAIT_L(0); PG8_BAR; PG8_MMA(1, 0, At, B0); PG8_MMA(1, 1, At, B1); PG8_BAR; PG8_SCHED;
            PG8_LDB(B0, 1, 0); PG8_LDB(B1, 1, 1); PG8_SCHED; PG8_LDA(At, 1, 0); PG8_STAGE(PG8_SA(0, 1), a2 + hstep, voffA);
            PG8_WAIT_V(8); PG8_WAIT_L(0); PG8_BAR; PG8_MMA(0, 0, At, B0); PG8_MMA(0, 1, At, B1); PG8_BAR; PG8_SCHED;
            PG8_LDA(At, 1, 1); PG8_STAGE(PG8_SB(1, 0), b3, voffB); PG8_STAGE(PG8_SB(1, 1), b3 + hstep, voffB); PG8_STAGE(PG8_SA(1, 0), a3, voffA);
            PG8_WAIT_V(8); PG8_WAIT_L(0); PG8_BAR; PG8_MMA(1, 0, At, B0); PG8_MMA(1, 1, At, B1); PG8_BAR; PG8_SCHED;
            } else {
            PG8_LDB(B0, 0, 0); PG8_SCHED; PG8_LDA(At, 0, 0); PG8_STAGE(PG8_SA(1, 1), a1 + hstep, voffA);
            PG8_WAIT_L(8); PG8_BAR; PG8_WAIT_L(0); PG8_MMA(0, 0, At, B0); PG8_BAR; PG8_SCHED;
            PG8_LDB(B1, 0, 1); PG8_STAGE(PG8_SB(0, 0), b2, voffB);
            PG8_BAR; PG8_WAIT_L(0); PG8_MMA(0, 1, At, B1); PG8_BAR;
            PG8_LDA(At, 0, 1); PG8_STAGE(PG8_SA(0, 0), a2, voffA);
            PG8_BAR; PG8_WAIT_L(0); PG8_MMA(1, 0, At, B0); PG8_BAR; PG8_SCHED;
            PG8_STAGE(PG8_SB(0, 1), b2 + hstep, voffB);
            PG8_WAIT_V(6); PG8_BAR; PG8_MMA(1, 1, At, B1); PG8_BAR;
            PG8_LDB(B0, 1, 0); PG8_SCHED; PG8_LDA(At, 1, 0); PG8_STAGE(PG8_SA(0, 1), a2 + hstep, voffA);
            PG8_WAIT_L(8); PG8_BAR; PG8_WAIT_L(0); PG8_MMA(0, 0, At, B0); PG8_BAR; PG8_SCHED;
            PG8_LDB(B1, 1, 1); PG8_STAGE(PG8_SB(1, 0), b3, voffB);
            PG8_BAR; PG8_WAIT_L(0); PG8_MMA(0, 1, At, B1); PG8_BAR;
            PG8_LDA(At, 1, 1); PG8_STAGE(PG8_SA(1, 0), a3, voffA);
            PG8_BAR; PG8_WAIT_L(0); PG8_MMA(1, 0, At, B0); PG8_BAR; PG8_SCHED;
            PG8_STAGE(PG8_SB(1, 1), b3 + hstep, voffB);
            PG8_WAIT_V(6); PG8_BAR; PG8_MMA(1, 1, At, B1); PG8_BAR;
            }
        }
        if constexpr (ALIGN_EPI) { if (wr == 0) PG8_BAR; }
        if constexpr (!Epi::AFTER_DRAIN) { E(acc, cur, wr, wc, fr, fq); S.done(cur); }
        if (!has_next) break;
#pragma unroll
        for (int a = 0; a < 2; ++a)
#pragma unroll
            for (int b = 0; b < 2; ++b)
#pragma unroll
                for (int m = 0; m < 4; ++m)
#pragma unroll
                    for (int n = 0; n < 2; ++n) acc[a][b][m][n] = (f32x4){0.f, 0.f, 0.f, 0.f};
        cur = nxt; cA = nA; cB = nB; ++ui;
        if constexpr (ALIGN_EPI) { if (wr == 1) PG8_BAR; }
    }
    PG8_WAIT_V(0);
    if constexpr (!ALIGN_EPI) { if (wr == 0) PG8_BAR; }
    PG8_BAR;
    if constexpr (Epi::AFTER_DRAIN) { E.fused(acc, cur, wr, wc, fr, fq, lds, wid, lane); S.done(cur); }
#undef PG8_SA
#undef PG8_SB
#undef PG8_STAGE
#undef PG8_LDA
#undef PG8_LDB
#undef PG8_MMA
#undef PG8_WAIT_V
#undef PG8_WAIT_L
#undef PG8_BAR
#undef PG8_SCHED
}
}
using pg8::bf16_t; using pg8::bf16x8; using pg8::f32x4; using pg8::u32x4; using pg8::cvt_pk_bf16; using pg8::f32x2;
#define LAS __attribute__((address_space(3)))
typedef unsigned u32x2 __attribute__((ext_vector_type(2)));
#define XB_TMO      128
#define XB_XCNT(j)  (256  + 64 * (j))
#define XB_XSUB(j)  (1280 + 64 * (j))
#define XB_XGEN(j)  (2304 + 64 * (j))
#define XB_TOP      3328
#define XB_TOPGEN   3392
#define XCD_BAR_WORDS 3456
#define XB_SPIN_CAP (1u << 18)

__device__ __forceinline__ unsigned xb_ld(unsigned* p)              { return __hip_atomic_load(p, __ATOMIC_RELAXED, __HIP_MEMORY_SCOPE_AGENT); }
__device__ __forceinline__ unsigned xb_add(unsigned* p, unsigned v) { return __hip_atomic_fetch_add(p, v, __ATOMIC_RELAXED, __HIP_MEMORY_SCOPE_AGENT); }
__device__ __forceinline__ unsigned xb_xcc_id() { return (unsigned)__builtin_amdgcn_s_getreg((3 << 11) | 20) & 0xFu; }
#define XB_SPIN(cond, bar) do { unsigned _sp = 0; while (cond) { __builtin_amdgcn_s_sleep(1); \
    if ((++_sp & 255u) == 0u) { if (xb_ld(&(bar)[XB_TMO])) break; if (_sp > XB_SPIN_CAP) { atomicAdd(&(bar)[XB_TMO], 1u); break; } } } } while (0)

struct XcdBarrier {
    unsigned* bar; unsigned x;
    volatile LAS unsigned* st;
};

__device__ __forceinline__ XcdBarrier xcd_barrier_post(unsigned* bar, volatile LAS unsigned* st) {
    XcdBarrier b; b.bar = bar; b.x = xb_xcc_id(); b.st = st;
    if (threadIdx.x == 0) (void)xb_add(&bar[XB_XCNT(b.x)], 1u);
    return b;
}
__device__ __forceinline__ void xcd_barrier_complete(unsigned* bar, unsigned x, unsigned& nloc, unsigned& nx) {
    const unsigned G = gridDim.x * gridDim.y * gridDim.z;
    unsigned sum, cnt, mine, sp = 0u;
    for (;;) {
        sum = 0u; cnt = 0u; mine = 0u;
#pragma unroll
        for (unsigned j = 0; j < 16; ++j) { const unsigned c = xb_ld(&bar[XB_XCNT(j)]); sum += c; cnt += (c > 0u) ? 1u : 0u; mine = (j == x) ? c : mine; }
        if (sum == G) break;
        __builtin_amdgcn_s_sleep(1);
        if ((++sp & 255u) == 0u) { if (xb_ld(&bar[XB_TMO])) break; if (sp > XB_SPIN_CAP) { atomicAdd(&bar[XB_TMO], 1u); break; } }
    }
    nloc = mine > 0u ? mine : 1u; nx = cnt > 0u ? cnt : 1u;
}

__device__ __forceinline__ void xcd_barrier(const XcdBarrier& b) {
    asm volatile("s_waitcnt vmcnt(0)" ::: "memory");
    __syncthreads();
    if (threadIdx.x == 0) {
        unsigned* bar = b.bar;
        __builtin_amdgcn_s_waitcnt(0);
        unsigned nloc = b.st[0], nx = b.st[1];
        if (nloc == 0u) { xcd_barrier_complete(bar, b.x, nloc, nx); b.st[0] = nloc; b.st[1] = nx; }
        const unsigned old = xb_add(&bar[XB_XSUB(b.x)], 1u);
        const unsigned gen = old / nloc;
        if (old + 1u == (gen + 1u) * nloc) {
            __builtin_amdgcn_fence(__ATOMIC_RELEASE, "agent");
            asm volatile("s_waitcnt vmcnt(0)" ::: "memory");
            const unsigned og = xb_add(&bar[XB_TOP], 1u);
            const unsigned tg = og / nx;
            if (og + 1u == (tg + 1u) * nx) xb_add(&bar[XB_TOPGEN], 1u);
            else XB_SPIN(xb_ld(&bar[XB_TOPGEN]) == tg, bar);
            __builtin_amdgcn_fence(__ATOMIC_ACQUIRE, "agent");
            xb_add(&bar[XB_XGEN(b.x)], 1u);
            asm volatile("s_waitcnt vmcnt(0)" ::: "memory");
        } else {
            XB_SPIN(xb_ld(&bar[XB_XGEN(b.x)]) == gen, bar);
            __builtin_amdgcn_fence(__ATOMIC_ACQUIRE, "agent");
            asm volatile("s_waitcnt vmcnt(0)" ::: "memory");
        }
    }
    __syncthreads();
}


#ifndef MK_PER_PHASE
#define MK_PER_PHASE 0
#endif
#define PROBE_MASK 0u
#define PROBE_N 0
#define PROBE_SYNC 0

constexpr int T_ = 16384, D_ = 1024, DFF = 2816, SEQ = 2048;
constexpr float EPS = 1e-6f;
constexpr size_t MiB = 1u << 20;
constexpr size_t WS_MOD = 0, WS_BAR = 768 * 1024, WS_LAML = 1 * MiB, WS_MW = 2 * MiB, WS_V = 14 * MiB, WS_WIN = 18 * MiB, WS_WOUT = 62 * MiB, WS_ABIN = 84 * MiB,
                 WS_ABOUT = 87 * MiB, WS_SSMIN = 89 * MiB, WS_GLU = 91 * MiB, WS_SMALL = 95 * MiB, WS_H = 96 * MiB, WS_F = 128 * MiB, WS_ACT = 160 * MiB,
                 WS_END = 248 * MiB;
constexpr size_t WS_Z = WS_ACT, WS_YCAT = WS_ACT + 48 * MiB;
constexpr size_t WS_U = WS_ACT, WS_YI = WS_ACT + 32 * MiB, WS_XS = WS_ACT + 64 * MiB, WS_G = WS_H, WS_SST = WS_F;
constexpr int LDS_BYTES = 135168;
constexpr int NPH = 24;

struct Args { const float* in[26]; float* out; unsigned char* ws; int ph_lo, ph_hi; };

__device__ __forceinline__ float wave_sum(float v) {
#pragma unroll
    for (int o = 1; o < 64; o <<= 1) v += __shfl_xor(v, o);
    return v;
}
__device__ __forceinline__ float bf2f(unsigned b) { return __uint_as_float(b << 16); }
__device__ __forceinline__ unsigned f2bf(float f) { unsigned u = __float_as_uint(f); return (u + 0x7fffu + ((u >> 16) & 1u)) >> 16; }
__device__ __forceinline__ f32x4 ld4bf(const bf16_t* p) { const u32x2 v = *(const u32x2*)p; f32x4 r; r.x = __uint_as_float(v.x << 16); r.y = __uint_as_float(v.x & 0xffff0000u); r.z = __uint_as_float(v.y << 16); r.w = __uint_as_float(v.y & 0xffff0000u); return r; }
__device__ __forceinline__ void st4bf(bf16_t* p, f32x4 v) { u32x2 w; w.x = cvt_pk_bf16(v.x, v.y); w.y = cvt_pk_bf16(v.z, v.w); *(u32x2*)p = w; }
__device__ __forceinline__ float gelu_tanh(float x) { const float t = 1.5957691216f * (x + 0.044715f * x * x * x); return x * __builtin_amdgcn_rcpf(1.0f + __expf(-t)); }

template <int MODE> struct EpiGated {
    static constexpr bool PERM = true, AFTER_DRAIN = false;
    bf16_t* O; int ldc;
    __device__ __forceinline__ void operator()(const f32x4 (&acc)[2][2][4][2], const pg8::Unit& u, int wr, int wc, int fr, int fq) const {
        const int row0 = u.pm * 256 + wr * 64 + fr, col0 = u.pn * 128 + wc * 32 + 8 * fq;
#pragma unroll
        for (int ai = 0; ai < 2; ++ai)
#pragma unroll
            for (int m = 0; m < 4; ++m) {
                bf16_t* rowp = O + (size_t)(row0 + ai * 128 + m * 16) * ldc + col0;
                float v[8];
#pragma unroll
                for (int n = 0; n < 2; ++n)
#pragma unroll
                    for (int i = 0; i < 4; ++i) { const float a = acc[ai][0][m][n][i], b = acc[ai][1][m][n][i];
                        v[n * 4 + i] = (MODE == 0) ? a * b * __builtin_amdgcn_rcpf(1.0f + __expf(-a)) : a * __builtin_amdgcn_rcpf(1.0f + __expf(-b)); }
                u32x4 w; w.x = cvt_pk_bf16(v[0], v[1]); w.y = cvt_pk_bf16(v[2], v[3]); w.z = cvt_pk_bf16(v[4], v[5]); w.w = cvt_pk_bf16(v[6], v[7]);
                *(u32x4*)rowp = w;
            }
    }
};
struct EpiPlain {
    static constexpr bool PERM = true, AFTER_DRAIN = false;
    bf16_t* O; int ldc; int gelu_from;
    __device__ __forceinline__ void operator()(const f32x4 (&acc)[2][2][4][2], const pg8::Unit& u, int wr, int wc, int fr, int fq) const {
        const int row0 = u.pm * 256 + wr * 64 + fr, col0 = u.pn * 256 + wc * 32 + 8 * fq; const bool gl = u.pn >= gelu_from;
#pragma unroll
        for (int ai = 0; ai < 2; ++ai)
#pragma unroll
            for (int m = 0; m < 4; ++m) {
                bf16_t* rowp = O + (size_t)(row0 + ai * 128 + m * 16) * ldc + col0;
#pragma unroll
                for (int bj = 0; bj < 2; ++bj) { f32x4 v0 = acc[ai][bj][m][0], v1 = acc[ai][bj][m][1];
                    if (gl) {
#pragma unroll
                        for (int i = 0; i < 4; ++i) { v0[i] = gelu_tanh(v0[i]); v1[i] = gelu_tanh(v1[i]); } }
                    u32x4 w; w.x = cvt_pk_bf16(v0[0], v0[1]); w.y = cvt_pk_bf16(v0[2], v0[3]); w.z = cvt_pk_bf16(v1[0], v1[1]); w.w = cvt_pk_bf16(v1[2], v1[3]);
                    *(u32x4*)(rowp + bj * 128) = w; }
            }
    }
};

__device__ __forceinline__ void transpose_item(const float* W, int K, int N, bf16_t* WT, int mode, LAS float* scr, int item, int lane) {
    const int nblk = N / 32, kb = item / nblk, nb = item % nblk, k0 = 64 * kb, n0 = 32 * nb;
    int r0 = n0;
    if (mode) { const int half = N >> 1, hf = (n0 >= half) ? 1 : 0, j = n0 - hf * half; r0 = (j >> 7) * 256 + hf * 128 + (j & 127); }
#pragma unroll 8
    for (int i = 0; i < 32; ++i) { const int kk = 2 * i + (lane >> 5); scr[kk * 33 + (lane & 31)] = W[(size_t)(k0 + kk) * N + n0 + (lane & 31)]; }
    asm volatile("s_waitcnt lgkmcnt(0)" ::: "memory");
    const int c = lane & 7;
#pragma unroll
    for (int j = 0; j < 4; ++j) { const int n = (lane >> 3) + 8 * j; const LAS float* s = scr + (8 * c) * 33 + n;
        u32x4 o; o.x = cvt_pk_bf16(s[0 * 33], s[1 * 33]); o.y = cvt_pk_bf16(s[2 * 33], s[3 * 33]); o.z = cvt_pk_bf16(s[4 * 33], s[5 * 33]); o.w = cvt_pk_bf16(s[6 * 33], s[7 * 33]);
        *(u32x4*)(WT + (size_t)(r0 + n) * K + k0 + 8 * c) = o; }
    asm volatile("s_waitcnt lgkmcnt(0)" ::: "memory");
}

__device__ __forceinline__ void ssm_precompute(const int tidv, int g, const float* lam_re, const float* lam_im, const float* b_re, const float* b_im, const float* c_re, const float* c_im,
                                               const float* log_dt, bf16_t* MW, bf16_t* V, float* lamL, LAS unsigned char* L) {
    LAS float* pw = (LAS float*)L;
    LAS float* Bb = pw + 17 * 64 * 2;
    LAS float* Cc = Bb + 2048;
    LAS float* Kk = Cc + 2048;
    const int tid = tidv;
    const float dt = expf(log_dt[g]);
    for (int idx = tid; idx < 17 * 64; idx += 512) { const int j = idx >> 6, p = idx & 63; const float lr = lam_re[g * 64 + p], li = lam_im[g * 64 + p];
        const float mag = expf((float)j * dt * lr); double rev = (double)j * (double)dt * (double)li * 0.15915494309189535; rev -= rint(rev);
        const float ang = (float)(rev * 6.283185307179586); pw[idx * 2] = mag * __cosf(ang); pw[idx * 2 + 1] = mag * __sinf(ang); }
    for (int idx = tid; idx < 1024; idx += 512) { const int p = idx >> 4; const float lr = lam_re[g * 64 + p], li = lam_im[g * 64 + p];
        const float mag = expf(dt * lr); double rev = (double)dt * (double)li * 0.15915494309189535; rev -= rint(rev); const float ang = (float)(rev * 6.283185307179586);
        const float er = mag * __cosf(ang) - 1.0f, ei = mag * __sinf(ang);
        const float den = 1.0f / (lr * lr + li * li); const float qr = (er * lr + ei * li) * den, qi = (ei * lr - er * li) * den;
        const float br = b_re[g * 1024 + idx], bi = b_im[g * 1024 + idx];
        Bb[idx * 2] = qr * br - qi * bi; Bb[idx * 2 + 1] = qr * bi + qi * br; }
    for (int idx = tid; idx < 1024; idx += 512) { Cc[idx * 2] = c_re[g * 1024 + idx]; Cc[idx * 2 + 1] = c_im[g * 1024 + idx]; }
    __syncthreads();
    for (int idx = tid; idx < 4096; idx += 512) { const int j = idx >> 8, n = (idx >> 4) & 15, m = idx & 15; float s = 0.f;
        for (int p = 0; p < 64; ++p) { const float cr = Cc[(n * 64 + p) * 2], ci = Cc[(n * 64 + p) * 2 + 1], pr = pw[(j * 64 + p) * 2], pi = pw[(j * 64 + p) * 2 + 1];
            const float xr = cr * pr - ci * pi, xi = cr * pi + ci * pr; s += xr * Bb[(p * 16 + m) * 2] - xi * Bb[(p * 16 + m) * 2 + 1]; }
        Kk[idx] = s; }
    __syncthreads();
    bf16_t* MWg = MW + (size_t)g * 384 * 256; bf16_t* Vg = V + (size_t)g * 256 * 128;
    for (int q = tid; q < 32768; q += 512) { const int row = q >> 7, c2 = (q & 127) * 2; const int t = row >> 4, n = row & 15, s = c2 >> 4, m = c2 & 15;
        float v0 = 0.f, v1 = 0.f; if (s <= t) { v0 = Kk[((t - s) * 16 + n) * 16 + m]; v1 = Kk[((t - s) * 16 + n) * 16 + m + 1]; }
        *(unsigned*)(MWg + row * 256 + c2) = cvt_pk_bf16(v0, v1); }
    for (int q = tid; q < 16384; q += 512) { const int r = q >> 7, c2 = (q & 127) * 2; const int p = r >> 1, ri = r & 1, s = c2 >> 4, m = c2 & 15;
        const float pr = pw[((15 - s) * 64 + p) * 2], pi = pw[((15 - s) * 64 + p) * 2 + 1]; float v[2];
#pragma unroll
        for (int e = 0; e < 2; ++e) { const float br = Bb[(p * 16 + m + e) * 2], bi = Bb[(p * 16 + m + e) * 2 + 1]; v[e] = ri ? (pr * bi + pi * br) : (pr * br - pi * bi); }
        *(unsigned*)(MWg + (256 + r) * 256 + c2) = cvt_pk_bf16(v[0], v[1]); }
    for (int q = tid; q < 16384; q += 512) { const int row = q >> 6, p = q & 63; const int t = row >> 4, n = row & 15;
        const float cr = Cc[(n * 64 + p) * 2], ci = Cc[(n * 64 + p) * 2 + 1], pr = pw[((t + 1) * 64 + p) * 2], pi = pw[((t + 1) * 64 + p) * 2 + 1];
        *(unsigned*)(Vg + row * 128 + 2 * p) = cvt_pk_bf16(cr * pr - ci * pi, -(cr * pi + ci * pr)); }
    if (tid < 64) { lamL[(g * 64 + tid) * 2] = pw[(16 * 64 + tid) * 2]; lamL[(g * 64 + tid) * 2 + 1] = pw[(16 * 64 + tid) * 2 + 1]; }
}

__device__ __forceinline__ void p0_phase(const int tidv, const Args& a, LAS unsigned char* L, const bool do_mod) {
    const int tid = tidv, lane = tid & 63, wave = __builtin_amdgcn_readfirstlane(tid >> 6), G = gridDim.x, bx = blockIdx.x;
    unsigned char* ws = a.ws;
    for (int g = bx; g < 64; g += G) {
        ssm_precompute(tidv, g, a.in[17], a.in[18], a.in[19], a.in[20], a.in[21], a.in[22], a.in[24], (bf16_t*)(ws + WS_MW), (bf16_t*)(ws + WS_V), (float*)(ws + WS_LAML), L);
        __syncthreads(); }
    { bf16_t* pwt = (bf16_t*)(ws + WS_SMALL); bf16_t* sgw = pwt + 65536; const float* pool_w = a.in[9]; const float* sgu_w = a.in[13];
      for (int i = bx * 512 + tid; i < 65536; i += G * 512) { const int gg = i >> 14, o = (i >> 7) & 127, ii = i & 127;
          pwt[i] = (bf16_t)f2bf(pool_w[(gg * 128 + ii) * 128 + o]); sgw[i] = (ii <= o) ? (bf16_t)f2bf(sgu_w[i]) : (bf16_t)0; } }
    { LAS float* cond = (LAS float*)L; const float* c = a.in[1];
      for (int i = tid; i < 8192; i += 512) { const float v = c[i]; cond[i] = v / (1.0f + __expf(-v)); }
      __syncthreads();
      float* mod = (float*)(ws + WS_MOD); const float* ada_w = a.in[2]; const float* ada_b = a.in[3];
      if (do_mod) for (int it = bx; it < 1152; it += G) { const int l = it / 576, r = it % 576, jc = r >> 5, kc = r & 31; const int j = jc * 512 + tid;
          float acc[8];
#pragma unroll
          for (int b = 0; b < 8; ++b) acc[b] = 0.f;
          const float* wp = ada_w + ((size_t)l * 1024 + kc * 32) * 9216 + j;
#pragma unroll 8
          for (int kk = 0; kk < 32; ++kk) { const float w = wp[(size_t)kk * 9216];
#pragma unroll
              for (int b = 0; b < 8; ++b) acc[b] += cond[b * 1024 + kc * 32 + kk] * w; }
          const float bias = (kc == 0) ? ada_b[l * 9216 + j] : 0.f;
#pragma unroll
          for (int b = 0; b < 8; ++b) atomicAdd(mod + ((size_t)l * 8 + b) * 9216 + j, acc[b] + bias); }
      __syncthreads(); }
    { LAS float* scr = (LAS float*)(L + wave * 8448); const int gw = bx * 8 + wave, NGW = G * 8;
      constexpr int I_IN = 16 * 176, I_OUT = 44 * 32, I_ABIN = 16 * 48, I_SQ = 16 * 32, I_GLU = 16 * 64;
      constexpr int NIT = 4 * I_IN + 4 * I_OUT + I_ABIN + 2 * I_SQ + I_GLU;
      for (int it = gw; it < NIT; it += NGW) { int r = it;
          if (r < 4 * I_IN) { const int w = r / I_IN; transpose_item(a.in[6] + (size_t)w * 1024 * 5632, 1024, 5632, (bf16_t*)(ws + WS_WIN) + (size_t)w * 5632 * 1024, 1, scr, r % I_IN, lane); continue; } r -= 4 * I_IN;
          if (r < 4 * I_OUT) { const int w = r / I_OUT; transpose_item(a.in[7] + (size_t)w * 2816 * 1024, 2816, 1024, (bf16_t*)(ws + WS_WOUT) + (size_t)w * 1024 * 2816, 0, scr, r % I_OUT, lane); continue; } r -= 4 * I_OUT;
          if (r < I_ABIN) { transpose_item(a.in[8], 1024, 1536, (bf16_t*)(ws + WS_ABIN), 0, scr, r, lane); continue; } r -= I_ABIN;
          if (r < I_SQ) { transpose_item(a.in[15], 1024, 1024, (bf16_t*)(ws + WS_ABOUT), 0, scr, r, lane); continue; } r -= I_SQ;
          if (r < I_SQ) { transpose_item(a.in[16], 1024, 1024, (bf16_t*)(ws + WS_SSMIN), 0, scr, r, lane); continue; } r -= I_SQ;
          transpose_item(a.in[25], 1024, 2048, (bf16_t*)(ws + WS_GLU), 1, scr, r, lane); } }
}

template <bool HAS_PREV, bool HAS_NEXT>
__device__ __forceinline__ void r_phase(const int tidv, const float* xin, const bf16_t* f, float* xout, bf16_t* h, const float* gpost, const float* modprev, float rw, const float* gpre, const float* modnext) {
    const int tid = tidv, lane = tid & 63, wave = tid >> 6; const int gw = blockIdx.x * 8 + wave, NGW = gridDim.x * 8;
    for (int rb = gw; rb < T_ / 8; rb += NGW) {
        const int r0 = rb * 8, b = r0 / SEQ;
        f32x4 A1[4], A2[4], A3[4];
#pragma unroll
        for (int c = 0; c < 4; ++c) { const int col = c * 256 + lane * 4;
            if (HAS_PREV) { const f32x4 gp = *(const f32x4*)(gpost + col), gt = *(const f32x4*)(modprev + (size_t)b * 9216 + 2048 + col); A1[c] = gp * gt * rw; }
            if (HAS_NEXT) { const f32x4 gq = *(const f32x4*)(gpre + col), sc = *(const f32x4*)(modnext + (size_t)b * 9216 + 1024 + col); A2[c] = gq * (sc + 1.0f); A3[c] = *(const f32x4*)(modnext + (size_t)b * 9216 + col); } }
        for (int r = r0; r < r0 + 8; ++r) {
            f32x4 xv[4];
#pragma unroll
            for (int c = 0; c < 4; ++c) xv[c] = *(const f32x4*)(xin + (size_t)r * D_ + c * 256 + lane * 4);
            if (HAS_PREV) { f32x4 fv[4]; float ss = 0.f;
#pragma unroll
                for (int c = 0; c < 4; ++c) { fv[c] = ld4bf(f + (size_t)r * D_ + c * 256 + lane * 4); ss += fv[c].x * fv[c].x + fv[c].y * fv[c].y + fv[c].z * fv[c].z + fv[c].w * fv[c].w; }
                const float rs = rsqrtf(wave_sum(ss) * (1.0f / D_) + EPS);
#pragma unroll
                for (int c = 0; c < 4; ++c) { xv[c] = xv[c] + A1[c] * fv[c] * rs; *(f32x4*)(xout + (size_t)r * D_ + c * 256 + lane * 4) = xv[c]; } }
            if (HAS_NEXT) { float ss = 0.f;
#pragma unroll
                for (int c = 0; c < 4; ++c) ss += xv[c].x * xv[c].x + xv[c].y * xv[c].y + xv[c].z * xv[c].z + xv[c].w * xv[c].w;
                const float rs = rsqrtf(wave_sum(ss) * (1.0f / D_) + EPS);
#pragma unroll
                for (int c = 0; c < 4; ++c) st4bf(h + (size_t)r * D_ + c * 256 + lane * 4, xv[c] * rs * A2[c] + A3[c]); }
        }
    }
}

__device__ __forceinline__ void mix0_phase(const int tidv, const bf16_t* z, const bf16_t* pool_wt, const float* pool_scale, const float* ln_g, const float* ln_b, const bf16_t* sguw, const float* sgu_b,
                                           bf16_t* ycat, LAS unsigned char* L) {
    LAS unsigned char* As = L; LAS unsigned char* Bs = L + 34816; LAS float* st = (LAS float*)(L + 69632);
    const int tid = tidv, lane = tid & 63, wave = __builtin_amdgcn_readfirstlane(tid >> 6), fr = lane & 15, fq = lane >> 4;
    for (int it = blockIdx.x; it < 1024; it += gridDim.x) {
        const int q = it >> 3, unit = it & 7, row0 = q * 128;
        __syncthreads();
        if (unit < 4) {
            const int g = unit, w = 2 << g, i4 = tid & 31, t0 = (tid >> 5) * 8, pos0 = (q & 15) * 128 + t0;
            const bf16_t* zp = z + (size_t)(row0 + t0) * 1536 + g * 128 + 4 * i4;
            f32x4 sum = {0.f, 0.f, 0.f, 0.f};
            for (int k = 1; k < w; ++k) if (pos0 - k >= 0) sum = sum + ld4bf(zp - (ptrdiff_t)k * 1536);
#pragma unroll
            for (int r = 0; r < 8; ++r) { const int pos = pos0 + r; const f32x4 cur = ld4bf(zp + (ptrdiff_t)r * 1536); sum = sum + cur;
                if (r > 0 && pos - w >= 0) sum = sum - ld4bf(zp + (ptrdiff_t)(r - w) * 1536);
                const float inv = 1.0f / (float)min(pos + 1, w); const f32x4 d = sum * inv - cur;
                u32x2 o; o.x = cvt_pk_bf16(d.x, d.y); o.y = cvt_pk_bf16(d.z, d.w); *(LAS u32x2*)(As + (t0 + r) * 272 + 8 * i4) = o; }
#pragma unroll
            for (int e = 0; e < 4; ++e) { const int idx = tid + e * 512, r = idx >> 4, c = idx & 15; *(LAS u32x4*)(Bs + r * 272 + c * 16) = *(const u32x4*)(pool_wt + g * 16384 + r * 128 + c * 8); }
        } else {
            const int hh = unit - 4;
#pragma unroll
            for (int e = 0; e < 4; ++e) { const int idx = tid + e * 512, r = idx >> 4, c = idx & 15; *(LAS u32x4*)(As + r * 272 + c * 16) = *(const u32x4*)(sguw + hh * 16384 + r * 128 + c * 8); }
            for (int i = 0; i < 16; ++i) { const int s = wave * 16 + i; const unsigned vv = *(const unsigned*)(z + (size_t)(row0 + s) * 1536 + 1024 + hh * 128 + 2 * lane);
                const float v0 = __uint_as_float(vv << 16), v1 = __uint_as_float(vv & 0xffff0000u); const float mean = wave_sum(v0 + v1) * (1.0f / 128.0f);
                const float d0 = v0 - mean, d1 = v1 - mean; const float var = wave_sum(d0 * d0 + d1 * d1) * (1.0f / 128.0f);
                if (lane == 0) { st[s * 2] = mean; st[s * 2 + 1] = rsqrtf(var + EPS); } }
            __syncthreads();
            const int d = tid & 127, sg = tid >> 7; const float gln = ln_g[hh * 128 + d], bln = ln_b[hh * 128 + d];
#pragma unroll
            for (int sb = 0; sb < 4; ++sb) { const int s0 = sg * 32 + sb * 8; float vn[8];
#pragma unroll
                for (int k = 0; k < 8; ++k) { const float v = bf2f(z[(size_t)(row0 + s0 + k) * 1536 + 1024 + hh * 128 + d]); vn[k] = (v - st[(s0 + k) * 2]) * st[(s0 + k) * 2 + 1] * gln + bln; }
                u32x4 o; o.x = cvt_pk_bf16(vn[0], vn[1]); o.y = cvt_pk_bf16(vn[2], vn[3]); o.z = cvt_pk_bf16(vn[4], vn[5]); o.w = cvt_pk_bf16(vn[6], vn[7]);
                *(LAS u32x4*)(Bs + d * 272 + s0 * 2) = o; }
        }
        __syncthreads();
        const int wr = wave >> 1, wc = wave & 1;
        f32x4 acc[2][4];
#pragma unroll
        for (int m = 0; m < 2; ++m)
#pragma unroll
            for (int n = 0; n < 4; ++n) acc[m][n] = (f32x4){0.f, 0.f, 0.f, 0.f};
#pragma unroll
        for (int kk = 0; kk < 4; ++kk) { bf16x8 Af[2];
#pragma unroll
            for (int m = 0; m < 2; ++m) Af[m] = *(const LAS bf16x8*)(As + (32 * wr + 16 * m + fr) * 272 + kk * 64 + fq * 16);
#pragma unroll
            for (int n = 0; n < 4; ++n) { const bf16x8 Bf = *(const LAS bf16x8*)(Bs + (64 * wc + 16 * n + fr) * 272 + kk * 64 + fq * 16);
#pragma unroll
                for (int m = 0; m < 2; ++m) acc[m][n] = __builtin_amdgcn_mfma_f32_16x16x32_bf16(Bf, Af[m], acc[m][n], 0, 0, 0); } }
#pragma unroll
        for (int m = 0; m < 2; ++m) { const int row = 32 * wr + 16 * m + fr;
#pragma unroll
            for (int n = 0; n < 4; ++n) { const int col = 64 * wc + 16 * n + 4 * fq;
                if (unit < 4) { const f32x4 sc = *(const f32x4*)(pool_scale + unit * 128 + col); st4bf(ycat + (size_t)(row0 + row) * 1024 + unit * 128 + col, acc[m][n] * sc); }
                else { const int hh = unit - 4; const f32x4 uu = ld4bf(z + (size_t)(row0 + row) * 1536 + 512 + hh * 128 + col); const float bs = sgu_b[hh * 128 + row];
                    st4bf(ycat + (size_t)(row0 + row) * 1024 + 512 + hh * 128 + col, uu * (acc[m][n] + bs)); } } }
    }
}

__device__ __forceinline__ void s1_phase(const int tidv, const bf16_t* u, const bf16_t* MW, bf16_t* yintra, float* Sst, LAS unsigned char* L) {
    const int tid = tidv, lane = tid & 63, wave = __builtin_amdgcn_readfirstlane(tid >> 6), fr = lane & 15, fq = lane >> 4;
    for (int it = blockIdx.x; it < 256; it += gridDim.x) {
        const int g = it >> 2, cb = it & 3, colw = cb * 256 + wave * 32;
        bf16x8 Bf[2][8];
#pragma unroll
        for (int nt = 0; nt < 2; ++nt)
#pragma unroll
            for (int kk = 0; kk < 8; ++kk) { const int col = colw + nt * 16 + fr; Bf[nt][kk] = *(const bf16x8*)(u + ((size_t)col * 16 + 2 * kk + (fq >> 1)) * 1024 + g * 16 + (fq & 1) * 8); }
        for (int rb = 0; rb < 3; ++rb) {
            __syncthreads();
#pragma unroll
            for (int e = 0; e < 8; ++e) { const int idx = tid + e * 512, r = idx >> 5, c = idx & 31; *(LAS u32x4*)(L + r * 528 + c * 16) = *(const u32x4*)(MW + ((size_t)g * 384 + rb * 128 + r) * 256 + c * 8); }
            __syncthreads();
            f32x4 acc[8][2];
#pragma unroll
            for (int mt = 0; mt < 8; ++mt) { acc[mt][0] = (f32x4){0.f, 0.f, 0.f, 0.f}; acc[mt][1] = (f32x4){0.f, 0.f, 0.f, 0.f}; }
#pragma unroll
            for (int mt = 0; mt < 8; ++mt)
#pragma unroll
                for (int kk = 0; kk < 8; ++kk) { const bf16x8 Af = *(const LAS bf16x8*)(L + (mt * 16 + fr) * 528 + kk * 64 + fq * 16);
                    acc[mt][0] = __builtin_amdgcn_mfma_f32_16x16x32_bf16(Af, Bf[0][kk], acc[mt][0], 0, 0, 0);
                    acc[mt][1] = __builtin_amdgcn_mfma_f32_16x16x32_bf16(Af, Bf[1][kk], acc[mt][1], 0, 0, 0); }
#pragma unroll
            for (int mt = 0; mt < 8; ++mt)
#pragma unroll
                for (int nt = 0; nt < 2; ++nt) { const int col = colw + nt * 16 + fr;
                    if (rb < 2) { const int t = rb * 8 + mt; st4bf(yintra + ((size_t)col * 16 + t) * 1024 + g * 16 + fq * 4, acc[mt][nt]); }
                    else *(f32x4*)(Sst + ((size_t)col * 64 + g) * 128 + mt * 16 + fq * 4) = acc[mt][nt]; }
        }
    }
}
__device__ __forceinline__ void s2_phase(const int tidv, const float* Sst, const float* lamL, bf16_t* Xs) {
    for (int gt = blockIdx.x * 512 + tidv; gt < 32768; gt += gridDim.x * 512) {
        const int b = gt >> 12, gp = gt & 4095; const float lr = lamL[gp * 2], li = lamL[gp * 2 + 1]; float xr = 0.f, xi = 0.f;
#pragma unroll 8
        for (int c = 0; c < 128; ++c) { const size_t idx = ((size_t)(b * 128 + c) * 4096 + gp) * 2; *(unsigned*)(Xs + idx) = cvt_pk_bf16(xr, xi);
            const f32x2 s = *(const f32x2*)(Sst + idx); const float nr = lr * xr - li * xi + s.x, ni = lr * xi + li * xr + s.y; xr = nr; xi = ni; }
    }
}
__device__ __forceinline__ void s3_phase(const int tidv, const bf16_t* Xs, const bf16_t* V, const bf16_t* yintra, const bf16_t* u, const float* dskip, bf16_t* gout, LAS unsigned char* L) {
    const int tid = tidv, lane = tid & 63, wave = __builtin_amdgcn_readfirstlane(tid >> 6), fr = lane & 15, fq = lane >> 4;
    for (int it = blockIdx.x; it < 256; it += gridDim.x) {
        const int g = it >> 2, cb = it & 3, colw = cb * 256 + wave * 32;
        bf16x8 Bf[2][4];
#pragma unroll
        for (int nt = 0; nt < 2; ++nt)
#pragma unroll
            for (int kk = 0; kk < 4; ++kk) { const int col = colw + nt * 16 + fr; Bf[nt][kk] = *(const bf16x8*)(Xs + ((size_t)col * 64 + g) * 128 + kk * 32 + fq * 8); }
        __syncthreads();
#pragma unroll
        for (int e = 0; e < 8; ++e) { const int idx = tid + e * 512, r = idx >> 4, c = idx & 15; *(LAS u32x4*)(L + r * 272 + c * 16) = *(const u32x4*)(V + ((size_t)g * 256 + r) * 128 + c * 8); }
        __syncthreads();
        const f32x4 ds = *(const f32x4*)(dskip + g * 16 + fq * 4);
        for (int hf = 0; hf < 2; ++hf) {
            f32x4 acc[8][2];
#pragma unroll
            for (int mt = 0; mt < 8; ++mt) { acc[mt][0] = (f32x4){0.f, 0.f, 0.f, 0.f}; acc[mt][1] = (f32x4){0.f, 0.f, 0.f, 0.f}; }
#pragma unroll
            for (int mt = 0; mt < 8; ++mt)
#pragma unroll
                for (int kk = 0; kk < 4; ++kk) { const bf16x8 Af = *(const LAS bf16x8*)(L + ((hf * 8 + mt) * 16 + fr) * 272 + kk * 64 + fq * 16);
                    acc[mt][0] = __builtin_amdgcn_mfma_f32_16x16x32_bf16(Af, Bf[0][kk], acc[mt][0], 0, 0, 0);
                    acc[mt][1] = __builtin_amdgcn_mfma_f32_16x16x32_bf16(Af, Bf[1][kk], acc[mt][1], 0, 0, 0); }
#pragma unroll
            for (int mt = 0; mt < 8; ++mt)
#pragma unroll
                for (int nt = 0; nt < 2; ++nt) { const int col = colw + nt * 16 + fr, t = hf * 8 + mt; const size_t o = ((size_t)col * 16 + t) * 1024 + g * 16 + fq * 4;
                    const f32x4 y = acc[mt][nt] + ld4bf(yintra + o) + ds * ld4bf(u + o); f32x4 r;
#pragma unroll
                    for (int i = 0; i < 4; ++i) r[i] = gelu_tanh(y[i]);
                    st4bf(gout + o, r); }
        }
    }
}

__global__ void __launch_bounds__(512, 2) mega(Args a) {
    extern __shared__ __attribute__((aligned(16))) unsigned char lds_raw[];
    LAS unsigned char* L = (LAS unsigned char*)lds_raw;
    cg::grid_group grid = cg::this_grid();
    volatile LAS unsigned* stw = (volatile LAS unsigned*)(L + 131072);
    if (threadIdx.x < 2) stw[threadIdx.x] = 0u;
    __syncthreads();
    const XcdBarrier xbar = xcd_barrier_post((unsigned*)(a.ws + WS_BAR), stw);
    unsigned char* ws = a.ws;
    const float* x_in = a.in[0]; float* out = a.out;
    const float* norm_pre = a.in[4]; const float* norm_post = a.in[5];
    const float* mod = (const float*)(ws + WS_MOD);
    bf16_t* H = (bf16_t*)(ws + WS_H); bf16_t* F = (bf16_t*)(ws + WS_F); bf16_t* ACT = (bf16_t*)(ws + WS_ACT);
    const int G = gridDim.x, bx = blockIdx.x;
#define MODP(l, s) (mod + (size_t)(l) * 8 * 9216 + (s) * 3072)
#define NPRE(l, s) (norm_pre + ((l) * 3 + (s)) * 1024)
#define NPOST(l, s) (norm_post + ((l) * 3 + (s)) * 1024)
    for (int ph = a.ph_lo; ph < a.ph_hi; ++ph) {
        int nrep = 1; if ((PROBE_MASK >> ph) & 1u) nrep += PROBE_N;
        for (int rep = 0; rep < nrep; ++rep) {
        int tidv = threadIdx.x; asm volatile("" : "+v"(tidv));
        switch (ph) {
        case 0: p0_phase(tidv, a, L, rep == 0); break;
        case 1: r_phase<false, true>(tidv, x_in, nullptr, nullptr, H, nullptr, nullptr, 0.f, NPRE(0, 0), MODP(0, 0)); break;
        case 4: r_phase<true, true>(tidv, x_in, F, out, H, NPOST(0, 0), MODP(0, 0), 0.5f, NPRE(0, 1), MODP(0, 1)); break;
        case 8: case 11: case 14: case 20: {
            int lp, sp, ln, sn; float rw;
            if (ph == 8) { lp = 0; sp = 1; ln = 0; sn = 2; rw = 1.0f; } else if (ph == 11) { lp = 0; sp = 2; ln = 1; sn = 0; rw = 0.5f; }
            else if (ph == 14) { lp = 1; sp = 0; ln = 1; sn = 1; rw = 0.5f; } else { lp = 1; sp = 1; ln = 1; sn = 2; rw = 1.0f; }
            r_phase<true, true>(tidv, out, F, out, H, NPOST(lp, sp), MODP(lp, sp), rw, NPRE(ln, sn), MODP(ln, sn)); } break;
        case 23: r_phase<true, false>(tidv, out, F, out, nullptr, NPOST(1, 2), MODP(1, 2), 0.5f, nullptr, nullptr); break;
        case 2: case 9: case 12: case 21: {
            const int w = (ph == 2) ? 0 : (ph == 9) ? 1 : (ph == 12) ? 2 : 3;
            pg8::Gemm g{H, (const bf16_t*)(ws + WS_WIN) + (size_t)w * 5632 * 1024, T_, 2 * DFF, D_}; pg8::StaticOrder S; S.init(T_, 2 * DFF, G, bx);
            EpiGated<0> E{ACT, DFF}; pg8::gemm_phase<EpiGated<0>, pg8::StaticOrder, true, true>(L, g, S, E, tidv); } break;
        case 3: case 10: case 13: case 22: case 5: case 7: case 15: {
            pg8::Gemm g; EpiPlain E;
            if (ph == 5) { g = pg8::Gemm{H, (const bf16_t*)(ws + WS_ABIN), T_, 1536, D_}; E = EpiPlain{(bf16_t*)(ws + WS_Z), 1536, 2}; }
            else if (ph == 7) { g = pg8::Gemm{(const bf16_t*)(ws + WS_YCAT), (const bf16_t*)(ws + WS_ABOUT), T_, D_, D_}; E = EpiPlain{F, D_, 1 << 30}; }
            else if (ph == 15) { g = pg8::Gemm{H, (const bf16_t*)(ws + WS_SSMIN), T_, D_, D_}; E = EpiPlain{(bf16_t*)(ws + WS_U), D_, 1 << 30}; }
            else { const int w = (ph == 3) ? 0 : (ph == 10) ? 1 : (ph == 13) ? 2 : 3;
                g = pg8::Gemm{ACT, (const bf16_t*)(ws + WS_WOUT) + (size_t)w * 1024 * 2816, T_, D_, DFF}; E = EpiPlain{F, D_, 1 << 30}; }
            pg8::StaticOrder S; S.init(g.M, g.N, G, bx);
            pg8::gemm_phase<EpiPlain, pg8::StaticOrder, true, true>(L, g, S, E, tidv); } break;
        case 6: mix0_phase(tidv, (const bf16_t*)(ws + WS_Z), (const bf16_t*)(ws + WS_SMALL), a.in[10], a.in[11], a.in[12], (const bf16_t*)(ws + WS_SMALL) + 65536, a.in[14], (bf16_t*)(ws + WS_YCAT), L); break;
        case 16: s1_phase(tidv, (const bf16_t*)(ws + WS_U), (const bf16_t*)(ws + WS_MW), (bf16_t*)(ws + WS_YI), (float*)(ws + WS_SST), L); break;
        case 17: s2_phase(tidv, (const float*)(ws + WS_SST), (const float*)(ws + WS_LAML), (bf16_t*)(ws + WS_XS)); break;
        case 18: s3_phase(tidv, (const bf16_t*)(ws + WS_XS), (const bf16_t*)(ws + WS_V), (const bf16_t*)(ws + WS_YI), (const bf16_t*)(ws + WS_U), a.in[23], (bf16_t*)(ws + WS_G), L); break;
        case 19: { pg8::Gemm g{(const bf16_t*)(ws + WS_G), (const bf16_t*)(ws + WS_GLU), T_, 2 * D_, D_}; pg8::StaticOrder S; S.init(T_, 2 * D_, G, bx);
            EpiGated<1> E{F, D_}; pg8::gemm_phase<EpiGated<1>, pg8::StaticOrder, true, true>(L, g, S, E, tidv); } break;
        default: break;
        }
        }
        if (ph + 1 < a.ph_hi) { if (ph == 0) grid.sync(); else xcd_barrier(xbar); for (int s = 0; s < PROBE_SYNC; ++s) xcd_barrier(xbar); }
    }
}

extern "C" void kernel_launch(void* const* d_in, const int* in_sizes, int n_in, void* d_out, int out_size, void* d_ws, size_t ws_size, hipStream_t stream) {
    static int grid = 0;
    if (grid == 0) {
        if (n_in != 26 || in_sizes[0] != T_ * D_ || out_size != T_ * D_ || ws_size < WS_END) { fprintf(stderr, "kernel_launch: unexpected shapes (n_in %d, in0 %d, out %d, ws %zu)\n", n_in, n_in > 0 ? in_sizes[0] : -1, out_size, ws_size); grid = -1; return; }
        int dev = 0, cus = 0, per_cu = 0;
        if (hipGetDevice(&dev) != hipSuccess || hipDeviceGetAttribute(&cus, hipDeviceAttributeMultiprocessorCount, dev) != hipSuccess) { grid = -1; return; }
        if (hipFuncSetAttribute((const void*)mega, hipFuncAttributeMaxDynamicSharedMemorySize, LDS_BYTES) != hipSuccess) { fprintf(stderr, "kernel_launch: hipFuncSetAttribute failed\n"); grid = -1; return; }
        if (hipOccupancyMaxActiveBlocksPerMultiprocessor(&per_cu, (const void*)mega, 512, LDS_BYTES) != hipSuccess || per_cu < 1) { fprintf(stderr, "kernel_launch: occupancy query gave %d\n", per_cu); per_cu = 1; (void)hipGetLastError(); }
        grid = cus * per_cu;
    }
    if (grid < 0) return;
    (void)hipMemsetAsync((char*)d_ws, 0, 1 * MiB, stream);
    Args a{};
    for (int i = 0; i < 26; ++i) a.in[i] = (const float*)d_in[i];
    a.out = (float*)d_out; a.ws = (unsigned char*)d_ws;
#if MK_PER_PHASE
    for (int ph = 0; ph < NPH; ++ph) { a.ph_lo = ph; a.ph_hi = ph + 1; hipLaunchKernelGGL(mega, dim3(grid), dim3(512), LDS_BYTES, stream, a); }
#else
    a.ph_lo = 0; a.ph_hi = NPH;
    void* args[] = {&a};
    hipError_t e = hipLaunchCooperativeKernel((const void*)mega, dim3(grid), dim3(512), args, LDS_BYTES, stream);
    if (e != hipSuccess) fprintf(stderr, "kernel_launch: cooperative launch failed: %s (grid %d)\n", hipGetErrorString(e), grid);
#endif
}
```

```cpp
#include <hip/hip_runtime.h>
#include <hip/hip_cooperative_groups.h>
#include <cstdio>
#include <cstdint>
namespace cg = cooperative_groups;
namespace pg8 {
#define PG8_LAS __attribute__((address_space(3)))
typedef unsigned short bf16_t;
typedef short bf16x8 __attribute__((ext_vector_type(8)));
typedef float f32x4 __attribute__((ext_vector_type(4)));
typedef unsigned u32x4 __attribute__((ext_vector_type(4)));
constexpr int BM = 256, BK = 64, HALF = 128, HTB = HALF * BK * 2  , STAGE_BYTES = 8 * HTB, NXCD = 8, WGM = 8;

__host__ __device__ __forceinline__ int lds_byte(int r, int c) { const int st = (r >> 4) * 2 + (c >> 5), rr = r & 15, cc = c & 31, ob = rr * 64 + cc * 2; return st * 1024 + (ob ^ (((ob >> 9) & 1) << 5)); }
__host__ __device__ __forceinline__ void stage_rc(int b, int& R, int& C) { const int st = b / 1024, sb = b % 1024, swz = sb ^ (((sb >> 9) & 1) << 5); R = (st >> 1) * 16 + swz / 64; C = (st & 1) * 32 + (swz % 64) / 2; }
__host__ __device__ __forceinline__ int perm32(int rho) { const int n = rho >> 4, i = rho & 15; return 8 * (i >> 2) + 4 * n + (i & 3); }

struct Unit { int pm, pn; };
struct Gemm { const bf16_t* A; const bf16_t* Bt; int M, N, K; };

struct StaticOrder {
    int nM, nN, nwg, G, c;
    __host__ __device__ void init(int M, int N, int G_, int c_) { nM = M / BM; nN = N / BM; nwg = nM * nN; G = G_; c = c_; }
    __host__ __device__ bool next(int i, Unit& u) const {
        const long L = (long)i * G + c; if (L >= nwg) return false;
        int wgid = (int)L; { const int q = nwg / NXCD, r = nwg % NXCD, xcd = wgid % NXCD, off = wgid / NXCD; wgid = (xcd < r ? xcd * (q + 1) : r * (q + 1) + (xcd - r) * q) + off; }
        const int nig = WGM * nN, gid = wgid / nig, fm = gid * WGM, gsz = (nM - fm) < WGM ? (nM - fm) : WGM;
        u.pm = fm + ((wgid % nig) % gsz); u.pn = (wgid % nig) / gsz; return true;
    }
    __device__ __forceinline__ void a_ready(const Unit&) const {}
    __device__ __forceinline__ void done(const Unit&) const {}
};

__device__ __forceinline__ unsigned cvt_pk_bf16(float lo, float hi) { unsigned r; asm volatile("v_cvt_pk_bf16_f32 %0, %1, %2" : "=v"(r) : "v"(lo), "v"(hi)); return r; }
typedef float f32x2 __attribute__((ext_vector_type(2)));
template <class Epi, class Sched, bool ALIGN_EPI = false, bool SP2 = false>
__device__ __forceinline__ void gemm_phase(PG8_LAS unsigned char* lds, const Gemm g, const Sched& S, const Epi& E, const int tid_in) {
    const int tid = tid_in, wid = __builtin_amdgcn_readfirstlane(tid >> 6), lane = tid & 63, wr = wid >> 2, wc = wid & 3, fr = lane & 15, fq = lane >> 4;
    const int K = g.K, nt = K / BK;
    unsigned voffA[2], voffB[2];
#pragma unroll
    for (int i = 0; i < 2; ++i) { int R, C; stage_rc(tid * 16 + i * 8192, R, C); const int Rb = Epi::PERM ? ((R & ~31) + perm32(R & 31)) : R;
        voffA[i] = (unsigned)(R * K + C) * 2u; voffB[i] = (unsigned)(Rb * K + C) * 2u; }
    const size_t kstep = (size_t)(BK * 2);
    const size_t hstep = (size_t)HALF * K * 2;
    const size_t tstep = 2 * hstep;
    const unsigned ldsw = (unsigned)wid * 1024u;
    const int aoff = lds_byte(wr * 64 + fr, fq * 8), boff = lds_byte(wc * 32 + fr, fq * 8);
#define PG8_SA(b, h) (((b) * 2 + (h)) * HTB)
#define PG8_SB(b, h) ((4 + (b) * 2 + (h)) * HTB)
#define PG8_STAGE(bufoff, gbase, voff) do { _Pragma("unroll") for (int _i = 0; _i < 2; ++_i) \
        __builtin_amdgcn_global_load_lds((const unsigned*)((const char*)(gbase) + (voff)[_i]), (PG8_LAS unsigned*)(lds + (bufoff) + ldsw + _i * 8192), 16, 0, 0); } while (0)
#define PG8_LDA(dst, b, h) do { _Pragma("unroll") for (int m = 0; m < 4; ++m) _Pragma("unroll") for (int k = 0; k < 2; ++k) dst[m][k] = *(const PG8_LAS bf16x8*)(lds + PG8_SA(b, h) + aoff + m * 2048 + k * 1024); } while (0)
#define PG8_LDB(dst, b, h) do { _Pragma("unroll") for (int n = 0; n < 2; ++n) _Pragma("unroll") for (int k = 0; k < 2; ++k) dst[n][k] = *(const PG8_LAS bf16x8*)(lds + PG8_SB(b, h) + boff + n * 2048 + k * 1024); } while (0)
#define PG8_MMA(ai, bj, At, Bt) do { __builtin_amdgcn_s_setprio(1); _Pragma("unroll") for (int m = 0; m < 4; ++m) _Pragma("unroll") for (int n = 0; n < 2; ++n) _Pragma("unroll") for (int k = 0; k < 2; ++k) \
        acc[ai][bj][m][n] = __builtin_amdgcn_mfma_f32_16x16x32_bf16(Bt[n][k], At[m][k], acc[ai][bj][m][n], 0, 0, 0); __builtin_amdgcn_s_setprio(0); } while (0)
#define PG8_WAIT_V(n) asm volatile("s_waitcnt vmcnt(" #n ")" ::: "memory")
#define PG8_WAIT_L(n) asm volatile("s_waitcnt lgkmcnt(" #n ")" ::: "memory")
#define PG8_BAR __builtin_amdgcn_s_barrier()
#define PG8_SCHED __builtin_amdgcn_sched_barrier(0)
    Unit cur, nxt; int ui = 0;
    if (!S.next(0, cur)) return;
    f32x4 acc[2][2][4][2];
#pragma unroll
    for (int a = 0; a < 2; ++a)
#pragma unroll
        for (int b = 0; b < 2; ++b)
#pragma unroll
            for (int m = 0; m < 4; ++m)
#pragma unroll
                for (int n = 0; n < 2; ++n) acc[a][b][m][n] = (f32x4){0.f, 0.f, 0.f, 0.f};
    bf16x8 At[4][2], B0[2][2], B1[2][2];
    const char* cA = (const char*)g.A + (size_t)cur.pm * tstep; const char* cB = (const char*)g.Bt + (size_t)cur.pn * tstep;
    S.a_ready(cur);
    if constexpr (SP2) {
        PG8_STAGE(PG8_SB(0, 0), cB, voffB); PG8_STAGE(PG8_SB(0, 1), cB + hstep, voffB); PG8_STAGE(PG8_SA(0, 0), cA, voffA); PG8_STAGE(PG8_SA(0, 1), cA + hstep, voffA);
        if (wr == 1) PG8_BAR;
        PG8_WAIT_V(2); PG8_BAR;
        PG8_STAGE(PG8_SB(1, 0), cB + kstep, voffB); PG8_STAGE(PG8_SA(1, 0), cA + kstep, voffA); PG8_STAGE(PG8_SB(1, 1), cB + hstep + kstep, voffB);
        PG8_WAIT_V(6); PG8_BAR;
    } else {
        PG8_STAGE(PG8_SB(0, 0), cB, voffB); PG8_STAGE(PG8_SA(0, 0), cA, voffA); PG8_STAGE(PG8_SB(0, 1), cB + hstep, voffB); PG8_STAGE(PG8_SA(0, 1), cA + hstep, voffA);
        if (wr == 1) PG8_BAR;
        PG8_WAIT_V(4); PG8_BAR;
        PG8_STAGE(PG8_SB(1, 0), cB + kstep, voffB); PG8_STAGE(PG8_SA(1, 0), cA + kstep, voffA); PG8_STAGE(PG8_SB(1, 1), cB + hstep + kstep, voffB);
        PG8_WAIT_V(6); PG8_BAR;
    }
    for (;;) {
        const bool has_next = S.next(ui + 1, nxt);
        const char* nA = has_next ? (const char*)g.A + (size_t)nxt.pm * tstep : cA; const char* nB = has_next ? (const char*)g.Bt + (size_t)nxt.pn * tstep : cB;
        for (int t = 0; t < nt; t += 2) {
            const bool last = (t == nt - 2);
            const char* a1 = cA + (size_t)(t + 1) * kstep;
            const char* a2 = last ? nA : cA + (size_t)(t + 2) * kstep; const char* b2 = last ? nB : cB + (size_t)(t + 2) * kstep;
            const char* a3 = a2 + kstep; const char* b3 = b2 + kstep;
            if (last && has_next) S.a_ready(nxt);
            if constexpr (SP2) {
            PG8_LDB(B0, 0, 0); PG8_LDB(B1, 0, 1); PG8_SCHED; PG8_LDA(At, 0, 0); PG8_STAGE(PG8_SA(1, 1), a1 + hstep, voffA);
            PG8_WAIT_V(8); PG8_WAIT_L(0); PG8_BAR; PG8_MMA(0, 0, At, B0); PG8_MMA(0, 1, At, B1); PG8_BAR; PG8_SCHED;
            PG8_LDA(At, 0, 1); PG8_STAGE(PG8_SB(0, 0), b2, voffB); PG8_STAGE(PG8_SB(0, 1), b2 + hstep, voffB); PG8_STAGE(PG8_SA(0, 0), a2, voffA);
            PG8_WAIT_V(8); PG8_WAIT_L(0); PG8_BAR; PG8_MMA(1, 0, At, B0); PG8_MMA(1, 1, At, B1); PG8_BAR; PG8_SCHED;
            PG8_LDB(B0, 1, 0); PG8_LDB(B1, 1, 1); PG8_SCHED; PG8_LDA(At, 1, 0); PG8_STAGE(PG8_SA(0, 1), a2 + hstep, voffA);
            PG8_WAIT_V(8); PG8_WAIT_L(0); PG8_BAR; PG8_MMA(0, 0, At, B0); PG8_MMA(0, 1, At, B1); PG8_BAR; PG8_SCHED;
            PG8_LDA(At, 1, 1); PG8_STAGE(PG8_SB(1, 0), b3, voffB); PG8_STAGE(PG8_SB(1, 1), b3 + hstep, voffB); PG8_STAGE(PG8_SA(1, 0), a3, voffA);
            PG8_WAIT_V(8); PG8_WAIT_L(0); PG8_BAR; PG8_MMA(1, 0, At, B0); PG8_MMA(1, 1, At, B1); PG8_BAR; PG8_SCHED;
            } else {
            PG8_LDB(B0, 0, 0); PG8_SCHED; PG8_LDA(At, 0, 0); PG8_STAGE(PG8_SA(1, 1), a1 + hstep, voffA);
            PG8_WAIT_L(8); PG8_BAR; PG8_WAIT_L(0); PG8_MMA(0, 0, At, B0); PG8_BAR; PG8_SCHED;
            PG8_LDB(B1, 0, 1); PG8_STAGE(PG8_SB(0, 0), b2, voffB);
            PG8_BAR; PG8_WAIT_L(0); PG8_MMA(0, 1, At, B1); PG8_BAR;
            PG8_LDA(At, 0, 1); PG8_STAGE(PG8_SA(0, 0), a2, voffA);
            PG8_BAR; PG8_WAIT_L(0); PG8_MMA(1, 0, At, B0); PG8_BAR; PG8_SCHED;
            PG8_STAGE(PG8_SB(0, 1), b2 + hstep, voffB);
            PG8_WAIT_V(6); PG8_BAR; PG8_MMA(1, 1, At, B1); PG8_BAR;
            PG8_LDB(B0, 1, 0); PG8_SCHED; PG8_LDA(At, 1, 0); PG8_STAGE(PG8_SA(0, 1), a2 + hstep, voffA);
            PG8_WAIT_L(8); PG8_BAR; PG8_WAIT_L(0); PG8_MMA(0, 0, At, B0); PG8_BAR; PG8_SCHED;
            PG8_LDB(B1, 1, 1); PG8_STAGE(PG8_SB(1, 0), b3, voffB);
            PG8_BAR; PG8_WAIT_L(0); PG8_MMA(0, 1, At, B1); PG8_BAR;
            PG8_LDA(At, 1, 1); PG8_STAGE(PG8_SA(1, 0), a3, voffA);
            PG8_BAR; PG8_WAIT_L(0); PG8_MMA(1, 0, At, B0); PG8_BAR; PG8_SCHED;
            PG8_STAGE(PG8_SB(1, 1), b3 + hstep, voffB);
            PG8_WAIT_V(6); PG8_BAR; PG8_MMA(1, 1, At, B1); PG8_BAR;
            }
        }
        if constexpr (ALIGN_EPI) { if (wr == 0) PG8_BAR; }
        if constexpr (!Epi::AFTER_DRAIN) { E(acc, cur, wr, wc, fr, fq); S.done(cur); }
        if (!has_next) break;
#pragma unroll
        for (int a = 0; a < 2; ++a)
#pragma unroll
            for (int b = 0; b < 2; ++b)
#pragma unroll
                for (int m = 0; m < 4; ++m)
#pragma unroll
                    for (int n = 0; n < 2; ++n) acc[a][b][m][n] = (f32x4){0.f, 0.f, 0.f, 0.f};
        cur = nxt; cA = nA; cB = nB; ++ui;
        if constexpr (ALIGN_EPI) { if (wr == 1) PG8_BAR; }
    }
    PG8_WAIT_V(0);
    if constexpr (!ALIGN_EPI) { if (wr == 0) PG8_BAR; }
    PG8_BAR;
    if constexpr (Epi::AFTER_DRAIN) { E.fused(acc, cur, wr, wc, fr, fq, lds, wid, lane); S.done(cur); }
#undef PG8_SA
#undef PG8_SB
#undef PG8_STAGE
#undef PG8_LDA
#undef PG8_LDB
#undef PG8_MMA
#undef PG8_WAIT_V
#undef PG8_WAIT_L
#undef PG8_BAR
#undef PG8_SCHED
}
}
using pg8::bf16_t; using pg8::bf16x8; using pg8::f32x4; using pg8::u32x4; using pg8::cvt_pk_bf16; using pg8::f32x2;
#define LAS __attribute__((address_space(3)))
typedef unsigned u32x2 __attribute__((ext_vector_type(2)));
#define XB_TMO      128
#define XB_XCNT(j)  (256  + 64 * (j))
#define XB_XSUB(j)  (1280 + 64 * (j))
#define XB_XGEN(j)  (2304 + 64 * (j))
#define XB_TOP      3328
#define XB_TOPGEN   3392
#define XCD_BAR_WORDS 3456
#define XB_SPIN_CAP (1u << 18)

__device__ __forceinline__ unsigned xb_ld(unsigned* p)              { return __hip_atomic_load(p, __ATOMIC_RELAXED, __HIP_MEMORY_SCOPE_AGENT); }
__device__ __forceinline__ unsigned xb_add(unsigned* p, unsigned v) { return __hip_atomic_fetch_add(p, v, __ATOMIC_RELAXED, __HIP_MEMORY_SCOPE_AGENT); }
__device__ __forceinline__ unsigned xb_xcc_id() { return (unsigned)__builtin_amdgcn_s_getreg((3 << 11) | 20) & 0xFu; }
#define XB_SPIN(cond, bar) do { unsigned _sp = 0; while (cond) { __builtin_amdgcn_s_sleep(1); \
    if ((++_sp & 255u) == 0u) { if (xb_ld(&(bar)[XB_TMO])) break; if (_sp > XB_SPIN_CAP) { atomicAdd(&(bar)[XB_TMO], 1u); break; } } } } while (0)

struct XcdBarrier {
    unsigned* bar; unsigned x;
    volatile LAS unsigned* st;
};

__device__ __forceinline__ XcdBarrier xcd_barrier_post(unsigned* bar, volatile LAS unsigned* st) {
    XcdBarrier b; b.bar = bar; b.x = xb_xcc_id(); b.st = st;
    if (threadIdx.x == 0) (void)xb_add(&bar[XB_XCNT(b.x)], 1u);
    return b;
}
__device__ __forceinline__ void xcd_barrier_complete(unsigned* bar, unsigned x, unsigned& nloc, unsigned& nx) {
    const unsigned G = gridDim.x * gridDim.y * gridDim.z;
    unsigned sum, cnt, mine, sp = 0u;
    for (;;) {
        sum = 0u; cnt = 0u; mine = 0u;
#pragma unroll
        for (unsigned j = 0; j < 16; ++j) { const unsigned c = xb_ld(&bar[XB_XCNT(j)]); sum += c; cnt += (c > 0u) ? 1u : 0u; mine = (j == x) ? c : mine; }
        if (sum == G) break;
        __builtin_amdgcn_s_sleep(1);
        if ((++sp & 255u) == 0u) { if (xb_ld(&bar[XB_TMO])) break; if (sp > XB_SPIN_CAP) { atomicAdd(&bar[XB_TMO], 1u); break; } }
    }
    nloc = mine > 0u ? mine : 1u; nx = cnt > 0u ? cnt : 1u;
}

__device__ __forceinline__ void xcd_barrier(const XcdBarrier& b) {
    asm volatile("s_waitcnt vmcnt(0)" ::: "memory");
    __syncthreads();
    if (threadIdx.x == 0) {
        unsigned* bar = b.bar;
        __builtin_amdgcn_s_waitcnt(0);
        unsigned nloc = b.st[0], nx = b.st[1];
        if (nloc == 0u) { xcd_barrier_complete(bar, b.x, nloc, nx); b.st[0] = nloc; b.st[1] = nx; }
        const unsigned old = xb_add(&bar[XB_XSUB(b.x)], 1u);
        const unsigned gen = old / nloc;
        if (old + 1u == (gen + 1u) * nloc) {
            __builtin_amdgcn_fence(__ATOMIC_RELEASE, "agent");
            asm volatile("s_waitcnt vmcnt(0)" ::: "memory");
            const unsigned og = xb_add(&bar[XB_TOP], 1u);
            const unsigned tg = og / nx;
            if (og + 1u == (tg + 1u) * nx) xb_add(&bar[XB_TOPGEN], 1u);
            else XB_SPIN(xb_ld(&bar[XB_TOPGEN]) == tg, bar);
            __builtin_amdgcn_fence(__ATOMIC_ACQUIRE, "agent");
            xb_add(&bar[XB_XGEN(b.x)], 1u);
            asm volatile("s_waitcnt vmcnt(0)" ::: "memory");
        } else {
            XB_SPIN(xb_ld(&bar[XB_XGEN(b.x)]) == gen, bar);
            __builtin_amdgcn_fence(__ATOMIC_ACQUIRE, "agent");
            asm volatile("s_waitcnt vmcnt(0)" ::: "memory");
        }
    }
    __syncthreads();
}


#ifndef MK_PER_PHASE
#define MK_PER_PHASE 0
#endif
#define PROBE_MASK 0u
#define PROBE_N 0
#define PROBE_SYNC 0

constexpr int T_ = 16384, D_ = 1024, DFF = 2816, SEQ = 2048;
constexpr float EPS = 1e-6f;
constexpr size_t MiB = 1u << 20;
constexpr size_t WS_MOD = 0, WS_BAR = 768 * 1024, WS_LAML = 1 * MiB, WS_MW = 2 * MiB, WS_V = 14 * MiB, WS_WIN = 18 * MiB, WS_WOUT = 62 * MiB, WS_ABIN = 84 * MiB,
                 WS_ABOUT = 87 * MiB, WS_SSMIN = 89 * MiB, WS_GLU = 91 * MiB, WS_SMALL = 95 * MiB, WS_H = 96 * MiB, WS_F = 128 * MiB, WS_ACT = 160 * MiB,
                 WS_END = 248 * MiB;
constexpr size_t WS_Z = WS_ACT, WS_YCAT = WS_ACT + 48 * MiB;
constexpr size_t WS_U = WS_ACT, WS_YI = WS_ACT + 32 * MiB, WS_XS = WS_ACT + 64 * MiB, WS_G = WS_H, WS_SST = WS_F;
constexpr int LDS_BYTES = 135168;
constexpr int NPH = 24;

struct Args { const float* in[26]; float* out; unsigned char* ws; int ph_lo, ph_hi; };

__device__ __forceinline__ float wave_sum(float v) {
#pragma unroll
    for (int o = 1; o < 64; o <<= 1) v += __shfl_xor(v, o);
    return v;
}
__device__ __forceinline__ float bf2f(unsigned b) { return __uint_as_float(b << 16); }
__device__ __forceinline__ unsigned f2bf(float f) { unsigned u = __float_as_uint(f); return (u + 0x7fffu + ((u >> 16) & 1u)) >> 16; }
__device__ __forceinline__ f32x4 ld4bf(const bf16_t* p) { const u32x2 v = *(const u32x2*)p; f32x4 r; r.x = __uint_as_float(v.x << 16); r.y = __uint_as_float(v.x & 0xffff0000u); r.z = __uint_as_float(v.y << 16); r.w = __uint_as_float(v.y & 0xffff0000u); return r; }
__device__ __forceinline__ void st4bf(bf16_t* p, f32x4 v) { u32x2 w; w.x = cvt_pk_bf16(v.x, v.y); w.y = cvt_pk_bf16(v.z, v.w); *(u32x2*)p = w; }
__device__ __forceinline__ float gelu_tanh(float x) { const float t = 1.5957691216f * (x + 0.044715f * x * x * x); return x * __builtin_amdgcn_rcpf(1.0f + __expf(-t)); }

template <int MODE> struct EpiGated {
    static constexpr bool PERM = true, AFTER_DRAIN = false;
    bf16_t* O; int ldc;
    __device__ __forceinline__ void operator()(const f32x4 (&acc)[2][2][4][2], const pg8::Unit& u, int wr, int wc, int fr, int fq) const {
        const int row0 = u.pm * 256 + wr * 64 + fr, col0 = u.pn * 128 + wc * 32 + 8 * fq;
#pragma unroll
        for (int ai = 0; ai < 2; ++ai)
#pragma unroll
            for (int m = 0; m < 4; ++m) {
                bf16_t* rowp = O + (size_t)(row0 + ai * 128 + m * 16) * ldc + col0;
                float v[8];
#pragma unroll
                for (int n = 0; n < 2; ++n)
#pragma unroll
                    for (int i = 0; i < 4; ++i) { const float a = acc[ai][0][m][n][i], b = acc[ai][1][m][n][i];
                        v[n * 4 + i] = (MODE == 0) ? a * b * __builtin_amdgcn_rcpf(1.0f + __expf(-a)) : a * __builtin_amdgcn_rcpf(1.0f + __expf(-b)); }
                u32x4 w; w.x = cvt_pk_bf16(v[0], v[1]); w.y = cvt_pk_bf16(v[2], v[3]); w.z = cvt_pk_bf16(v[4], v[5]); w.w = cvt_pk_bf16(v[6], v[7]);
                *(u32x4*)rowp = w;
            }
    }
};
struct EpiPlain {
    static constexpr bool PERM = true, AFTER_DRAIN = false;
    bf16_t* O; int ldc; int gelu_from;
    __device__ __forceinline__ void operator()(const f32x4 (&acc)[2][2][4][2], const pg8::Unit& u, int wr, int wc, int fr, int fq) const {
        const int row0 = u.pm * 256 + wr * 64 + fr, col0 = u.pn * 256 + wc * 32 + 8 * fq; const bool gl = u.pn >= gelu_from;
#pragma unroll
        for (int ai = 0; ai < 2; ++ai)
#pragma unroll
            for (int m = 0; m < 4; ++m) {
                bf16_t* rowp = O + (size_t)(row0 + ai * 128 + m * 16) * ldc + col0;
#pragma unroll
                for (int bj = 0; bj < 2; ++bj) { f32x4 v0 = acc[ai][bj][m][0], v1 = acc[ai][bj][m][1];
                    if (gl) {
#pragma unroll
                        for (int i = 0; i < 4; ++i) { v0[i] = gelu_tanh(v0[i]); v1[i] = gelu_tanh(v1[i]); } }
                    u32x4 w; w.x = cvt_pk_bf16(v0[0], v0[1]); w.y = cvt_pk_bf16(v0[2], v0[3]); w.z = cvt_pk_bf16(v1[0], v1[1]); w.w = cvt_pk_bf16(v1[2], v1[3]);
                    *(u32x4*)(rowp + bj * 128) = w; }
            }
    }
};

struct TItem { const float* src; bf16_t* dst; int N, K; };
__device__ __forceinline__ TItem t_decode(const Args& a, unsigned char* ws, int r) {
    constexpr int I_IN = 16 * 176, I_OUT = 44 * 32, I_ABIN = 16 * 48, I_SQ = 16 * 32;
    const float* W; bf16_t* WT; int K, N, mode = 0;
    if (r < 4 * I_IN) { const int w = r / I_IN; r -= w * I_IN; W = a.in[6] + (size_t)w * 1024 * 5632; K = 1024; N = 5632; WT = (bf16_t*)(ws + WS_WIN) + (size_t)w * 5632 * 1024; mode = 1; }
    else if ((r -= 4 * I_IN) < 4 * I_OUT) { const int w = r / I_OUT; r -= w * I_OUT; W = a.in[7] + (size_t)w * 2816 * 1024; K = 2816; N = 1024; WT = (bf16_t*)(ws + WS_WOUT) + (size_t)w * 1024 * 2816; }
    else if ((r -= 4 * I_OUT) < I_ABIN) { W = a.in[8]; K = 1024; N = 1536; WT = (bf16_t*)(ws + WS_ABIN); }
    else if ((r -= I_ABIN) < I_SQ) { W = a.in[15]; K = 1024; N = 1024; WT = (bf16_t*)(ws + WS_ABOUT); }
    else if ((r -= I_SQ) < I_SQ) { W = a.in[16]; K = 1024; N = 1024; WT = (bf16_t*)(ws + WS_SSMIN); }
    else { r -= I_SQ; W = a.in[25]; K = 1024; N = 2048; WT = (bf16_t*)(ws + WS_GLU); mode = 1; }
    const int nblk = N / 32, kb = r / nblk, nb = r % nblk, k0 = 64 * kb, n0 = 32 * nb;
    int r0 = n0;
    if (mode) { const int half = N >> 1, hf = (n0 >= half) ? 1 : 0, j = n0 - hf * half; r0 = (j >> 7) * 256 + hf * 128 + (j & 127); }
    TItem t; t.src = W + (size_t)k0 * N + n0; t.dst = WT + (size_t)r0 * K + k0; t.N = N; t.K = K; return t;
}
__device__ __forceinline__ void ssm_precompute(const int tidv, int g, const float* lam_re, const float* lam_im, const float* b_re, const float* b_im, const float* c_re, const float* c_im,
                                               const float* log_dt, bf16_t* MW, bf16_t* V, float* lamL, LAS unsigned char* L) {
    LAS float* pw = (LAS float*)L;
    LAS float* Bb = pw + 17 * 64 * 2;
    LAS float* Cc = Bb + 2048;
    LAS float* Kk = Cc + 2048;
    const int tid = tidv;
    const float dt = expf(log_dt[g]);
    for (int idx = tid; idx < 17 * 64; idx += 512) { const int j = idx >> 6, p = idx & 63; const float lr = lam_re[g * 64 + p], li = lam_im[g * 64 + p];
        const float mag = expf((float)j * dt * lr); double rev = (double)j * (double)dt * (double)li * 0.15915494309189535; rev -= rint(rev);
        const float ang = (float)(rev * 6.283185307179586); pw[idx * 2] = mag * __cosf(ang); pw[idx * 2 + 1] = mag * __sinf(ang); }
    for (int idx = tid; idx < 1024; idx += 512) { const int p = idx >> 4; const float lr = lam_re[g * 64 + p], li = lam_im[g * 64 + p];
        const float mag = expf(dt * lr); double rev = (double)dt * (double)li * 0.15915494309189535; rev -= rint(rev); const float ang = (float)(rev * 6.283185307179586);
        const float er = mag * __cosf(ang) - 1.0f, ei = mag * __sinf(ang);
        const float den = 1.0f / (lr * lr + li * li); const float qr = (er * lr + ei * li) * den, qi = (ei * lr - er * li) * den;
        const float br = b_re[g * 1024 + idx], bi = b_im[g * 1024 + idx];
        Bb[idx * 2] = qr * br - qi * bi; Bb[idx * 2 + 1] = qr * bi + qi * br; }
    for (int idx = tid; idx < 1024; idx += 512) { Cc[idx * 2] = c_re[g * 1024 + idx]; Cc[idx * 2 + 1] = c_im[g * 1024 + idx]; }
    __syncthreads();
    for (int idx = tid; idx < 4096; idx += 512) { const int j = idx >> 8, n = (idx >> 4) & 15, m = idx & 15; float s = 0.f;
        for (int p = 0; p < 64; ++p) { const float cr = Cc[(n * 64 + p) * 2], ci = Cc[(n * 64 + p) * 2 + 1], pr = pw[(j * 64 + p) * 2], pi = pw[(j * 64 + p) * 2 + 1];
            const float xr = cr * pr - ci * pi, xi = cr * pi + ci * pr; s += xr * Bb[(p * 16 + m) * 2] - xi * Bb[(p * 16 + m) * 2 + 1]; }
        Kk[idx] = s; }
    __syncthreads();
    bf16_t* MWg = MW + (size_t)g * 384 * 256; bf16_t* Vg = V + (size_t)g * 256 * 128;
    for (int q = tid; q < 32768; q += 512) { const int row = q >> 7, c2 = (q & 127) * 2; const int t = row >> 4, n = row & 15, s = c2 >> 4, m = c2 & 15;
        float v0 = 0.f, v1 = 0.f; if (s <= t) { v0 = Kk[((t - s) * 16 + n) * 16 + m]; v1 = Kk[((t - s) * 16 + n) * 16 + m + 1]; }
        *(unsigned*)(MWg + row * 256 + c2) = cvt_pk_bf16(v0, v1); }
    for (int q = tid; q < 16384; q += 512) { const int r = q >> 7, c2 = (q & 127) * 2; const int p = r >> 1, ri = r & 1, s = c2 >> 4, m = c2 & 15;
        const float pr = pw[((15 - s) * 64 + p) * 2], pi = pw[((15 - s) * 64 + p) * 2 + 1]; float v[2];
#pragma unroll
        for (int e = 0; e < 2; ++e) { const float br = Bb[(p * 16 + m + e) * 2], bi = Bb[(p * 16 + m + e) * 2 + 1]; v[e] = ri ? (pr * bi + pi * br) : (pr * br - pi * bi); }
        *(unsigned*)(MWg + (256 + r) * 256 + c2) = cvt_pk_bf16(v[0], v[1]); }
    for (int q = tid; q < 16384; q += 512) { const int row = q >> 6, p = q & 63; const int t = row >> 4, n = row & 15;
        const float cr = Cc[(n * 64 + p) * 2], ci = Cc[(n * 64 + p) * 2 + 1], pr = pw[((t + 1) * 64 + p) * 2], pi = pw[((t + 1) * 64 + p) * 2 + 1];
        *(unsigned*)(Vg + row * 128 + 2 * p) = cvt_pk_bf16(cr * pr - ci * pi, -(cr * pi + ci * pr)); }
    if (tid < 64) { lamL[(g * 64 + tid) * 2] = pw[(16 * 64 + tid) * 2]; lamL[(g * 64 + tid) * 2 + 1] = pw[(16 * 64 + tid) * 2 + 1]; }
}

__device__ __forceinline__ void p0_phase(const int tidv, const Args& a, LAS unsigned char* L, const bool do_mod) {
    const int tid = tidv, lane = tid & 63, wave = __builtin_amdgcn_readfirstlane(tid >> 6), G = gridDim.x, bx = blockIdx.x;
    unsigned char* ws = a.ws;
    for (int g = bx; g < 64; g += G) {
        ssm_precompute(tidv, g, a.in[17], a.in[18], a.in[19], a.in[20], a.in[21], a.in[22], a.in[24], (bf16_t*)(ws + WS_MW), (bf16_t*)(ws + WS_V), (float*)(ws + WS_LAML), L);
        __syncthreads(); }
    { bf16_t* pwt = (bf16_t*)(ws + WS_SMALL); bf16_t* sgw = pwt + 65536; const float* pool_w = a.in[9]; const float* sgu_w = a.in[13];
      for (int i = bx * 512 + tid; i < 65536; i += G * 512) { const int gg = i >> 14, o = (i >> 7) & 127, ii = i & 127;
          pwt[i] = (bf16_t)f2bf(pool_w[(gg * 128 + ii) * 128 + o]); sgw[i] = (ii <= o) ? (bf16_t)f2bf(sgu_w[i]) : (bf16_t)0; } }
    { LAS float* cond = (LAS float*)L; const float* c = a.in[1];
      for (int i = tid; i < 8192; i += 512) { const float v = c[i]; cond[i] = v / (1.0f + __expf(-v)); }
      __syncthreads();
      float* mod = (float*)(ws + WS_MOD); const float* ada_w = a.in[2]; const float* ada_b = a.in[3];
      LAS float* red = cond + 8192;
      if (do_mod) for (int it = bx; it < 256; it += G) { const int l = it >> 7, col0 = (it & 127) * 72, c4 = tid % 18, ks = tid / 18;
          f32x4 acc[8];
#pragma unroll
          for (int b = 0; b < 8; ++b) acc[b] = (f32x4){0.f, 0.f, 0.f, 0.f};
          if (ks < 28) {
              const float* wp = ada_w + (size_t)l * 1024 * 9216 + col0 + 4 * c4;
#pragma unroll 4
              for (int k = ks; k < 1024; k += 28) { const f32x4 w = *(const f32x4*)(wp + (size_t)k * 9216);
#pragma unroll
                  for (int b = 0; b < 8; ++b) acc[b] = acc[b] + w * cond[b * 1024 + k]; }
#pragma unroll
              for (int b = 0; b < 8; ++b) *(LAS f32x4*)(red + (ks * 8 + b) * 72 + 4 * c4) = acc[b]; }
          __syncthreads();
          for (int o = tid; o < 576; o += 512) { const int b = o / 72, cc = o % 72; float s = ada_b[l * 9216 + col0 + cc];
              for (int k2 = 0; k2 < 28; ++k2) s += red[(k2 * 8 + b) * 72 + cc];
              mod[((size_t)l * 8 + b) * 9216 + col0 + cc] = s; }
          __syncthreads(); }
      __syncthreads(); }
    { LAS float* scr = (LAS float*)(L + wave * 8448); const int gw = bx * 8 + wave, NGW = G * 8;
      constexpr int NIT = 4 * 16 * 176 + 4 * 44 * 32 + 16 * 48 + 2 * 16 * 32 + 16 * 64;
      int it = gw; TItem cur, nxt; float tv[32];
      if (it < NIT) { cur = t_decode(a, ws, it);
#pragma unroll
          for (int i = 0; i < 32; ++i) tv[i] = cur.src[(size_t)(2 * i + (lane >> 5)) * cur.N + (lane & 31)]; }
      while (it < NIT) {
#pragma unroll
          for (int i = 0; i < 32; ++i) scr[(2 * i + (lane >> 5)) * 33 + (lane & 31)] = tv[i];
          const int itn = it + NGW;
          if (itn < NIT) { nxt = t_decode(a, ws, itn);
#pragma unroll
              for (int i = 0; i < 32; ++i) tv[i] = nxt.src[(size_t)(2 * i + (lane >> 5)) * nxt.N + (lane & 31)]; }
          asm volatile("s_waitcnt lgkmcnt(0)" ::: "memory");
          const int cc = lane & 7;
#pragma unroll
          for (int j = 0; j < 4; ++j) { const int n = (lane >> 3) + 8 * j; const LAS float* s = scr + (8 * cc) * 33 + n;
              u32x4 o; o.x = cvt_pk_bf16(s[0 * 33], s[1 * 33]); o.y = cvt_pk_bf16(s[2 * 33], s[3 * 33]); o.z = cvt_pk_bf16(s[4 * 33], s[5 * 33]); o.w = cvt_pk_bf16(s[6 * 33], s[7 * 33]);
              *(u32x4*)(cur.dst + (size_t)n * cur.K + 8 * cc) = o; }
          asm volatile("s_waitcnt lgkmcnt(0)" ::: "memory");
          cur = nxt; it = itn; } }
}

template <bool HAS_PREV, bool HAS_NEXT>
__device__ __forceinline__ void r_phase(const int tidv, const float* xin, const bf16_t* f, float* xout, bf16_t* h, const float* gpost, const float* modprev, float rw, const float* gpre, const float* modnext) {
    const int tid = tidv, lane = tid & 63, wave = tid >> 6; const int gw = blockIdx.x * 8 + wave, NGW = gridDim.x * 8;
    for (int rb = gw; rb < T_ / 8; rb += NGW) {
        const int r0 = rb * 8, b = r0 / SEQ;
        f32x4 A1[4], A2[4], A3[4];
#pragma unroll
        for (int c = 0; c < 4; ++c) { const int col = c * 256 + lane * 4;
            if (HAS_PREV) { const f32x4 gp = *(const f32x4*)(gpost + col), gt = *(const f32x4*)(modprev + (size_t)b * 9216 + 2048 + col); A1[c] = gp * gt * rw; }
            if (HAS_NEXT) { const f32x4 gq = *(const f32x4*)(gpre + col), sc = *(const f32x4*)(modnext + (size_t)b * 9216 + 1024 + col); A2[c] = gq * (sc + 1.0f); A3[c] = *(const f32x4*)(modnext + (size_t)b * 9216 + col); } }
        for (int r = r0; r < r0 + 8; ++r) {
            f32x4 xv[4];
#pragma unroll
            for (int c = 0; c < 4; ++c) xv[c] = *(const f32x4*)(xin + (size_t)r * D_ + c * 256 + lane * 4);
            if (HAS_PREV) { f32x4 fv[4]; float ss = 0.f;
#pragma unroll
                for (int c = 0; c < 4; ++c) { fv[c] = ld4bf(f + (size_t)r * D_ + c * 256 + lane * 4); ss += fv[c].x * fv[c].x + fv[c].y * fv[c].y + fv[c].z * fv[c].z + fv[c].w * fv[c].w; }
                const float rs = rsqrtf(wave_sum(ss) * (1.0f / D_) + EPS);
#pragma unroll
                for (int c = 0; c < 4; ++c) { xv[c] = xv[c] + A1[c] * fv[c] * rs; *(f32x4*)(xout + (size_t)r * D_ + c * 256 + lane * 4) = xv[c]; } }
            if (HAS_NEXT) { float ss = 0.f;
#pragma unroll
                for (int c = 0; c < 4; ++c) ss += xv[c].x * xv[c].x + xv[c].y * xv[c].y + xv[c].z * xv[c].z + xv[c].w * xv[c].w;
                const float rs = rsqrtf(wave_sum(ss) * (1.0f / D_) + EPS);
#pragma unroll
                for (int c = 0; c < 4; ++c) st4bf(h + (size_t)r * D_ + c * 256 + lane * 4, xv[c] * rs * A2[c] + A3[c]); }
        }
    }
}

template <int W> __device__ __forceinline__ void pool_prep(const int tid, const int q, const bf16_t* z, const int row0, const int g, LAS unsigned char* As) {
    const int i4 = tid & 31, t0 = (tid >> 5) * 8, pos0 = (q & 15) * 128 + t0;
    const bf16_t* zp = z + (size_t)(row0 + t0) * 1536 + g * 128 + 4 * i4;
    u32x2 raw[W + 7];
#pragma unroll
    for (int i = 0; i < W + 7; ++i) { const int rel = i - (W - 1); const bool valid = (pos0 + rel) >= 0; raw[i] = *(const u32x2*)(zp + (ptrdiff_t)(valid ? rel : 0) * 1536); if (!valid) { raw[i].x = 0u; raw[i].y = 0u; } }
    f32x4 sum = {0.f, 0.f, 0.f, 0.f};
#define UNPK(v) ((f32x4){__uint_as_float((v).x << 16), __uint_as_float((v).x & 0xffff0000u), __uint_as_float((v).y << 16), __uint_as_float((v).y & 0xffff0000u)})
#pragma unroll
    for (int i = 0; i < W - 1; ++i) sum = sum + UNPK(raw[i]);
#pragma unroll
    for (int r = 0; r < 8; ++r) { const f32x4 cur = UNPK(raw[W - 1 + r]); sum = sum + cur; if (r > 0) sum = sum - UNPK(raw[r - 1]);
        const float inv = 1.0f / (float)min(pos0 + r + 1, W); const f32x4 d = sum * inv - cur;
        u32x2 o; o.x = cvt_pk_bf16(d.x, d.y); o.y = cvt_pk_bf16(d.z, d.w); *(LAS u32x2*)(As + (t0 + r) * 272 + 8 * i4) = o; }
#undef UNPK
}
__device__ __forceinline__ void mix0_phase(const int tidv, const bf16_t* z, const bf16_t* pool_wt, const float* pool_scale, const float* ln_g, const float* ln_b, const bf16_t* sguw, const float* sgu_b,
                                           bf16_t* ycat, LAS unsigned char* L) {
    LAS unsigned char* As = L; LAS unsigned char* Bs = L + 34816; LAS float* st = (LAS float*)(L + 69632);
    const int tid = tidv, lane = tid & 63, wave = __builtin_amdgcn_readfirstlane(tid >> 6), fr = lane & 15, fq = lane >> 4;
    for (int it = blockIdx.x; it < 1024; it += gridDim.x) {
        const int q = it >> 3, unit = it & 7, row0 = q * 128;
        __syncthreads();
        if (unit < 4) {
            const int g = unit;
            if (g == 0) pool_prep<2>(tid, q, z, row0, g, As); else if (g == 1) pool_prep<4>(tid, q, z, row0, g, As); else if (g == 2) pool_prep<8>(tid, q, z, row0, g, As); else pool_prep<16>(tid, q, z, row0, g, As);
#pragma unroll
            for (int e = 0; e < 4; ++e) { const int idx = tid + e * 512, r = idx >> 4, c = idx & 15; *(LAS u32x4*)(Bs + r * 272 + c * 16) = *(const u32x4*)(pool_wt + g * 16384 + r * 128 + c * 8); }
        } else {
            const int hh = unit - 4;
#pragma unroll
            for (int e = 0; e < 4; ++e) { const int idx = tid + e * 512, r = idx >> 4, c = idx & 15; *(LAS u32x4*)(As + r * 272 + c * 16) = *(const u32x4*)(sguw + hh * 16384 + r * 128 + c * 8); }
            unsigned vraw[16];
#pragma unroll
            for (int i = 0; i < 16; ++i) vraw[i] = *(const unsigned*)(z + (size_t)(row0 + wave * 16 + i) * 1536 + 1024 + hh * 128 + 2 * lane);
#pragma unroll
            for (int i = 0; i < 16; ++i) { const int s = wave * 16 + i; const unsigned vv = vraw[i];
                const float v0 = __uint_as_float(vv << 16), v1 = __uint_as_float(vv & 0xffff0000u); const float mean = wave_sum(v0 + v1) * (1.0f / 128.0f);
                const float d0 = v0 - mean, d1 = v1 - mean; const float var = wave_sum(d0 * d0 + d1 * d1) * (1.0f / 128.0f);
                if (lane == 0) { st[s * 2] = mean; st[s * 2 + 1] = rsqrtf(var + EPS); } }
            __syncthreads();
            const int d = tid & 127, sg = tid >> 7; const float gln = ln_g[hh * 128 + d], bln = ln_b[hh * 128 + d];
#pragma unroll
            for (int sb = 0; sb < 4; ++sb) { const int s0 = sg * 32 + sb * 8; float vn[8];
#pragma unroll
                for (int k = 0; k < 8; ++k) { const float v = bf2f(z[(size_t)(row0 + s0 + k) * 1536 + 1024 + hh * 128 + d]); vn[k] = (v - st[(s0 + k) * 2]) * st[(s0 + k) * 2 + 1] * gln + bln; }
                u32x4 o; o.x = cvt_pk_bf16(vn[0], vn[1]); o.y = cvt_pk_bf16(vn[2], vn[3]); o.z = cvt_pk_bf16(vn[4], vn[5]); o.w = cvt_pk_bf16(vn[6], vn[7]);
                *(LAS u32x4*)(Bs + d * 272 + s0 * 2) = o; }
        }
        __syncthreads();
        const int wr = wave >> 1, wc = wave & 1;
        f32x4 acc[2][4];
#pragma unroll
        for (int m = 0; m < 2; ++m)
#pragma unroll
            for (int n = 0; n < 4; ++n) acc[m][n] = (f32x4){0.f, 0.f, 0.f, 0.f};
#pragma unroll
        for (int kk = 0; kk < 4; ++kk) { bf16x8 Af[2];
#pragma unroll
            for (int m = 0; m < 2; ++m) Af[m] = *(const LAS bf16x8*)(As + (32 * wr + 16 * m + fr) * 272 + kk * 64 + fq * 16);
#pragma unroll
            for (int n = 0; n < 4; ++n) { const bf16x8 Bf = *(const LAS bf16x8*)(Bs + (64 * wc + 16 * n + fr) * 272 + kk * 64 + fq * 16);
#pragma unroll
                for (int m = 0; m < 2; ++m) acc[m][n] = __builtin_amdgcn_mfma_f32_16x16x32_bf16(Bf, Af[m], acc[m][n], 0, 0, 0); } }
#pragma unroll
        for (int m = 0; m < 2; ++m) { const int row = 32 * wr + 16 * m + fr;
#pragma unroll
            for (int n = 0; n < 4; ++n) { const int col = 64 * wc + 16 * n + 4 * fq;
                if (unit < 4) { const f32x4 sc = *(const f32x4*)(pool_scale + unit * 128 + col); st4bf(ycat + (size_t)(row0 + row) * 1024 + unit * 128 + col, acc[m][n] * sc); }
                else { const int hh = unit - 4; const f32x4 uu = ld4bf(z + (size_t)(row0 + row) * 1536 + 512 + hh * 128 + col); const float bs = sgu_b[hh * 128 + row];
                    st4bf(ycat + (size_t)(row0 + row) * 1024 + 512 + hh * 128 + col, uu * (acc[m][n] + bs)); } } }
    }
}

__device__ __forceinline__ void s1_phase(const int tidv, const bf16_t* u, const bf16_t* MW, bf16_t* yintra, float* Sst, LAS unsigned char* L) {
    const int tid = tidv, lane = tid & 63, wave = __builtin_amdgcn_readfirstlane(tid >> 6), fr = lane & 15, fq = lane >> 4;
    for (int it = blockIdx.x; it < 256; it += gridDim.x) {
        const int g = it >> 2, cb = it & 3, colw = cb * 256 + wave * 32;
        bf16x8 Bf[2][8];
#pragma unroll
        for (int nt = 0; nt < 2; ++nt)
#pragma unroll
            for (int kk = 0; kk < 8; ++kk) { const int col = colw + nt * 16 + fr; Bf[nt][kk] = *(const bf16x8*)(u + ((size_t)col * 16 + 2 * kk + (fq >> 1)) * 1024 + g * 16 + (fq & 1) * 8); }
        for (int rb = 0; rb < 3; ++rb) {
            __syncthreads();
#pragma unroll
            for (int e = 0; e < 8; ++e) { const int idx = tid + e * 512, r = idx >> 5, c = idx & 31; *(LAS u32x4*)(L + r * 528 + c * 16) = *(const u32x4*)(MW + ((size_t)g * 384 + rb * 128 + r) * 256 + c * 8); }
            __syncthreads();
            f32x4 acc[8][2];
#pragma unroll
            for (int mt = 0; mt < 8; ++mt) { acc[mt][0] = (f32x4){0.f, 0.f, 0.f, 0.f}; acc[mt][1] = (f32x4){0.f, 0.f, 0.f, 0.f}; }
#pragma unroll
            for (int mt = 0; mt < 8; ++mt)
#pragma unroll
                for (int kk = 0; kk < 8; ++kk) { const bf16x8 Af = *(const LAS bf16x8*)(L + (mt * 16 + fr) * 528 + kk * 64 + fq * 16);
                    acc[mt][0] = __builtin_amdgcn_mfma_f32_16x16x32_bf16(Af, Bf[0][kk], acc[mt][0], 0, 0, 0);
                    acc[mt][1] = __builtin_amdgcn_mfma_f32_16x16x32_bf16(Af, Bf[1][kk], acc[mt][1], 0, 0, 0); }
#pragma unroll
            for (int mt = 0; mt < 8; ++mt)
#pragma unroll
                for (int nt = 0; nt < 2; ++nt) { const int col = colw + nt * 16 + fr;
                    if (rb < 2) { const int t = rb * 8 + mt; st4bf(yintra + ((size_t)col * 16 + t) * 1024 + g * 16 + fq * 4, acc[mt][nt]); }
                    else *(f32x4*)(Sst + ((size_t)col * 64 + g) * 128 + mt * 16 + fq * 4) = acc[mt][nt]; }
        }
    }
}
__device__ __forceinline__ void s2_phase(const int tidv, const float* Sst, const float* lamL, bf16_t* Xs) {
    if (tidv < 128) for (int gt = blockIdx.x * 128 + tidv; gt < 32768; gt += gridDim.x * 128) {
        const int b = gt >> 12, gp = gt & 4095; const float lr = lamL[gp * 2], li = lamL[gp * 2 + 1]; float xr = 0.f, xi = 0.f;
        for (int cb = 0; cb < 4; ++cb) { f32x2 sv[32];
#pragma unroll
            for (int c = 0; c < 32; ++c) sv[c] = *(const f32x2*)(Sst + ((size_t)(b * 128 + cb * 32 + c) * 4096 + gp) * 2);
#pragma unroll
            for (int c = 0; c < 32; ++c) { const size_t idx = ((size_t)(b * 128 + cb * 32 + c) * 4096 + gp) * 2; *(unsigned*)(Xs + idx) = cvt_pk_bf16(xr, xi);
                const float nr = lr * xr - li * xi + sv[c].x, ni = lr * xi + li * xr + sv[c].y; xr = nr; xi = ni; } }
    }
}
__device__ __forceinline__ void s3_phase(const int tidv, const bf16_t* Xs, const bf16_t* V, const bf16_t* yintra, const bf16_t* u, const float* dskip, bf16_t* gout, LAS unsigned char* L) {
    const int tid = tidv, lane = tid & 63, wave = __builtin_amdgcn_readfirstlane(tid >> 6), fr = lane & 15, fq = lane >> 4;
    for (int it = blockIdx.x; it < 256; it += gridDim.x) {
        const int g = it >> 2, cb = it & 3, colw = cb * 256 + wave * 32;
        bf16x8 Bf[2][4];
#pragma unroll
        for (int nt = 0; nt < 2; ++nt)
#pragma unroll
            for (int kk = 0; kk < 4; ++kk) { const int col = colw + nt * 16 + fr; Bf[nt][kk] = *(const bf16x8*)(Xs + ((size_t)col * 64 + g) * 128 + kk * 32 + fq * 8); }
        __syncthreads();
#pragma unroll
        for (int e = 0; e < 8; ++e) { const int idx = tid + e * 512, r = idx >> 4, c = idx & 15; *(LAS u32x4*)(L + r * 272 + c * 16) = *(const u32x4*)(V + ((size_t)g * 256 + r) * 128 + c * 8); }
        __syncthreads();
        const f32x4 ds = *(const f32x4*)(dskip + g * 16 + fq * 4);
        for (int hf = 0; hf < 2; ++hf) {
            f32x4 acc[8][2];
#pragma unroll
            for (int mt = 0; mt < 8; ++mt) { acc[mt][0] = (f32x4){0.f, 0.f, 0.f, 0.f}; acc[mt][1] = (f32x4){0.f, 0.f, 0.f, 0.f}; }
#pragma unroll
            for (int mt = 0; mt < 8; ++mt)
#pragma unroll
                for (int kk = 0; kk < 4; ++kk) { const bf16x8 Af = *(const LAS bf16x8*)(L + ((hf * 8 + mt) * 16 + fr) * 272 + kk * 64 + fq * 16);
                    acc[mt][0] = __builtin_amdgcn_mfma_f32_16x16x32_bf16(Af, Bf[0][kk], acc[mt][0], 0, 0, 0);
                    acc[mt][1] = __builtin_amdgcn_mfma_f32_16x16x32_bf16(Af, Bf[1][kk], acc[mt][1], 0, 0, 0); }
#pragma unroll
            for (int mt = 0; mt < 8; ++mt)
#pragma unroll
                for (int nt = 0; nt < 2; ++nt) { const int col = colw + nt * 16 + fr, t = hf * 8 + mt; const size_t o = ((size_t)col * 16 + t) * 1024 + g * 16 + fq * 4;
                    const f32x4 y = acc[mt][nt] + ld4bf(yintra + o) + ds * ld4bf(u + o); f32x4 r;
#pragma unroll
                    for (int i = 0; i < 4; ++i) r[i] = gelu_tanh(y[i]);
                    st4bf(gout + o, r); }
        }
    }
}

__global__ void __launch_bounds__(512, 2) mega(Args a) {
    extern __shared__ __attribute__((aligned(16))) unsigned char lds_raw[];
    LAS unsigned char* L = (LAS unsigned char*)lds_raw;
    cg::grid_group grid = cg::this_grid();
    volatile LAS unsigned* stw = (volatile LAS unsigned*)(L + 131072);
    if (threadIdx.x < 2) stw[threadIdx.x] = 0u;
    __syncthreads();
    const XcdBarrier xbar = xcd_barrier_post((unsigned*)(a.ws + WS_BAR), stw);
    if (a.ph_lo > a.ph_hi) grid.sync();
    unsigned char* ws = a.ws;
    const float* x_in = a.in[0]; float* out = a.out;
    const float* norm_pre = a.in[4]; const float* norm_post = a.in[5];
    const float* mod = (const float*)(ws + WS_MOD);
    bf16_t* H = (bf16_t*)(ws + WS_H); bf16_t* F = (bf16_t*)(ws + WS_F); bf16_t* ACT = (bf16_t*)(ws + WS_ACT);
    const int G = gridDim.x, bx = blockIdx.x;
#define MODP(l, s) (mod + (size_t)(l) * 8 * 9216 + (s) * 3072)
#define NPRE(l, s) (norm_pre + ((l) * 3 + (s)) * 1024)
#define NPOST(l, s) (norm_post + ((l) * 3 + (s)) * 1024)
    for (int ph = a.ph_lo; ph < a.ph_hi; ++ph) {
        int nrep = 1; if ((PROBE_MASK >> ph) & 1u) nrep += PROBE_N;
        for (int rep = 0; rep < nrep; ++rep) {
        int tidv = threadIdx.x; asm volatile("" : "+v"(tidv));
        switch (ph) {
        case 0: p0_phase(tidv, a, L, rep == 0); break;
        case 1: r_phase<false, true>(tidv, x_in, nullptr, nullptr, H, nullptr, nullptr, 0.f, NPRE(0, 0), MODP(0, 0)); break;
        case 4: r_phase<true, true>(tidv, x_in, F, out, H, NPOST(0, 0), MODP(0, 0), 0.5f, NPRE(0, 1), MODP(0, 1)); break;
        case 8: case 11: case 14: case 20: {
            int lp, sp, ln, sn; float rw;
            if (ph == 8) { lp = 0; sp = 1; ln = 0; sn = 2; rw = 1.0f; } else if (ph == 11) { lp = 0; sp = 2; ln = 1; sn = 0; rw = 0.5f; }
            else if (ph == 14) { lp = 1; sp = 0; ln = 1; sn = 1; rw = 0.5f; } else { lp = 1; sp = 1; ln = 1; sn = 2; rw = 1.0f; }
            r_phase<true, true>(tidv, out, F, out, H, NPOST(lp, sp), MODP(lp, sp), rw, NPRE(ln, sn), MODP(ln, sn)); } break;
        case 23: r_phase<true, false>(tidv, out, F, out, nullptr, NPOST(1, 2), MODP(1, 2), 0.5f, nullptr, nullptr); break;
        case 2: case 9: case 12: case 21: {
            const int w = (ph == 2) ? 0 : (ph == 9) ? 1 : (ph == 12) ? 2 : 3;
            pg8::Gemm g{H, (const bf16_t*)(ws + WS_WIN) + (size_t)w * 5632 * 1024, T_, 2 * DFF, D_}; pg8::StaticOrder S; S.init(T_, 2 * DFF, G, bx);
            EpiGated<0> E{ACT, DFF}; pg8::gemm_phase<EpiGated<0>, pg8::StaticOrder, true, true>(L, g, S, E, tidv); } break;
        case 3: case 10: case 13: case 22: case 5: case 7: case 15: {
            pg8::Gemm g; EpiPlain E;
            if (ph == 5) { g = pg8::Gemm{H, (const bf16_t*)(ws + WS_ABIN), T_, 1536, D_}; E = EpiPlain{(bf16_t*)(ws + WS_Z), 1536, 2}; }
            else if (ph == 7) { g = pg8::Gemm{(const bf16_t*)(ws + WS_YCAT), (const bf16_t*)(ws + WS_ABOUT), T_, D_, D_}; E = EpiPlain{F, D_, 1 << 30}; }
            else if (ph == 15) { g = pg8::Gemm{H, (const bf16_t*)(ws + WS_SSMIN), T_, D_, D_}; E = EpiPlain{(bf16_t*)(ws + WS_U), D_, 1 << 30}; }
            else { const int w = (ph == 3) ? 0 : (ph == 10) ? 1 : (ph == 13) ? 2 : 3;
                g = pg8::Gemm{ACT, (const bf16_t*)(ws + WS_WOUT) + (size_t)w * 1024 * 2816, T_, D_, DFF}; E = EpiPlain{F, D_, 1 << 30}; }
            pg8::StaticOrder S; S.init(g.M, g.N, G, bx);
            pg8::gemm_phase<EpiPlain, pg8::StaticOrder, true, true>(L, g, S, E, tidv); } break;
        case 6: mix0_phase(tidv, (const bf16_t*)(ws + WS_Z), (const bf16_t*)(ws + WS_SMALL), a.in[10], a.in[11], a.in[12], (const bf16_t*)(ws + WS_SMALL) + 65536, a.in[14], (bf16_t*)(ws + WS_YCAT), L); break;
        case 16: s1_phase(tidv, (const bf16_t*)(ws + WS_U), (const bf16_t*)(ws + WS_MW), (bf16_t*)(ws + WS_YI), (float*)(ws + WS_SST), L); break;
        case 17: s2_phase(tidv, (const float*)(ws + WS_SST), (const float*)(ws + WS_LAML), (bf16_t*)(ws + WS_XS)); break;
        case 18: s3_phase(tidv, (const bf16_t*)(ws + WS_XS), (const bf16_t*)(ws + WS_V), (const bf16_t*)(ws + WS_YI), (const bf16_t*)(ws + WS_U), a.in[23], (bf16_t*)(ws + WS_G), L); break;
        case 19: { pg8::Gemm g{(const bf16_t*)(ws + WS_G), (const bf16_t*)(ws + WS_GLU), T_, 2 * D_, D_}; pg8::StaticOrder S; S.init(T_, 2 * D_, G, bx);
            EpiGated<1> E{F, D_}; pg8::gemm_phase<EpiGated<1>, pg8::StaticOrder, true, true>(L, g, S, E, tidv); } break;
        default: break;
        }
        }
        if (ph + 1 < a.ph_hi) { xcd_barrier(xbar); for (int s = 0; s < PROBE_SYNC; ++s) xcd_barrier(xbar); }
    }
}

extern "C" void kernel_launch(void* const* d_in, const int* in_sizes, int n_in, void* d_out, int out_size, void* d_ws, size_t ws_size, hipStream_t stream) {
    static int grid = 0;
    if (grid == 0) {
        if (n_in != 26 || in_sizes[0] != T_ * D_ || out_size != T_ * D_ || ws_size < WS_END) { fprintf(stderr, "kernel_launch: unexpected shapes (n_in %d, in0 %d, out %d, ws %zu)\n", n_in, n_in > 0 ? in_sizes[0] : -1, out_size, ws_size); grid = -1; return; }
        int dev = 0, cus = 0, per_cu = 0;
        if (hipGetDevice(&dev) != hipSuccess || hipDeviceGetAttribute(&cus, hipDeviceAttributeMultiprocessorCount, dev) != hipSuccess) { grid = -1; return; }
        if (hipFuncSetAttribute((const void*)mega, hipFuncAttributeMaxDynamicSharedMemorySize, LDS_BYTES) != hipSuccess) { fprintf(stderr, "kernel_launch: hipFuncSetAttribute failed\n"); grid = -1; return; }
        if (hipOccupancyMaxActiveBlocksPerMultiprocessor(&per_cu, (const void*)mega, 512, LDS_BYTES) != hipSuccess || per_cu < 1) { fprintf(stderr, "kernel_launch: occupancy query gave %d\n", per_cu); per_cu = 1; (void)hipGetLastError(); }
        grid = cus * per_cu;
    }
    if (grid < 0) return;
    (void)hipMemsetAsync((char*)d_ws, 0, 1 * MiB, stream);
    Args a{};
    for (int i = 0; i < 26; ++i) a.in[i] = (const float*)d_in[i];
    a.out = (float*)d_out; a.ws = (unsigned char*)d_ws;
#if MK_PER_PHASE
    for (int ph = 0; ph < NPH; ++ph) { a.ph_lo = ph; a.ph_hi = ph + 1; hipLaunchKernelGGL(mega, dim3(grid), dim3(512), LDS_BYTES, stream, a); }
#else
    a.ph_lo = 0; a.ph_hi = NPH;
    void* args[] = {&a};
    hipError_t e = hipLaunchCooperativeKernel((const void*)mega, dim3(grid), dim3(512), args, LDS_BYTES, stream);
    if (e != hipSuccess) fprintf(stderr, "kernel_launch: cooperative launch failed: %s (grid %d)\n", hipGetErrorString(e), grid);
#endif
}
```

```cpp
#include <hip/hip_runtime.h>
#include <hip/hip_cooperative_groups.h>
#include <cstdio>
#include <cstdint>
namespace cg = cooperative_groups;
namespace pg8 {
#define PG8_LAS __attribute__((address_space(3)))
typedef unsigned short bf16_t;
typedef short bf16x8 __attribute__((ext_vector_type(8)));
typedef float f32x4 __attribute__((ext_vector_type(4)));
typedef unsigned u32x4 __attribute__((ext_vector_type(4)));
constexpr int BM = 256, BK = 64, HALF = 128, HTB = HALF * BK * 2  , STAGE_BYTES = 8 * HTB, NXCD = 8, WGM = 8;

__host__ __device__ __forceinline__ int lds_byte(int r, int c) { const int st = (r >> 4) * 2 + (c >> 5), rr = r & 15, cc = c & 31, ob = rr * 64 + cc * 2; return st * 1024 + (ob ^ (((ob >> 9) & 1) << 5)); }
__host__ __device__ __forceinline__ void stage_rc(int b, int& R, int& C) { const int st = b / 1024, sb = b % 1024, swz = sb ^ (((sb >> 9) & 1) << 5); R = (st >> 1) * 16 + swz / 64; C = (st & 1) * 32 + (swz % 64) / 2; }
__host__ __device__ __forceinline__ int perm32(int rho) { const int n = rho >> 4, i = rho & 15; return 8 * (i >> 2) + 4 * n + (i & 3); }

struct Unit { int pm, pn; };
struct Gemm { const bf16_t* A; const bf16_t* Bt; int M, N, K; };

struct StaticOrder {
    int nM, nN, nwg, G, c;
    __host__ __device__ void init(int M, int N, int G_, int c_) { nM = M / BM; nN = N / BM; nwg = nM * nN; G = G_; c = c_; }
    __host__ __device__ bool next(int i, Unit& u) const {
        const long L = (long)i * G + c; if (L >= nwg) return false;
        int wgid = (int)L; { const int q = nwg / NXCD, r = nwg % NXCD, xcd = wgid % NXCD, off = wgid / NXCD; wgid = (xcd < r ? xcd * (q + 1) : r * (q + 1) + (xcd - r) * q) + off; }
        const int nig = WGM * nN, gid = wgid / nig, fm = gid * WGM, gsz = (nM - fm) < WGM ? (nM - fm) : WGM;
        u.pm = fm + ((wgid % nig) % gsz); u.pn = (wgid % nig) / gsz; return true;
    }
    __device__ __forceinline__ void a_ready(const Unit&) const {}
    __device__ __forceinline__ void done(const Unit&) const {}
};

__device__ __forceinline__ unsigned cvt_pk_bf16(float lo, float hi) { unsigned r; asm volatile("v_cvt_pk_bf16_f32 %0, %1, %2" : "=v"(r) : "v"(lo), "v"(hi)); return r; }
typedef float f32x2 __attribute__((ext_vector_type(2)));
template <class Epi, class Sched, bool ALIGN_EPI = false, bool SP2 = false>
__device__ __forceinline__ void gemm_phase(PG8_LAS unsigned char* lds, const Gemm g, const Sched& S, const Epi& E, const int tid_in) {
    const int tid = tid_in, wid = __builtin_amdgcn_readfirstlane(tid >> 6), lane = tid & 63, wr = wid >> 2, wc = wid & 3, fr = lane & 15, fq = lane >> 4;
    const int K = g.K, nt = K / BK;
    unsigned voffA[2], voffB[2];
#pragma unroll
    for (int i = 0; i < 2; ++i) { int R, C; stage_rc(tid * 16 + i * 8192, R, C); const int Rb = Epi::PERM ? ((R & ~31) + perm32(R & 31)) : R;
        voffA[i] = (unsigned)(R * K + C) * 2u; voffB[i] = (unsigned)(Rb * K + C) * 2u; }
    const size_t kstep = (size_t)(BK * 2);
    const size_t hstep = (size_t)HALF * K * 2;
    const size_t tstep = 2 * hstep;
    const unsigned ldsw = (unsigned)wid * 1024u;
    const int aoff = lds_byte(wr * 64 + fr, fq * 8), boff = lds_byte(wc * 32 + fr, fq * 8);
#define PG8_SA(b, h) (((b) * 2 + (h)) * HTB)
#define PG8_SB(b, h) ((4 + (b) * 2 + (h)) * HTB)
#define PG8_STAGE(bufoff, gbase, voff) do { _Pragma("unroll") for (int _i = 0; _i < 2; ++_i) \
        __builtin_amdgcn_global_load_lds((const unsigned*)((const char*)(gbase) + (voff)[_i]), (PG8_LAS unsigned*)(lds + (bufoff) + ldsw + _i * 8192), 16, 0, 0); } while (0)
#define PG8_LDA(dst, b, h) do { _Pragma("unroll") for (int m = 0; m < 4; ++m) _Pragma("unroll") for (int k = 0; k < 2; ++k) dst[m][k] = *(const PG8_LAS bf16x8*)(lds + PG8_SA(b, h) + aoff + m * 2048 + k * 1024); } while (0)
#define PG8_LDB(dst, b, h) do { _Pragma("unroll") for (int n = 0; n < 2; ++n) _Pragma("unroll") for (int k = 0; k < 2; ++k) dst[n][k] = *(const PG8_LAS bf16x8*)(lds + PG8_SB(b, h) + boff + n * 2048 + k * 1024); } while (0)
#define PG8_MMA(ai, bj, At, Bt) do { __builtin_amdgcn_s_setprio(1); _Pragma("unroll") for (int m = 0; m < 4; ++m) _Pragma("unroll") for (int n = 0; n < 2; ++n) _Pragma("unroll") for (int k = 0; k < 2; ++k) \
        acc[ai][bj][m][n] = __builtin_amdgcn_mfma_f32_16x16x32_bf16(Bt[n][k], At[m][k], acc[ai][bj][m][n], 0, 0, 0); __builtin_amdgcn_s_setprio(0); } while (0)
#define PG8_WAIT_V(n) asm volatile("s_waitcnt vmcnt(" #n ")" ::: "memory")
#define PG8_WAIT_L(n) asm volatile("s_waitcnt lgkmcnt(" #n ")" ::: "memory")
#define PG8_BAR __builtin_amdgcn_s_barrier()
#define PG8_SCHED __builtin_amdgcn_sched_barrier(0)
    Unit cur, nxt; int ui = 0;
    if (!S.next(0, cur)) return;
    f32x4 acc[2][2][4][2];
#pragma unroll
    for (int a = 0; a < 2; ++a)
#pragma unroll
        for (int b = 0; b < 2; ++b)
#pragma unroll
            for (int m = 0; m < 4; ++m)
#pragma unroll
                for (int n = 0; n < 2; ++n) acc[a][b][m][n] = (f32x4){0.f, 0.f, 0.f, 0.f};
    bf16x8 At[4][2], B0[2][2], B1[2][2];
    const char* cA = (const char*)g.A + (size_t)cur.pm * tstep; const char* cB = (const char*)g.Bt + (size_t)cur.pn * tstep;
    S.a_ready(cur);
    if constexpr (SP2) {
        PG8_STAGE(PG8_SB(0, 0), cB, voffB); PG8_STAGE(PG8_SB(0, 1), cB + hstep, voffB); PG8_STAGE(PG8_SA(0, 0), cA, voffA); PG8_STAGE(PG8_SA(0, 1), cA + hstep, voffA);
        if (wr == 1) PG8_BAR;
        PG8_WAIT_V(2); PG8_BAR;
        PG8_STAGE(PG8_SB(1, 0), cB + kstep, voffB); PG8_STAGE(PG8_SA(1, 0), cA + kstep, voffA); PG8_STAGE(PG8_SB(1, 1), cB + hstep + kstep, voffB);
        PG8_WAIT_V(6); PG8_BAR;
    } else {
        PG8_STAGE(PG8_SB(0, 0), cB, voffB); PG8_STAGE(PG8_SA(0, 0), cA, voffA); PG8_STAGE(PG8_SB(0, 1), cB + hstep, voffB); PG8_STAGE(PG8_SA(0, 1), cA + hstep, voffA);
        if (wr == 1) PG8_BAR;
        PG8_WAIT_V(4); PG8_BAR;
        PG8_STAGE(PG8_SB(1, 0), cB + kstep, voffB); PG8_STAGE(PG8_SA(1, 0), cA + kstep, voffA); PG8_STAGE(PG8_SB(1, 1), cB + hstep + kstep, voffB);
        PG8_WAIT_V(6); PG8_BAR;
    }
    for (;;) {
        const bool has_next = S.next(ui + 1, nxt);
        const char* nA = has_next ? (const char*)g.A + (size_t)nxt.pm * tstep : cA; const char* nB = has_next ? (const char*)g.Bt + (size_t)nxt.pn * tstep : cB;
        for (int t = 0; t < nt; t += 2) {
            const bool last = (t == nt - 2);
            const char* a1 = cA + (size_t)(t + 1) * kstep;
            const char* a2 = last ? nA : cA + (size_t)(t + 2) * kstep; const char* b2 = last ? nB : cB + (size_t)(t + 2) * kstep;
            const char* a3 = a2 + kstep; const char* b3 = b2 + kstep;
            if (last && has_next) S.a_ready(nxt);
            if constexpr (SP2) {
            PG8_LDB(B0, 0, 0); PG8_LDB(B1, 0, 1); PG8_SCHED; PG8_LDA(At, 0, 0); PG8_STAGE(PG8_SA(1, 1), a1 + hstep, voffA);
            PG8_WAIT_V(8); PG8_WAIT_L(0); PG8_BAR; PG8_MMA(0, 0, At, B0); PG8_MMA(0, 1, At, B1); PG8_BAR; PG8_SCHED;
            PG8_LDA(At, 0, 1); PG8_STAGE(PG8_SB(0, 0), b2, voffB); PG8_STAGE(PG8_SB(0, 1), b2 + hstep, voffB); PG8_STAGE(PG8_SA(0, 0), a2, voffA);
            PG8_WAIT_V(8); PG8_WAIT_L(0); PG8_BAR; PG8_MMA(1, 0, At, B0); PG8_MMA(1, 1, At, B1); PG8_BAR; PG8_SCHED;
            PG8_LDB(B0, 1, 0); PG8_LDB(B1, 1, 1); PG8_SCHED; PG8_LDA(At, 1, 0); PG8_STAGE(PG8_SA(0, 1), a2 + hstep, voffA);
            PG8_WAIT_V(8); PG8_WAIT_L(0); PG8_BAR; PG8_MMA(0, 0, At, B0); PG8_MMA(0, 1, At, B1); PG8_BAR; PG8_SCHED;
            PG8_LDA(At, 1, 1); PG8_STAGE(PG8_SB(1, 0), b3, voffB); PG8_STAGE(PG8_SB(1, 1), b3 + hstep, voffB); PG8_STAGE(PG8_SA(1, 0), a3, voffA);
            PG8_WAIT_V(8); PG8_WAIT_L(0); PG8_BAR; PG8_MMA(1, 0, At, B0); PG8_MMA(1, 1, At, B1); PG8_BAR; PG8_SCHED;
            } else {
            PG8_LDB(B0, 0, 0); PG8_SCHED; PG8_LDA(At, 0, 0); PG8_STAGE(PG8_SA(1, 1), a1 + hstep, voffA);
            PG8_WAIT_L(8); PG8_BAR; PG8_WAIT_L(0); PG8_MMA(0, 0, At, B0); PG8_BAR; PG8_SCHED;
            PG8_LDB(B1, 0, 1); PG8_STAGE(PG8_SB(0, 0), b2, voffB);
            PG8_BAR; PG8_WAIT_L(0); PG8_MMA(0, 1, At, B1); PG8_BAR;
            PG8_LDA(At, 0, 1); PG8_STAGE(PG8_SA(0, 0), a2, voffA);
            PG8_BAR; PG8_WAIT_L(0); PG8_MMA(1, 0, At, B0); PG8_BAR; PG8_SCHED;
            PG8_STAGE(PG8_SB(0, 1), b2 + hstep, voffB);
            PG8_WAIT_V(6); PG8_BAR; PG8_MMA(1, 1, At, B1); PG8_BAR;
            PG8_LDB(B0, 1, 0); PG8_SCHED; PG8_LDA(At, 1, 0); PG8_STAGE(PG8_SA(0, 1), a2 + hstep, voffA);
            PG8_WAIT_L(8); PG8_BAR; PG8_WAIT_L(0); PG8_MMA(0, 0, At, B0); PG8_BAR; PG8_SCHED;
            PG8_LDB(B1, 1, 1); PG8_STAGE(PG8_SB(1, 0), b3, voffB);
            PG8_BAR; PG8_WAIT_L(0); PG8_MMA(0, 1, At, B1); PG8_BAR;
            PG8_LDA(At, 1, 1); PG8_STAGE(PG8_SA(1, 0), a3, voffA);
            PG8_BAR; PG8_WAIT_L(0); PG8_MMA(1, 0, At, B0); PG8_BAR; PG8_SCHED;
            PG8_STAGE(PG8_SB(1, 1), b3 + hstep, voffB);
            PG8_WAIT_V(6); PG8_BAR; PG8_MMA(1, 1, At, B1); PG8_BAR;
            }
        }
        if constexpr (ALIGN_EPI) { if (wr == 0) PG8_BAR; }
        if constexpr (!Epi::AFTER_DRAIN) { E(acc, cur, wr, wc, fr, fq); S.done(cur); }
        if (!has_next) break;
#pragma unroll
        for (int a = 0; a < 2; ++a)
#pragma unroll
            for (int b = 0; b < 2; ++b)
#pragma unroll
                for (int m = 0; m < 4; ++m)
#pragma unroll
                    for (int n = 0; n < 2; ++n) acc[a][b][m][n] = (f32x4){0.f, 0.f, 0.f, 0.f};
        cur = nxt; cA = nA; cB = nB; ++ui;
        if constexpr (ALIGN_EPI) { if (wr == 1) PG8_BAR; }
    }
    PG8_WAIT_V(0);
    if constexpr (!ALIGN_EPI) { if (wr == 0) PG8_BAR; }
    PG8_BAR;
    if constexpr (Epi::AFTER_DRAIN) { E.fused(acc, cur, wr, wc, fr, fq, lds, wid, lane); S.done(cur); }
#undef PG8_SA
#undef PG8_SB
#undef PG8_STAGE
#undef PG8_LDA
#undef PG8_LDB
#undef PG8_MMA
#undef PG8_WAIT_V
#undef PG8_WAIT_L
#undef PG8_BAR
#undef PG8_SCHED
}
}
using pg8::bf16_t; using pg8::bf16x8; using pg8::f32x4; using pg8::u32x4; using pg8::cvt_pk_bf16; using pg8::f32x2;
#define LAS __attribute__((address_space(3)))
typedef unsigned u32x2 __attribute__((ext_vector_type(2)));
#define XB_TMO      128
#define XB_XCNT(j)  (256  + 64 * (j))
#define XB_XSUB(j)  (1280 + 64 * (j))
#define XB_XGEN(j)  (2304 + 64 * (j))
#define XB_TOP      3328
#define XB_TOPGEN   3392
#define XCD_BAR_WORDS 3456
#define XB_SPIN_CAP (1u << 18)

__device__ __forceinline__ unsigned xb_ld(unsigned* p)              { return __hip_atomic_load(p, __ATOMIC_RELAXED, __HIP_MEMORY_SCOPE_AGENT); }
__device__ __forceinline__ unsigned xb_add(unsigned* p, unsigned v) { return __hip_atomic_fetch_add(p, v, __ATOMIC_RELAXED, __HIP_MEMORY_SCOPE_AGENT); }
__device__ __forceinline__ unsigned xb_xcc_id() { return (unsigned)__builtin_amdgcn_s_getreg((3 << 11) | 20) & 0xFu; }
#define XB_SPIN(cond, bar) do { unsigned _sp = 0; while (cond) { __builtin_amdgcn_s_sleep(1); \
    if ((++_sp & 255u) == 0u) { if (xb_ld(&(bar)[XB_TMO])) break; if (_sp > XB_SPIN_CAP) { atomicAdd(&(bar)[XB_TMO], 1u); break; } } } } while (0)

struct XcdBarrier {
    unsigned* bar; unsigned x;
    volatile LAS unsigned* st;
};

__device__ __forceinline__ XcdBarrier xcd_barrier_post(unsigned* bar, volatile LAS unsigned* st) {
    XcdBarrier b; b.bar = bar; b.x = xb_xcc_id(); b.st = st;
    if (threadIdx.x == 0) (void)xb_add(&bar[XB_XCNT(b.x)], 1u);
    return b;
}
__device__ __forceinline__ void xcd_barrier_complete(unsigned* bar, unsigned x, unsigned& nloc, unsigned& nx) {
    const unsigned G = gridDim.x * gridDim.y * gridDim.z;
    unsigned sum, cnt, mine, sp = 0u;
    for (;;) {
        sum = 0u; cnt = 0u; mine = 0u;
#pragma unroll
        for (unsigned j = 0; j < 16; ++j) { const unsigned c = xb_ld(&bar[XB_XCNT(j)]); sum += c; cnt += (c > 0u) ? 1u : 0u; mine = (j == x) ? c : mine; }
        if (sum == G) break;
        __builtin_amdgcn_s_sleep(1);
        if ((++sp & 255u) == 0u) { if (xb_ld(&bar[XB_TMO])) break; if (sp > XB_SPIN_CAP) { atomicAdd(&bar[XB_TMO], 1u); break; } }
    }
    nloc = mine > 0u ? mine : 1u; nx = cnt > 0u ? cnt : 1u;
}

__device__ __forceinline__ void xcd_barrier(const XcdBarrier& b) {
    asm volatile("s_waitcnt vmcnt(0)" ::: "memory");
    __syncthreads();
    if (threadIdx.x == 0) {
        unsigned* bar = b.bar;
        __builtin_amdgcn_s_waitcnt(0);
        unsigned nloc = b.st[0], nx = b.st[1];
        if (nloc == 0u) { xcd_barrier_complete(bar, b.x, nloc, nx); b.st[0] = nloc; b.st[1] = nx; }
        const unsigned old = xb_add(&bar[XB_XSUB(b.x)], 1u);
        const unsigned gen = old / nloc;
        if (old + 1u == (gen + 1u) * nloc) {
            __builtin_amdgcn_fence(__ATOMIC_RELEASE, "agent");
            asm volatile("s_waitcnt vmcnt(0)" ::: "memory");
            const unsigned og = xb_add(&bar[XB_TOP], 1u);
            const unsigned tg = og / nx;
            if (og + 1u == (tg + 1u) * nx) xb_add(&bar[XB_TOPGEN], 1u);
            else XB_SPIN(xb_ld(&bar[XB_TOPGEN]) == tg, bar);
            __builtin_amdgcn_fence(__ATOMIC_ACQUIRE, "agent");
            xb_add(&bar[XB_XGEN(b.x)], 1u);
            asm volatile("s_waitcnt vmcnt(0)" ::: "memory");
        } else {
            XB_SPIN(xb_ld(&bar[XB_XGEN(b.x)]) == gen, bar);
            __builtin_amdgcn_fence(__ATOMIC_ACQUIRE, "agent");
            asm volatile("s_waitcnt vmcnt(0)" ::: "memory");
        }
    }
    __syncthreads();
}


#ifndef MK_PER_PHASE
#define MK_PER_PHASE 0
#endif
#define PROBE_MASK 0u
#define PROBE_N 0
#define PROBE_SYNC 0

constexpr int T_ = 16384, D_ = 1024, DFF = 2816, SEQ = 2048;
constexpr float EPS = 1e-6f;
constexpr size_t MiB = 1u << 20;
constexpr size_t WS_MOD = 0, WS_BAR = 768 * 1024, WS_LAML = 1 * MiB, WS_MW = 2 * MiB, WS_V = 14 * MiB, WS_WIN = 18 * MiB, WS_WOUT = 62 * MiB, WS_ABIN = 84 * MiB,
                 WS_ABOUT = 87 * MiB, WS_SSMIN = 89 * MiB, WS_GLU = 91 * MiB, WS_SMALL = 95 * MiB, WS_H = 96 * MiB, WS_F = 128 * MiB, WS_ACT = 160 * MiB,
                 WS_XB = 248 * MiB, WS_END = 280 * MiB;
constexpr size_t WS_Z = WS_ACT, WS_YCAT = WS_ACT + 48 * MiB;
constexpr size_t WS_U = WS_ACT, WS_YI = WS_ACT + 32 * MiB, WS_XS = WS_ACT + 64 * MiB, WS_G = WS_H, WS_SST = WS_F;
constexpr int LDS_BYTES = 135168;
constexpr int NPH = 24;

struct Args { const float* in[26]; float* out; unsigned char* ws; int ph_lo, ph_hi; };

__device__ __forceinline__ float wave_sum(float v) {
#pragma unroll
    for (int o = 1; o < 64; o <<= 1) v += __shfl_xor(v, o);
    return v;
}
__device__ __forceinline__ float bf2f(unsigned b) { return __uint_as_float(b << 16); }
__device__ __forceinline__ unsigned f2bf(float f) { unsigned u = __float_as_uint(f); return (u + 0x7fffu + ((u >> 16) & 1u)) >> 16; }
__device__ __forceinline__ f32x4 ld4bf(const bf16_t* p) { const u32x2 v = *(const u32x2*)p; f32x4 r; r.x = __uint_as_float(v.x << 16); r.y = __uint_as_float(v.x & 0xffff0000u); r.z = __uint_as_float(v.y << 16); r.w = __uint_as_float(v.y & 0xffff0000u); return r; }
__device__ __forceinline__ void st4bf(bf16_t* p, f32x4 v) { u32x2 w; w.x = cvt_pk_bf16(v.x, v.y); w.y = cvt_pk_bf16(v.z, v.w); *(u32x2*)p = w; }
__device__ __forceinline__ float gelu_tanh(float x) { const float t = 1.5957691216f * (x + 0.044715f * x * x * x); return x * __builtin_amdgcn_rcpf(1.0f + __expf(-t)); }

template <int MODE> struct EpiGated {
    static constexpr bool PERM = true, AFTER_DRAIN = false;
    bf16_t* O; int ldc;
    __device__ __forceinline__ void operator()(const f32x4 (&acc)[2][2][4][2], const pg8::Unit& u, int wr, int wc, int fr, int fq) const {
        const int row0 = u.pm * 256 + wr * 64 + fr, col0 = u.pn * 128 + wc * 32 + 8 * fq;
#pragma unroll
        for (int ai = 0; ai < 2; ++ai)
#pragma unroll
            for (int m = 0; m < 4; ++m) {
                bf16_t* rowp = O + (size_t)(row0 + ai * 128 + m * 16) * ldc + col0;
                float v[8];
#pragma unroll
                for (int n = 0; n < 2; ++n)
#pragma unroll
                    for (int i = 0; i < 4; ++i) { const float a = acc[ai][0][m][n][i], b = acc[ai][1][m][n][i];
                        v[n * 4 + i] = (MODE == 0) ? a * b * __builtin_amdgcn_rcpf(1.0f + __expf(-a)) : a * __builtin_amdgcn_rcpf(1.0f + __expf(-b)); }
                u32x4 w; w.x = cvt_pk_bf16(v[0], v[1]); w.y = cvt_pk_bf16(v[2], v[3]); w.z = cvt_pk_bf16(v[4], v[5]); w.w = cvt_pk_bf16(v[6], v[7]);
                *(u32x4*)rowp = w;
            }
    }
};
struct EpiPlain {
    static constexpr bool PERM = true, AFTER_DRAIN = false;
    bf16_t* O; int ldc; int gelu_from;
    __device__ __forceinline__ void operator()(const f32x4 (&acc)[2][2][4][2], const pg8::Unit& u, int wr, int wc, int fr, int fq) const {
        const int row0 = u.pm * 256 + wr * 64 + fr, col0 = u.pn * 256 + wc * 32 + 8 * fq; const bool gl = u.pn >= gelu_from;
#pragma unroll
        for (int ai = 0; ai < 2; ++ai)
#pragma unroll
            for (int m = 0; m < 4; ++m) {
                bf16_t* rowp = O + (size_t)(row0 + ai * 128 + m * 16) * ldc + col0;
#pragma unroll
                for (int bj = 0; bj < 2; ++bj) { f32x4 v0 = acc[ai][bj][m][0], v1 = acc[ai][bj][m][1];
                    if (gl) {
#pragma unroll
                        for (int i = 0; i < 4; ++i) { v0[i] = gelu_tanh(v0[i]); v1[i] = gelu_tanh(v1[i]); } }
                    u32x4 w; w.x = cvt_pk_bf16(v0[0], v0[1]); w.y = cvt_pk_bf16(v0[2], v0[3]); w.z = cvt_pk_bf16(v1[0], v1[1]); w.w = cvt_pk_bf16(v1[2], v1[3]);
                    *(u32x4*)(rowp + bj * 128) = w; }
            }
    }
};

struct TItem { const float* src; bf16_t* dst; int N, K; };
__device__ __forceinline__ TItem t_decode(const Args& a, unsigned char* ws, int r) {
    constexpr int I_IN = 16 * 176, I_OUT = 44 * 32, I_ABIN = 16 * 48, I_SQ = 16 * 32;
    const float* W; bf16_t* WT; int K, N, mode = 0;
    if (r < 4 * I_IN) { const int w = r / I_IN; r -= w * I_IN; W = a.in[6] + (size_t)w * 1024 * 5632; K = 1024; N = 5632; WT = (bf16_t*)(ws + WS_WIN) + (size_t)w * 5632 * 1024; mode = 1; }
    else if ((r -= 4 * I_IN) < 4 * I_OUT) { const int w = r / I_OUT; r -= w * I_OUT; W = a.in[7] + (size_t)w * 2816 * 1024; K = 2816; N = 1024; WT = (bf16_t*)(ws + WS_WOUT) + (size_t)w * 1024 * 2816; }
    else if ((r -= 4 * I_OUT) < I_ABIN) { W = a.in[8]; K = 1024; N = 1536; WT = (bf16_t*)(ws + WS_ABIN); }
    else if ((r -= I_ABIN) < I_SQ) { W = a.in[15]; K = 1024; N = 1024; WT = (bf16_t*)(ws + WS_ABOUT); }
    else if ((r -= I_SQ) < I_SQ) { W = a.in[16]; K = 1024; N = 1024; WT = (bf16_t*)(ws + WS_SSMIN); }
    else { r -= I_SQ; W = a.in[25]; K = 1024; N = 2048; WT = (bf16_t*)(ws + WS_GLU); mode = 1; }
    const int nblk = N / 32, kb = r / nblk, nb = r % nblk, k0 = 64 * kb, n0 = 32 * nb;
    int r0 = n0;
    if (mode) { const int half = N >> 1, hf = (n0 >= half) ? 1 : 0, j = n0 - hf * half; r0 = (j >> 7) * 256 + hf * 128 + (j & 127); }
    TItem t; t.src = W + (size_t)k0 * N + n0; t.dst = WT + (size_t)r0 * K + k0; t.N = N; t.K = K; return t;
}
__device__ __forceinline__ void ssm_precompute(const int tidv, int g, const int part, const float* lam_re, const float* lam_im, const float* b_re, const float* b_im, const float* c_re, const float* c_im,
                                               const float* log_dt, const float* dskip, bf16_t* MW, bf16_t* V, float* lamL, LAS unsigned char* L) {
    LAS float* pw = (LAS float*)L;
    LAS float* Bb = pw + 17 * 64 * 2;
    LAS float* Cc = Bb + 2048;
    LAS float* Kk = Cc + 2080;
    const int tid = tidv;
    const float dt = expf(log_dt[g]);
    for (int idx = tid; idx < 17 * 64; idx += 512) { const int j = idx >> 6, p = idx & 63; const float lr = lam_re[g * 64 + p], li = lam_im[g * 64 + p];
        const float mag = expf((float)j * dt * lr); double rev = (double)j * (double)dt * (double)li * 0.15915494309189535; rev -= rint(rev);
        const float ang = (float)(rev * 6.283185307179586); pw[idx * 2] = mag * __cosf(ang); pw[idx * 2 + 1] = mag * __sinf(ang); }
    for (int idx = tid; idx < 1024; idx += 512) { const int p = idx >> 4; const float lr = lam_re[g * 64 + p], li = lam_im[g * 64 + p];
        const float mag = expf(dt * lr); double rev = (double)dt * (double)li * 0.15915494309189535; rev -= rint(rev); const float ang = (float)(rev * 6.283185307179586);
        const float er = mag * __cosf(ang) - 1.0f, ei = mag * __sinf(ang);
        const float den = 1.0f / (lr * lr + li * li); const float qr = (er * lr + ei * li) * den, qi = (ei * lr - er * li) * den;
        const float br = b_re[g * 1024 + idx], bi = b_im[g * 1024 + idx];
        Bb[idx * 2] = qr * br - qi * bi; Bb[idx * 2 + 1] = qr * bi + qi * br; }
    for (int idx = tid; idx < 1024; idx += 512) { const int n = idx >> 6, p = idx & 63; Cc[(n * 65 + p) * 2] = c_re[g * 1024 + idx]; Cc[(n * 65 + p) * 2 + 1] = c_im[g * 1024 + idx]; }
    __syncthreads();
    { const int j = tid >> 5, n = (tid >> 1) & 15, mh = tid & 1; float s[8];
#pragma unroll
      for (int e2 = 0; e2 < 8; ++e2) s[e2] = 0.f;
      for (int p = 0; p < 64; ++p) { const f32x2 cv = *(const LAS f32x2*)(Cc + (n * 65 + p) * 2), pv = *(const LAS f32x2*)(pw + (j * 64 + p) * 2);
          const float xr = cv.x * pv.x - cv.y * pv.y, xi = cv.x * pv.y + cv.y * pv.x;
#pragma unroll
          for (int e2 = 0; e2 < 4; ++e2) { const f32x4 bb = *(const LAS f32x4*)(Bb + (p * 16 + mh * 8 + 2 * e2) * 2); s[2 * e2] += xr * bb.x - xi * bb.y; s[2 * e2 + 1] += xr * bb.z - xi * bb.w; } }
#pragma unroll
      for (int e2 = 0; e2 < 8; ++e2) Kk[(j * 16 + n) * 16 + mh * 8 + e2] = s[e2]; }
    __syncthreads();
    bf16_t* MVg = MW + (size_t)g * 256 * 384; bf16_t* Wg = V + (size_t)g * 128 * 256;
    for (int q = part * 8192 + tid; q < (part + 1) * 8192; q += 512) { const int row = q >> 7, c2 = (q & 127) * 2; const int t = row >> 4, n = row & 15, s = c2 >> 4, m = c2 & 15;
        float v0 = 0.f, v1 = 0.f; if (s <= t) { v0 = Kk[((t - s) * 16 + n) * 16 + m]; v1 = Kk[((t - s) * 16 + n) * 16 + m + 1]; }
        if (s == t) { if (m == n) v0 += dskip[g * 16 + n]; if (m + 1 == n) v1 += dskip[g * 16 + n]; }
        *(unsigned*)(MVg + row * 384 + c2) = cvt_pk_bf16(v0, v1); }
    for (int q = part * 4096 + tid; q < (part + 1) * 4096; q += 512) { const int r = q >> 7, c2 = (q & 127) * 2; const int p = r >> 1, ri = r & 1, s = c2 >> 4, m = c2 & 15;
        const float pr = pw[((15 - s) * 64 + p) * 2], pi = pw[((15 - s) * 64 + p) * 2 + 1]; float v[2];
#pragma unroll
        for (int e = 0; e < 2; ++e) { const float br = Bb[(p * 16 + m + e) * 2], bi = Bb[(p * 16 + m + e) * 2 + 1]; v[e] = ri ? (pr * bi + pi * br) : (pr * br - pi * bi); }
        *(unsigned*)(Wg + r * 256 + c2) = cvt_pk_bf16(v[0], v[1]); }
    for (int q = part * 4096 + tid; q < (part + 1) * 4096; q += 512) { const int row = q >> 6, p = q & 63; const int t = row >> 4, n = row & 15;
        const float cr = Cc[(n * 65 + p) * 2], ci = Cc[(n * 65 + p) * 2 + 1], pr = pw[((t + 1) * 64 + p) * 2], pi = pw[((t + 1) * 64 + p) * 2 + 1];
        *(unsigned*)(MVg + row * 384 + 256 + 2 * p) = cvt_pk_bf16(cr * pr - ci * pi, -(cr * pi + ci * pr)); }
    if (part == 0 && tid < 64) { lamL[(g * 64 + tid) * 2] = pw[(16 * 64 + tid) * 2]; lamL[(g * 64 + tid) * 2 + 1] = pw[(16 * 64 + tid) * 2 + 1]; }
}

__device__ __forceinline__ void p0_phase(const int tidv, const Args& a, LAS unsigned char* L, const bool do_mod) {
    const int tid = tidv, lane = tid & 63, wave = __builtin_amdgcn_readfirstlane(tid >> 6), G = gridDim.x, bx = blockIdx.x;
    unsigned char* ws = a.ws;
    for (int gi = bx; gi < 256; gi += G) { const int g = gi >> 2;
        ssm_precompute(tidv, g, gi & 3, a.in[17], a.in[18], a.in[19], a.in[20], a.in[21], a.in[22], a.in[24], a.in[23], (bf16_t*)(ws + WS_MW), (bf16_t*)(ws + WS_V), (float*)(ws + WS_LAML), L);
        __syncthreads(); }
    { bf16_t* pwt = (bf16_t*)(ws + WS_SMALL); bf16_t* sgw = pwt + 65536; const float* pool_w = a.in[9]; const float* sgu_w = a.in[13];
      for (int i = bx * 512 + tid; i < 65536; i += G * 512) { const int gg = i >> 14, o = (i >> 7) & 127, ii = i & 127;
          pwt[i] = (bf16_t)f2bf(pool_w[(gg * 128 + ii) * 128 + o]); sgw[i] = (ii <= o) ? (bf16_t)f2bf(sgu_w[i]) : (bf16_t)0; } }
    { LAS float* cond = (LAS float*)L; const float* c = a.in[1];
      for (int i = tid; i < 8192; i += 512) { const float v = c[i]; cond[i] = v / (1.0f + __expf(-v)); }
      __syncthreads();
      float* mod = (float*)(ws + WS_MOD); const float* ada_w = a.in[2]; const float* ada_b = a.in[3];
      LAS float* red = cond + 8192;
      if (do_mod) for (int it = bx; it < 256; it += G) { const int l = it >> 7, col0 = (it & 127) * 72, c4 = tid % 18, ks = tid / 18;
          f32x4 acc[8];
#pragma unroll
          for (int b = 0; b < 8; ++b) acc[b] = (f32x4){0.f, 0.f, 0.f, 0.f};
          if (ks < 28) {
              const float* wp = ada_w + (size_t)l * 1024 * 9216 + col0 + 4 * c4;
#pragma unroll 4
              for (int k = ks; k < 1024; k += 28) { const f32x4 w = *(const f32x4*)(wp + (size_t)k * 9216);
#pragma unroll
                  for (int b = 0; b < 8; ++b) acc[b] = acc[b] + w * cond[b * 1024 + k]; }
#pragma unroll
              for (int b = 0; b < 8; ++b) *(LAS f32x4*)(red + (ks * 8 + b) * 72 + 4 * c4) = acc[b]; }
          __syncthreads();
          for (int o = tid; o < 576; o += 512) { const int b = o / 72, cc = o % 72; float s = ada_b[l * 9216 + col0 + cc];
              for (int k2 = 0; k2 < 28; ++k2) s += red[(k2 * 8 + b) * 72 + cc];
              mod[((size_t)l * 8 + b) * 9216 + col0 + cc] = s; }
          __syncthreads(); }
      __syncthreads(); }
    { LAS float* scr = (LAS float*)(L + wave * 8448); const int gw = bx * 8 + wave, NGW = G * 8;
      constexpr int NIT = 4 * 16 * 176 + 4 * 44 * 32 + 16 * 48 + 2 * 16 * 32 + 16 * 64;
      int it = gw; TItem cur, nxt; float tv[32];
      if (it < NIT) { cur = t_decode(a, ws, it);
#pragma unroll
          for (int i = 0; i < 32; ++i) tv[i] = cur.src[(size_t)(2 * i + (lane >> 5)) * cur.N + (lane & 31)]; }
      while (it < NIT) {
#pragma unroll
          for (int i = 0; i < 32; ++i) scr[(2 * i + (lane >> 5)) * 33 + (lane & 31)] = tv[i];
          const int itn = it + NGW;
          if (itn < NIT) { nxt = t_decode(a, ws, itn);
#pragma unroll
              for (int i = 0; i < 32; ++i) tv[i] = nxt.src[(size_t)(2 * i + (lane >> 5)) * nxt.N + (lane & 31)]; }
          asm volatile("s_waitcnt lgkmcnt(0)" ::: "memory");
          const int cc = lane & 7;
#pragma unroll
          for (int j = 0; j < 4; ++j) { const int n = (lane >> 3) + 8 * j; const LAS float* s = scr + (8 * cc) * 33 + n;
              u32x4 o; o.x = cvt_pk_bf16(s[0 * 33], s[1 * 33]); o.y = cvt_pk_bf16(s[2 * 33], s[3 * 33]); o.z = cvt_pk_bf16(s[4 * 33], s[5 * 33]); o.w = cvt_pk_bf16(s[6 * 33], s[7 * 33]);
              *(u32x4*)(cur.dst + (size_t)n * cur.K + 8 * cc) = o; }
          asm volatile("s_waitcnt lgkmcnt(0)" ::: "memory");
          cur = nxt; it = itn; } }
}

template <bool HAS_PREV, bool HAS_NEXT, bool XIN_BF, bool XOUT_BF>
__device__ __forceinline__ void r_phase(const int tidv, const void* xin_, const bf16_t* f, void* xout_, bf16_t* h, const float* gpost, const float* modprev, float rw, const float* gpre, const float* modnext) {
    const int tid = tidv, lane = tid & 63, wave = tid >> 6; const int gw = blockIdx.x * 8 + wave, NGW = gridDim.x * 8;
    for (int rb = gw; rb < T_ / 8; rb += NGW) {
        const int r0 = rb * 8, b = r0 / SEQ;
        f32x4 A1[4], A2[4], A3[4];
#pragma unroll
        for (int c = 0; c < 4; ++c) { const int col = c * 256 + lane * 4;
            if (HAS_PREV) { const f32x4 gp = *(const f32x4*)(gpost + col), gt = *(const f32x4*)(modprev + (size_t)b * 9216 + 2048 + col); A1[c] = gp * gt * rw; }
            if (HAS_NEXT) { const f32x4 gq = *(const f32x4*)(gpre + col), sc = *(const f32x4*)(modnext + (size_t)b * 9216 + 1024 + col); A2[c] = gq * (sc + 1.0f); A3[c] = *(const f32x4*)(modnext + (size_t)b * 9216 + col); } }
        for (int r = r0; r < r0 + 8; ++r) {
            f32x4 xv[4];
#pragma unroll
            for (int c = 0; c < 4; ++c) { if (XIN_BF) xv[c] = ld4bf((const bf16_t*)xin_ + (size_t)r * D_ + c * 256 + lane * 4); else xv[c] = *(const f32x4*)((const float*)xin_ + (size_t)r * D_ + c * 256 + lane * 4); }
            if (HAS_PREV) { f32x4 fv[4]; float ss = 0.f;
#pragma unroll
                for (int c = 0; c < 4; ++c) { fv[c] = ld4bf(f + (size_t)r * D_ + c * 256 + lane * 4); ss += fv[c].x * fv[c].x + fv[c].y * fv[c].y + fv[c].z * fv[c].z + fv[c].w * fv[c].w; }
                const float rs = rsqrtf(wave_sum(ss) * (1.0f / D_) + EPS);
#pragma unroll
                for (int c = 0; c < 4; ++c) { xv[c] = xv[c] + A1[c] * fv[c] * rs;
                    if (XOUT_BF) st4bf((bf16_t*)xout_ + (size_t)r * D_ + c * 256 + lane * 4, xv[c]); else *(f32x4*)((float*)xout_ + (size_t)r * D_ + c * 256 + lane * 4) = xv[c]; } }
            if (HAS_NEXT) { float ss = 0.f;
#pragma unroll
                for (int c = 0; c < 4; ++c) ss += xv[c].x * xv[c].x + xv[c].y * xv[c].y + xv[c].z * xv[c].z + xv[c].w * xv[c].w;
                const float rs = rsqrtf(wave_sum(ss) * (1.0f / D_) + EPS);
#pragma unroll
                for (int c = 0; c < 4; ++c) st4bf(h + (size_t)r * D_ + c * 256 + lane * 4, xv[c] * rs * A2[c] + A3[c]); }
        }
    }
}

template <int W> __device__ __forceinline__ void pool_prep(const int tid, const int q, const bf16_t* z, const int row0, const int g, LAS unsigned char* As) {
    const int i4 = tid & 31, t0 = (tid >> 5) * 8, pos0 = (q & 15) * 128 + t0;
    const bf16_t* zp = z + (size_t)(row0 + t0) * 1536 + g * 128 + 4 * i4;
    u32x2 raw[W + 7];
#pragma unroll
    for (int i = 0; i < W + 7; ++i) { const int rel = i - (W - 1); const bool valid = (pos0 + rel) >= 0; raw[i] = *(const u32x2*)(zp + (ptrdiff_t)(valid ? rel : 0) * 1536); if (!valid) { raw[i].x = 0u; raw[i].y = 0u; } }
    f32x4 sum = {0.f, 0.f, 0.f, 0.f};
#define UNPK(v) ((f32x4){__uint_as_float((v).x << 16), __uint_as_float((v).x & 0xffff0000u), __uint_as_float((v).y << 16), __uint_as_float((v).y & 0xffff0000u)})
#pragma unroll
    for (int i = 0; i < W - 1; ++i) sum = sum + UNPK(raw[i]);
#pragma unroll
    for (int r = 0; r < 8; ++r) { const f32x4 cur = UNPK(raw[W - 1 + r]); sum = sum + cur; if (r > 0) sum = sum - UNPK(raw[r - 1]);
        const float inv = 1.0f / (float)min(pos0 + r + 1, W); const f32x4 d = sum * inv - cur;
        u32x2 o; o.x = cvt_pk_bf16(d.x, d.y); o.y = cvt_pk_bf16(d.z, d.w); *(LAS u32x2*)(As + (t0 + r) * 272 + 8 * i4) = o; }
#undef UNPK
}
__device__ __forceinline__ void mix0_phase(const int tidv, const bf16_t* z, const bf16_t* pool_wt, const float* pool_scale, const float* ln_g, const float* ln_b, const bf16_t* sguw, const float* sgu_b,
                                           bf16_t* ycat, LAS unsigned char* L) {
    LAS unsigned char* As = L; LAS unsigned char* Bs = L + 34816; LAS float* st = (LAS float*)(L + 69632);
    const int tid = tidv, lane = tid & 63, wave = __builtin_amdgcn_readfirstlane(tid >> 6), fr = lane & 15, fq = lane >> 4;
    for (int it = blockIdx.x; it < 1024; it += gridDim.x) {
        const int q = it >> 3, unit = it & 7, row0 = q * 128;
        __syncthreads();
        if (unit < 4) {
            const int g = unit;
            if (g == 0) pool_prep<2>(tid, q, z, row0, g, As); else if (g == 1) pool_prep<4>(tid, q, z, row0, g, As); else if (g == 2) pool_prep<8>(tid, q, z, row0, g, As); else pool_prep<16>(tid, q, z, row0, g, As);
#pragma unroll
            for (int e = 0; e < 4; ++e) { const int idx = tid + e * 512, r = idx >> 4, c = idx & 15; *(LAS u32x4*)(Bs + r * 272 + c * 16) = *(const u32x4*)(pool_wt + g * 16384 + r * 128 + c * 8); }
        } else {
            const int hh = unit - 4;
#pragma unroll
            for (int e = 0; e < 4; ++e) { const int idx = tid + e * 512, r = idx >> 4, c = idx & 15; *(LAS u32x4*)(As + r * 272 + c * 16) = *(const u32x4*)(sguw + hh * 16384 + r * 128 + c * 8); }
            unsigned vraw[16];
#pragma unroll
            for (int i = 0; i < 16; ++i) vraw[i] = *(const unsigned*)(z + (size_t)(row0 + wave * 16 + i) * 1536 + 1024 + hh * 128 + 2 * lane);
#pragma unroll
            for (int i = 0; i < 16; ++i) { const int s = wave * 16 + i; const unsigned vv = vraw[i];
                const float v0 = __uint_as_float(vv << 16), v1 = __uint_as_float(vv & 0xffff0000u); const float mean = wave_sum(v0 + v1) * (1.0f / 128.0f);
                const float d0 = v0 - mean, d1 = v1 - mean; const float var = wave_sum(d0 * d0 + d1 * d1) * (1.0f / 128.0f);
                if (lane == 0) { st[s * 2] = mean; st[s * 2 + 1] = rsqrtf(var + EPS); } }
            __syncthreads();
            const int d = tid & 127, sg = tid >> 7; const float gln = ln_g[hh * 128 + d], bln = ln_b[hh * 128 + d];
#pragma unroll
            for (int sb = 0; sb < 4; ++sb) { const int s0 = sg * 32 + sb * 8; float vn[8];
#pragma unroll
                for (int k = 0; k < 8; ++k) { const float v = bf2f(z[(size_t)(row0 + s0 + k) * 1536 + 1024 + hh * 128 + d]); vn[k] = (v - st[(s0 + k) * 2]) * st[(s0 + k) * 2 + 1] * gln + bln; }
                u32x4 o; o.x = cvt_pk_bf16(vn[0], vn[1]); o.y = cvt_pk_bf16(vn[2], vn[3]); o.z = cvt_pk_bf16(vn[4], vn[5]); o.w = cvt_pk_bf16(vn[6], vn[7]);
                *(LAS u32x4*)(Bs + d * 272 + s0 * 2) = o; }
        }
        __syncthreads();
        const int wr = wave >> 1, wc = wave & 1;
        f32x4 acc[2][4];
#pragma unroll
        for (int m = 0; m < 2; ++m)
#pragma unroll
            for (int n = 0; n < 4; ++n) acc[m][n] = (f32x4){0.f, 0.f, 0.f, 0.f};
#pragma unroll
        for (int kk = 0; kk < 4; ++kk) { bf16x8 Af[2];
#pragma unroll
            for (int m = 0; m < 2; ++m) Af[m] = *(const LAS bf16x8*)(As + (32 * wr + 16 * m + fr) * 272 + kk * 64 + fq * 16);
#pragma unroll
            for (int n = 0; n < 4; ++n) { const bf16x8 Bf = *(const LAS bf16x8*)(Bs + (64 * wc + 16 * n + fr) * 272 + kk * 64 + fq * 16);
#pragma unroll
                for (int m = 0; m < 2; ++m) acc[m][n] = __builtin_amdgcn_mfma_f32_16x16x32_bf16(Bf, Af[m], acc[m][n], 0, 0, 0); } }
#pragma unroll
        for (int m = 0; m < 2; ++m) { const int row = 32 * wr + 16 * m + fr;
#pragma unroll
            for (int n = 0; n < 4; ++n) { const int col = 64 * wc + 16 * n + 4 * fq;
                if (unit < 4) { const f32x4 sc = *(const f32x4*)(pool_scale + unit * 128 + col); st4bf(ycat + (size_t)(row0 + row) * 1024 + unit * 128 + col, acc[m][n] * sc); }
                else { const int hh = unit - 4; const f32x4 uu = ld4bf(z + (size_t)(row0 + row) * 1536 + 512 + hh * 128 + col); const float bs = sgu_b[hh * 128 + row];
                    st4bf(ycat + (size_t)(row0 + row) * 1024 + 512 + hh * 128 + col, uu * (acc[m][n] + bs)); } } }
    }
}

__device__ __forceinline__ void s1_phase(const int tidv, const bf16_t* u, const bf16_t* Wm, float* Sst, LAS unsigned char* L) {
    const int tid = tidv, lane = tid & 63, wave = __builtin_amdgcn_readfirstlane(tid >> 6), fr = lane & 15, fq = lane >> 4;
    for (int it = blockIdx.x; it < 256; it += gridDim.x) {
        const int g = it >> 2, cb = it & 3, colw = cb * 256 + wave * 32;
        bf16x8 Bf[2][8];
#pragma unroll
        for (int nt = 0; nt < 2; ++nt)
#pragma unroll
            for (int kk = 0; kk < 8; ++kk) { const int col = colw + nt * 16 + fr; Bf[nt][kk] = *(const bf16x8*)(u + ((size_t)col * 16 + 2 * kk + (fq >> 1)) * 1024 + g * 16 + (fq & 1) * 8); }
        __syncthreads();
#pragma unroll
        for (int e = 0; e < 8; ++e) { const int idx = tid + e * 512, r = idx >> 5, c = idx & 31; *(LAS u32x4*)(L + r * 528 + c * 16) = *(const u32x4*)(Wm + ((size_t)g * 128 + r) * 256 + c * 8); }
        __syncthreads();
        f32x4 acc[8][2];
#pragma unroll
        for (int mt = 0; mt < 8; ++mt) { acc[mt][0] = (f32x4){0.f, 0.f, 0.f, 0.f}; acc[mt][1] = (f32x4){0.f, 0.f, 0.f, 0.f}; }
#pragma unroll
        for (int mt = 0; mt < 8; ++mt)
#pragma unroll
            for (int kk = 0; kk < 8; ++kk) { const bf16x8 Af = *(const LAS bf16x8*)(L + (mt * 16 + fr) * 528 + kk * 64 + fq * 16);
                acc[mt][0] = __builtin_amdgcn_mfma_f32_16x16x32_bf16(Af, Bf[0][kk], acc[mt][0], 0, 0, 0);
                acc[mt][1] = __builtin_amdgcn_mfma_f32_16x16x32_bf16(Af, Bf[1][kk], acc[mt][1], 0, 0, 0); }
#pragma unroll
        for (int mt = 0; mt < 8; ++mt)
#pragma unroll
            for (int nt = 0; nt < 2; ++nt) { const int col = colw + nt * 16 + fr; *(f32x4*)(Sst + ((size_t)col * 64 + g) * 128 + mt * 16 + fq * 4) = acc[mt][nt]; }
    }
}
__device__ __forceinline__ void s2_phase(const int tidv, const float* Sst, const float* lamL, bf16_t* Xs) {
    if (tidv < 128) for (int gt = blockIdx.x * 128 + tidv; gt < 32768; gt += gridDim.x * 128) {
        const int b = gt >> 12, gp = gt & 4095; const float lr = lamL[gp * 2], li = lamL[gp * 2 + 1]; float xr = 0.f, xi = 0.f;
        for (int cb = 0; cb < 4; ++cb) { f32x2 sv[32];
#pragma unroll
            for (int c = 0; c < 32; ++c) sv[c] = *(const f32x2*)(Sst + ((size_t)(b * 128 + cb * 32 + c) * 4096 + gp) * 2);
#pragma unroll
            for (int c = 0; c < 32; ++c) { const size_t idx = ((size_t)(b * 128 + cb * 32 + c) * 4096 + gp) * 2; *(unsigned*)(Xs + idx) = cvt_pk_bf16(xr, xi);
                const float nr = lr * xr - li * xi + sv[c].x, ni = lr * xi + li * xr + sv[c].y; xr = nr; xi = ni; } }
    }
}
template <int HF> __device__ __forceinline__ void s3_half(const int tid, const int fr, const int fq, const int g, const int colw, const bf16_t* MV, const bf16x8 (&Bu)[2][8], const bf16x8 (&Bx)[2][4], bf16_t* gout, LAS unsigned char* L) {
    __syncthreads();
#pragma unroll
    for (int eb = 0; eb < 3; ++eb) {
#pragma unroll
        for (int e = 0; e < 4; ++e) { const int idx = tid + (eb * 4 + e) * 512, r = idx / 48, c = idx % 48; *(LAS u32x4*)(L + r * 784 + c * 16) = *(const u32x4*)(MV + ((size_t)g * 256 + HF * 128 + r) * 384 + c * 8); }
        asm volatile("" ::: "memory"); }
    __syncthreads();
#pragma unroll
    for (int mg = 0; mg < 2; ++mg) {
        f32x4 acc[4][2];
#pragma unroll
        for (int mt = 0; mt < 4; ++mt) { acc[mt][0] = (f32x4){0.f, 0.f, 0.f, 0.f}; acc[mt][1] = (f32x4){0.f, 0.f, 0.f, 0.f}; }
#pragma unroll
        for (int mt = 0; mt < 4; ++mt) {
#pragma unroll
            for (int kk = 0; kk < 12; ++kk) { if (kk < 8 && kk > ((HF * 8 + mg * 4 + mt) >> 1)) continue;
                const bf16x8 Af = *(const LAS bf16x8*)(L + ((mg * 4 + mt) * 16 + fr) * 784 + kk * 64 + fq * 16);
                if (kk < 8) { acc[mt][0] = __builtin_amdgcn_mfma_f32_16x16x32_bf16(Af, Bu[0][kk < 8 ? kk : 0], acc[mt][0], 0, 0, 0); acc[mt][1] = __builtin_amdgcn_mfma_f32_16x16x32_bf16(Af, Bu[1][kk < 8 ? kk : 0], acc[mt][1], 0, 0, 0); }
                else { acc[mt][0] = __builtin_amdgcn_mfma_f32_16x16x32_bf16(Af, Bx[0][kk >= 8 ? kk - 8 : 0], acc[mt][0], 0, 0, 0); acc[mt][1] = __builtin_amdgcn_mfma_f32_16x16x32_bf16(Af, Bx[1][kk >= 8 ? kk - 8 : 0], acc[mt][1], 0, 0, 0); } } }
#pragma unroll
        for (int mt = 0; mt < 4; ++mt)
#pragma unroll
            for (int nt = 0; nt < 2; ++nt) { const int col = colw + nt * 16 + fr, t = HF * 8 + mg * 4 + mt; const size_t o = ((size_t)col * 16 + t) * 1024 + g * 16 + fq * 4; f32x4 r;
#pragma unroll
                for (int i = 0; i < 4; ++i) r[i] = gelu_tanh(acc[mt][nt][i]);
                st4bf(gout + o, r); }
    }
}
__device__ __forceinline__ void s3_phase(const int tidv, const bf16_t* Xs, const bf16_t* MV, const bf16_t* u, bf16_t* gout, LAS unsigned char* L) {
    const int tid = tidv, lane = tid & 63, wave = __builtin_amdgcn_readfirstlane(tid >> 6), fr = lane & 15, fq = lane >> 4;
    for (int it = blockIdx.x; it < 256; it += gridDim.x) {
        const int g = it >> 2, cb = it & 3, colw = cb * 256 + wave * 32;
        bf16x8 Bu[2][8], Bx[2][4];
#pragma unroll
        for (int nt = 0; nt < 2; ++nt) { const int col = colw + nt * 16 + fr;
#pragma unroll
            for (int kk = 0; kk < 8; ++kk) Bu[nt][kk] = *(const bf16x8*)(u + ((size_t)col * 16 + 2 * kk + (fq >> 1)) * 1024 + g * 16 + (fq & 1) * 8);
#pragma unroll
            for (int kk = 0; kk < 4; ++kk) Bx[nt][kk] = *(const bf16x8*)(Xs + ((size_t)col * 64 + g) * 128 + kk * 32 + fq * 8); }
        s3_half<0>(tid, fr, fq, g, colw, MV, Bu, Bx, gout, L);
        s3_half<1>(tid, fr, fq, g, colw, MV, Bu, Bx, gout, L);
    }
}

__global__ void __launch_bounds__(512, 2) mega(Args a) {
    extern __shared__ __attribute__((aligned(16))) unsigned char lds_raw[];
    LAS unsigned char* L = (LAS unsigned char*)lds_raw;
    cg::grid_group grid = cg::this_grid();
    volatile LAS unsigned* stw = (volatile LAS unsigned*)(L + 131072);
    if (threadIdx.x < 2) stw[threadIdx.x] = 0u;
    __syncthreads();
    const XcdBarrier xbar = xcd_barrier_post((unsigned*)(a.ws + WS_BAR), stw);
    if (a.ph_lo > a.ph_hi) grid.sync();
    unsigned char* ws = a.ws;
    const float* x_in = a.in[0]; float* out = a.out;
    const float* norm_pre = a.in[4]; const float* norm_post = a.in[5];
    const float* mod = (const float*)(ws + WS_MOD);
    bf16_t* XB = (bf16_t*)(ws + WS_XB); bf16_t* H = (bf16_t*)(ws + WS_H); bf16_t* F = (bf16_t*)(ws + WS_F); bf16_t* ACT = (bf16_t*)(ws + WS_ACT);
    const int G = gridDim.x, bx = blockIdx.x;
#define MODP(l, s) (mod + (size_t)(l) * 8 * 9216 + (s) * 3072)
#define NPRE(l, s) (norm_pre + ((l) * 3 + (s)) * 1024)
#define NPOST(l, s) (norm_post + ((l) * 3 + (s)) * 1024)
    for (int ph = a.ph_lo; ph < a.ph_hi; ++ph) {
        int nrep = 1; if ((PROBE_MASK >> ph) & 1u) nrep += PROBE_N;
        for (int rep = 0; rep < nrep; ++rep) {
        int tidv = threadIdx.x; asm volatile("" : "+v"(tidv));
        switch (ph) {
        case 0: p0_phase(tidv, a, L, rep == 0); break;
        case 1: r_phase<false, true, false, false>(tidv, x_in, nullptr, nullptr, H, nullptr, nullptr, 0.f, NPRE(0, 0), MODP(0, 0)); break;
        case 4: r_phase<true, true, false, true>(tidv, x_in, F, XB, H, NPOST(0, 0), MODP(0, 0), 0.5f, NPRE(0, 1), MODP(0, 1)); break;
        case 8: case 11: case 14: case 20: {
            int lp, sp, ln, sn; float rw;
            if (ph == 8) { lp = 0; sp = 1; ln = 0; sn = 2; rw = 1.0f; } else if (ph == 11) { lp = 0; sp = 2; ln = 1; sn = 0; rw = 0.5f; }
            else if (ph == 14) { lp = 1; sp = 0; ln = 1; sn = 1; rw = 0.5f; } else { lp = 1; sp = 1; ln = 1; sn = 2; rw = 1.0f; }
            r_phase<true, true, true, true>(tidv, XB, F, XB, H, NPOST(lp, sp), MODP(lp, sp), rw, NPRE(ln, sn), MODP(ln, sn)); } break;
        case 23: r_phase<true, false, true, false>(tidv, XB, F, out, nullptr, NPOST(1, 2), MODP(1, 2), 0.5f, nullptr, nullptr); break;
        case 2: case 9: case 12: case 21: {
            const int w = (ph == 2) ? 0 : (ph == 9) ? 1 : (ph == 12) ? 2 : 3;
            pg8::Gemm g{H, (const bf16_t*)(ws + WS_WIN) + (size_t)w * 5632 * 1024, T_, 2 * DFF, D_}; pg8::StaticOrder S; S.init(T_, 2 * DFF, G, bx);
            EpiGated<0> E{ACT, DFF}; pg8::gemm_phase<EpiGated<0>, pg8::StaticOrder, true, true>(L, g, S, E, tidv); } break;
        case 3: case 10: case 13: case 22: case 5: case 7: case 15: {
            pg8::Gemm g; EpiPlain E;
            if (ph == 5) { g = pg8::Gemm{H, (const bf16_t*)(ws + WS_ABIN), T_, 1536, D_}; E = EpiPlain{(bf16_t*)(ws + WS_Z), 1536, 2}; }
            else if (ph == 7) { g = pg8::Gemm{(const bf16_t*)(ws + WS_YCAT), (const bf16_t*)(ws + WS_ABOUT), T_, D_, D_}; E = EpiPlain{F, D_, 1 << 30}; }
            else if (ph == 15) { g = pg8::Gemm{H, (const bf16_t*)(ws + WS_SSMIN), T_, D_, D_}; E = EpiPlain{(bf16_t*)(ws + WS_U), D_, 1 << 30}; }
            else { const int w = (ph == 3) ? 0 : (ph == 10) ? 1 : (ph == 13) ? 2 : 3;
                g = pg8::Gemm{ACT, (const bf16_t*)(ws + WS_WOUT) + (size_t)w * 1024 * 2816, T_, D_, DFF}; E = EpiPlain{F, D_, 1 << 30}; }
            pg8::StaticOrder S; S.init(g.M, g.N, G, bx);
            pg8::gemm_phase<EpiPlain, pg8::StaticOrder, true, true>(L, g, S, E, tidv); } break;
        case 6: mix0_phase(tidv, (const bf16_t*)(ws + WS_Z), (const bf16_t*)(ws + WS_SMALL), a.in[10], a.in[11], a.in[12], (const bf16_t*)(ws + WS_SMALL) + 65536, a.in[14], (bf16_t*)(ws + WS_YCAT), L); break;
        case 16: s1_phase(tidv, (const bf16_t*)(ws + WS_U), (const bf16_t*)(ws + WS_V), (float*)(ws + WS_SST), L); break;
        case 17: s2_phase(tidv, (const float*)(ws + WS_SST), (const float*)(ws + WS_LAML), (bf16_t*)(ws + WS_XS)); break;
        case 18: s3_phase(tidv, (const bf16_t*)(ws + WS_XS), (const bf16_t*)(ws + WS_MW), (const bf16_t*)(ws + WS_U), (bf16_t*)(ws + WS_G), L); break;
        case 19: { pg8::Gemm g{(const bf16_t*)(ws + WS_G), (const bf16_t*)(ws + WS_GLU), T_, 2 * D_, D_}; pg8::StaticOrder S; S.init(T_, 2 * D_, G, bx);
            EpiGated<1> E{F, D_}; pg8::gemm_phase<EpiGated<1>, pg8::StaticOrder, true, true>(L, g, S, E, tidv); } break;
        default: break;
        }
        }
        if (ph + 1 < a.ph_hi) { xcd_barrier(xbar); for (int s = 0; s < PROBE_SYNC; ++s) xcd_barrier(xbar); }
    }
}

extern "C" void kernel_launch(void* const* d_in, const int* in_sizes, int n_in, void* d_out, int out_size, void* d_ws, size_t ws_size, hipStream_t stream) {
    static int grid = 0;
    if (grid == 0) {
        if (n_in != 26 || in_sizes[0] != T_ * D_ || out_size != T_ * D_ || ws_size < WS_END) { fprintf(stderr, "kernel_launch: unexpected shapes (n_in %d, in0 %d, out %d, ws %zu)\n", n_in, n_in > 0 ? in_sizes[0] : -1, out_size, ws_size); grid = -1; return; }
        int dev = 0, cus = 0, per_cu = 0;
        if (hipGetDevice(&dev) != hipSuccess || hipDeviceGetAttribute(&cus, hipDeviceAttributeMultiprocessorCount, dev) != hipSuccess) { grid = -1; return; }
        if (hipFuncSetAttribute((const void*)mega, hipFuncAttributeMaxDynamicSharedMemorySize, LDS_BYTES) != hipSuccess) { fprintf(stderr, "kernel_launch: hipFuncSetAttribute failed\n"); grid = -1; return; }
        if (hipOccupancyMaxActiveBlocksPerMultiprocessor(&per_cu, (const void*)mega, 512, LDS_BYTES) != hipSuccess || per_cu < 1) { fprintf(stderr, "kernel_launch: occupancy query gave %d\n", per_cu); per_cu = 1; (void)hipGetLastError(); }
        grid = cus * per_cu;
    }
    if (grid < 0) return;
    (void)hipMemsetAsync((char*)d_ws, 0, 1 * MiB, stream);
    Args a{};
    for (int i = 0; i < 26; ++i) a.in[i] = (const float*)d_in[i];
    a.out = (float*)d_out; a.ws = (unsigned char*)d_ws;
#if MK_PER_PHASE
    for (int ph = 0; ph < NPH; ++ph) { a.ph_lo = ph; a.ph_hi = ph + 1; hipLaunchKernelGGL(mega, dim3(grid), dim3(512), LDS_BYTES, stream, a); }
#else
    a.ph_lo = 0; a.ph_hi = NPH;
    void* args[] = {&a};
    hipError_t e = hipLaunchCooperativeKernel((const void*)mega, dim3(grid), dim3(512), args, LDS_BYTES, stream);
    if (e != hipSuccess) fprintf(stderr, "kernel_launch: cooperative launch failed: %s (grid %d)\n", hipGetErrorString(e), grid);
#endif
}
```

```cpp
#include <hip/hip_runtime.h>
#include <hip/hip_cooperative_groups.h>
#include <cstdio>
#include <cstdint>
namespace cg = cooperative_groups;
namespace pg8 {
#define PG8_LAS __attribute__((address_space(3)))
typedef unsigned short bf16_t;
typedef short bf16x8 __attribute__((ext_vector_type(8)));
typedef float f32x4 __attribute__((ext_vector_type(4)));
typedef unsigned u32x4 __attribute__((ext_vector_type(4)));
constexpr int BM = 256, BK = 64, HALF = 128, HTB = HALF * BK * 2  , STAGE_BYTES = 8 * HTB, NXCD = 8, WGM = 8;

__host__ __device__ __forceinline__ int lds_byte(int r, int c) { const int st = (r >> 4) * 2 + (c >> 5), rr = r & 15, cc = c & 31, ob = rr * 64 + cc * 2; return st * 1024 + (ob ^ (((ob >> 9) & 1) << 5)); }
__host__ __device__ __forceinline__ void stage_rc(int b, int& R, int& C) { const int st = b / 1024, sb = b % 1024, swz = sb ^ (((sb >> 9) & 1) << 5); R = (st >> 1) * 16 + swz / 64; C = (st & 1) * 32 + (swz % 64) / 2; }
__host__ __device__ __forceinline__ int perm32(int rho) { const int n = rho >> 4, i = rho & 15; return 8 * (i >> 2) + 4 * n + (i & 3); }

struct Unit { int pm, pn; };
struct Gemm { const bf16_t* A; const bf16_t* Bt; int M, N, K; };

struct StaticOrder {
    int nM, nN, nwg, G, c;
    __host__ __device__ void init(int M, int N, int G_, int c_) { nM = M / BM; nN = N / BM; nwg = nM * nN; G = G_; c = c_; }
    __host__ __device__ bool next(int i, Unit& u) const {
        const long L = (long)i * G + c; if (L >= nwg) return false;
        int wgid = (int)L; { const int q = nwg / NXCD, r = nwg % NXCD, xcd = wgid % NXCD, off = wgid / NXCD; wgid = (xcd < r ? xcd * (q + 1) : r * (q + 1) + (xcd - r) * q) + off; }
        const int nig = WGM * nN, gid = wgid / nig, fm = gid * WGM, gsz = (nM - fm) < WGM ? (nM - fm) : WGM;
        u.pm = fm + ((wgid % nig) % gsz); u.pn = (wgid % nig) / gsz; return true;
    }
    __device__ __forceinline__ void a_ready(const Unit&) const {}
    __device__ __forceinline__ void done(const Unit&) const {}
};

__device__ __forceinline__ unsigned cvt_pk_bf16(float lo, float hi) { unsigned r; asm volatile("v_cvt_pk_bf16_f32 %0, %1, %2" : "=v"(r) : "v"(lo), "v"(hi)); return r; }
typedef float f32x2 __attribute__((ext_vector_type(2)));
template <class Epi, class Sched, bool ALIGN_EPI = false, bool SP2 = false>
__device__ __forceinline__ void gemm_phase(PG8_LAS unsigned char* lds, const Gemm g, const Sched& S, const Epi& E, const int tid_in) {
    const int tid = tid_in, wid = __builtin_amdgcn_readfirstlane(tid >> 6), lane = tid & 63, wr = wid >> 2, wc = wid & 3, fr = lane & 15, fq = lane >> 4;
    const int K = g.K, nt = K / BK;
    unsigned voffA[2], voffB[2];
#pragma unroll
    for (int i = 0; i < 2; ++i) { int R, C; stage_rc(tid * 16 + i * 8192, R, C); const int Rb = Epi::PERM ? ((R & ~31) + perm32(R & 31)) : R;
        voffA[i] = (unsigned)(R * K + C) * 2u; voffB[i] = (unsigned)(Rb * K + C) * 2u; }
    const size_t kstep = (size_t)(BK * 2);
    const size_t hstep = (size_t)HALF * K * 2;
    const size_t tstep = 2 * hstep;
    const unsigned ldsw = (unsigned)wid * 1024u;
    const int aoff = lds_byte(wr * 64 + fr, fq * 8), boff = lds_byte(wc * 32 + fr, fq * 8);
#define PG8_SA(b, h) (((b) * 2 + (h)) * HTB)
#define PG8_SB(b, h) ((4 + (b) * 2 + (h)) * HTB)
#define PG8_STAGE(bufoff, gbase, voff) do { _Pragma("unroll") for (int _i = 0; _i < 2; ++_i) \
        __builtin_amdgcn_global_load_lds((const unsigned*)((const char*)(gbase) + (voff)[_i]), (PG8_LAS unsigned*)(lds + (bufoff) + ldsw + _i * 8192), 16, 0, 0); } while (0)
#define PG8_LDA(dst, b, h) do { _Pragma("unroll") for (int m = 0; m < 4; ++m) _Pragma("unroll") for (int k = 0; k < 2; ++k) dst[m][k] = *(const PG8_LAS bf16x8*)(lds + PG8_SA(b, h) + aoff + m * 2048 + k * 1024); } while (0)
#define PG8_LDB(dst, b, h) do { _Pragma("unroll") for (int n = 0; n < 2; ++n) _Pragma("unroll") for (int k = 0; k < 2; ++k) dst[n][k] = *(const PG8_LAS bf16x8*)(lds + PG8_SB(b, h) + boff + n * 2048 + k * 1024); } while (0)
#define PG8_MMA(ai, bj, At, Bt) do { __builtin_amdgcn_s_setprio(1); _Pragma("unroll") for (int m = 0; m < 4; ++m) _Pragma("unroll") for (int n = 0; n < 2; ++n) _Pragma("unroll") for (int k = 0; k < 2; ++k) \
        acc[ai][bj][m][n] = __builtin_amdgcn_mfma_f32_16x16x32_bf16(Bt[n][k], At[m][k], acc[ai][bj][m][n], 0, 0, 0); __builtin_amdgcn_s_setprio(0); } while (0)
#define PG8_WAIT_V(n) asm volatile("s_waitcnt vmcnt(" #n ")" ::: "memory")
#define PG8_WAIT_L(n) asm volatile("s_waitcnt lgkmcnt(" #n ")" ::: "memory")
#define PG8_BAR __builtin_amdgcn_s_barrier()
#define PG8_SCHED __builtin_amdgcn_sched_barrier(0)
    Unit cur, nxt; int ui = 0;
    if (!S.next(0, cur)) return;
    f32x4 acc[2][2][4][2];
#pragma unroll
    for (int a = 0; a < 2; ++a)
#pragma unroll
        for (int b = 0; b < 2; ++b)
#pragma unroll
            for (int m = 0; m < 4; ++m)
#pragma unroll
                for (int n = 0; n < 2; ++n) acc[a][b][m][n] = (f32x4){0.f, 0.f, 0.f, 0.f};
    bf16x8 At[4][2], B0[2][2], B1[2][2];
    const char* cA = (const char*)g.A + (size_t)cur.pm * tstep; const char* cB = (const char*)g.Bt + (size_t)cur.pn * tstep;
    S.a_ready(cur);
    if constexpr (SP2) {
        PG8_STAGE(PG8_SB(0, 0), cB, voffB); PG8_STAGE(PG8_SB(0, 1), cB + hstep, voffB); PG8_STAGE(PG8_SA(0, 0), cA, voffA); PG8_STAGE(PG8_SA(0, 1), cA + hstep, voffA);
        if (wr == 1) PG8_BAR;
        PG8_WAIT_V(2); PG8_BAR;
        PG8_STAGE(PG8_SB(1, 0), cB + kstep, voffB); PG8_STAGE(PG8_SA(1, 0), cA + kstep, voffA); PG8_STAGE(PG8_SB(1, 1), cB + hstep + kstep, voffB);
        PG8_WAIT_V(6); PG8_BAR;
    } else {
        PG8_STAGE(PG8_SB(0, 0), cB, voffB); PG8_STAGE(PG8_SA(0, 0), cA, voffA); PG8_STAGE(PG8_SB(0, 1), cB + hstep, voffB); PG8_STAGE(PG8_SA(0, 1), cA + hstep, voffA);
        if (wr == 1) PG8_BAR;
        PG8_WAIT_V(4); PG8_BAR;
        PG8_STAGE(PG8_SB(1, 0), cB + kstep, voffB); PG8_STAGE(PG8_SA(1, 0), cA + kstep, voffA); PG8_STAGE(PG8_SB(1, 1), cB + hstep + kstep, voffB);
        PG8_WAIT_V(6); PG8_BAR;
    }
    for (;;) {
        const bool has_next = S.next(ui + 1, nxt);
        const char* nA = has_next ? (const char*)g.A + (size_t)nxt.pm * tstep : cA; const char* nB = has_next ? (const char*)g.Bt + (size_t)nxt.pn * tstep : cB;
        for (int t = 0; t < nt; t += 2) {
            const bool last = (t == nt - 2);
            const char* a1 = cA + (size_t)(t + 1) * kstep;
            const char* a2 = last ? nA : cA + (size_t)(t + 2) * kstep; const char* b2 = last ? nB : cB + (size_t)(t + 2) * kstep;
            const char* a3 = a2 + kstep; const char* b3 = b2 + kstep;
            if (last && has_next) S.a_ready(nxt);
            if constexpr (SP2) {
            PG8_LDB(B0, 0, 0); PG8_LDB(B1, 0, 1); PG8_SCHED; PG8_LDA(At, 0, 0); PG8_STAGE(PG8_SA(1, 1), a1 + hstep, voffA);
            PG8_WAIT_V(8); PG8_WAIT_L(0); PG8_BAR; PG8_MMA(0, 0, At, B0); PG8_MMA(0, 1, At, B1); PG8_BAR; PG8_SCHED;
            PG8_LDA(At, 0, 1); PG8_STAGE(PG8_SB(0, 0), b2, voffB); PG8_STAGE(PG8_SB(0, 1), b2 + hstep, voffB); PG8_STAGE(PG8_SA(0, 0), a2, voffA);
            PG8_WAIT_V(8); PG8_WAIT_L(0); PG8_BAR; PG8_MMA(1, 0, At, B0); PG8_MMA(1, 1, At, B1); PG8_BAR; PG8_SCHED;
            PG8_LDB(B0, 1, 0); PG8_LDB(B1, 1, 1); PG8_SCHED; PG8_LDA(At, 1, 0); PG8_STAGE(PG8_SA(0, 1), a2 + hstep, voffA);
            PG8_WAIT_V(8); PG8_WAIT_L(0); PG8_BAR; PG8_MMA(0, 0, At, B0); PG8_MMA(0, 1, At, B1); PG8_BAR; PG8_SCHED;
            PG8_LDA(At, 1, 1); PG8_STAGE(PG8_SB(1, 0), b3, voffB); PG8_STAGE(PG8_SB(1, 1), b3 + hstep, voffB); PG8_STAGE(PG8_SA(1, 0), a3, voffA);
            PG8_WAIT_V(8); PG8_WAIT_L(0); PG8_BAR; PG8_MMA(1, 0, At, B0); PG8_MMA(1, 1, At, B1); PG8_BAR; PG8_SCHED;
            } else {
            PG8_LDB(B0, 0, 0); PG8_SCHED; PG8_LDA(At, 0, 0); PG8_STAGE(PG8_SA(1, 1), a1 + hstep, voffA);
            PG8_WAIT_L(8); PG8_BAR; PG8_WAIT_L(0); PG8_MMA(0, 0, At, B0); PG8_BAR; PG8_SCHED;
            PG8_LDB(B1, 0, 1); PG8_STAGE(PG8_SB(0, 0), b2, voffB);
            PG8_BAR; PG8_WAIT_L(0); PG8_MMA(0, 1, At, B1); PG8_BAR;
            PG8_LDA(At, 0, 1); PG8_STAGE(PG8_SA(0, 0), a2, voffA);
            PG8_BAR; PG8_WAIT_L(0); PG8_MMA(1, 0, At, B0); PG8_BAR; PG8_SCHED;
            PG8_STAGE(PG8_SB(0, 1), b2 + hstep, voffB);
            PG8_WAIT_V(6); PG8_BAR; PG8_MMA(1, 1, At, B1); PG8_BAR;
            PG8_LDB(B0, 1, 0); PG8_SCHED; PG8_LDA(At, 1, 0); PG8_STAGE(PG8_SA(0, 1), a2 + hstep, voffA);
            PG8_WAIT_L(8); PG8_BAR; PG8_WAIT_L(0); PG8_MMA(0, 0, At, B0); PG8_BAR; PG8_SCHED;
            PG8_LDB(B1, 1, 1); PG8_STAGE(PG8_SB(1, 0), b3, voffB);
            PG8_BAR; PG8_WAIT_L(0); PG8_MMA(0, 1, At, B1); PG8_BAR;
            PG8_LDA(At, 1, 1); PG8_STAGE(PG8_SA(1, 0), a3, voffA);
            PG8_BAR; PG8_WAIT_L(0); PG8_MMA(1, 0, At, B0); PG8_BAR; PG8_SCHED;
            PG8_STAGE(PG8_SB(1, 1), b3 + hstep, voffB);
            PG8_WAIT_V(6); PG8_BAR; PG8_MMA(1, 1, At, B1); PG8_BAR;
            }
        }
        if constexpr (ALIGN_EPI) { if (wr == 0) PG8_BAR; }
        if constexpr (!Epi::AFTER_DRAIN) { E(acc, cur, wr, wc, fr, fq); S.done(cur); }
        if (!has_next) break;
#pragma unroll
        for (int a = 0; a < 2; ++a)
#pragma unroll
            for (int b = 0; b < 2; ++b)
#pragma unroll
                for (int m = 0; m < 4; ++m)
#pragma unroll
                    for (int n = 0; n < 2; ++n) acc[a][b][m][n] = (f32x4){0.f, 0.f, 0.f, 0.f};
        cur = nxt; cA = nA; cB = nB; ++ui;
        if constexpr (ALIGN_EPI) { if (wr == 1) PG8_BAR; }
    }
    PG8_WAIT_V(0);
    if constexpr (!ALIGN_EPI) { if (wr == 0) PG8_BAR; }
    PG8_BAR;
    if constexpr (Epi::AFTER_DRAIN) { E.fused(acc, cur, wr, wc, fr, fq, lds, wid, lane); S.done(cur); }
#undef PG8_SA
#undef PG8_SB
#undef PG8_STAGE
#undef PG8_LDA
#undef PG8_LDB
#undef PG8_MMA
#undef PG8_WAIT_V
#undef PG8_WAIT_L
#undef PG8_BAR
#undef PG8_SCHED
}
}
using pg8::bf16_t; using pg8::bf16x8; using pg8::f32x4; using pg8::u32x4; using pg8::cvt_pk_bf16; using pg8::f32x2;
#define LAS __attribute__((address_space(3)))
typedef unsigned u32x2 __attribute__((ext_vector_type(2)));
#define XB_TMO      128
#define XB_XCNT(j)  (256  + 64 * (j))
#define XB_XSUB(j)  (1280 + 64 * (j))
#define XB_XGEN(j)  (2304 + 64 * (j))
#define XB_TOP      3328
#define XB_TOPGEN   3392
#define XCD_BAR_WORDS 3456
#define XB_SPIN_CAP (1u << 18)

__device__ __forceinline__ unsigned xb_ld(unsigned* p)              { return __hip_atomic_load(p, __ATOMIC_RELAXED, __HIP_MEMORY_SCOPE_AGENT); }
__device__ __forceinline__ unsigned xb_add(unsigned* p, unsigned v) { return __hip_atomic_fetch_add(p, v, __ATOMIC_RELAXED, __HIP_MEMORY_SCOPE_AGENT); }
__device__ __forceinline__ unsigned xb_xcc_id() { return (unsigned)__builtin_amdgcn_s_getreg((3 << 11) | 20) & 0xFu; }
#define XB_SPIN(cond, bar) do { unsigned _sp = 0; while (cond) { __builtin_amdgcn_s_sleep(1); \
    if ((++_sp & 255u) == 0u) { if (xb_ld(&(bar)[XB_TMO])) break; if (_sp > XB_SPIN_CAP) { atomicAdd(&(bar)[XB_TMO], 1u); break; } } } } while (0)

struct XcdBarrier {
    unsigned* bar; unsigned x;
    volatile LAS unsigned* st;
};

__device__ __forceinline__ XcdBarrier xcd_barrier_post(unsigned* bar, volatile LAS unsigned* st) {
    XcdBarrier b; b.bar = bar; b.x = xb_xcc_id(); b.st = st;
    if (threadIdx.x == 0) (void)xb_add(&bar[XB_XCNT(b.x)], 1u);
    return b;
}
__device__ __forceinline__ void xcd_barrier_complete(unsigned* bar, unsigned x, unsigned& nloc, unsigned& nx) {
    const unsigned G = gridDim.x * gridDim.y * gridDim.z;
    unsigned sum, cnt, mine, sp = 0u;
    for (;;) {
        sum = 0u; cnt = 0u; mine = 0u;
#pragma unroll
        for (unsigned j = 0; j < 16; ++j) { const unsigned c = xb_ld(&bar[XB_XCNT(j)]); sum += c; cnt += (c > 0u) ? 1u : 0u; mine = (j == x) ? c : mine; }
        if (sum == G) break;
        __builtin_amdgcn_s_sleep(1);
        if ((++sp & 255u) == 0u) { if (xb_ld(&bar[XB_TMO])) break; if (sp > XB_SPIN_CAP) { atomicAdd(&bar[XB_TMO], 1u); break; } }
    }
    nloc = mine > 0u ? mine : 1u; nx = cnt > 0u ? cnt : 1u;
}

__device__ __forceinline__ void xcd_barrier(const XcdBarrier& b) {
    asm volatile("s_waitcnt vmcnt(0)" ::: "memory");
    __syncthreads();
    if (threadIdx.x == 0) {
        unsigned* bar = b.bar;
        __builtin_amdgcn_s_waitcnt(0);
        unsigned nloc = b.st[0], nx = b.st[1];
        if (nloc == 0u) { xcd_barrier_complete(bar, b.x, nloc, nx); b.st[0] = nloc; b.st[1] = nx; }
        const unsigned old = xb_add(&bar[XB_XSUB(b.x)], 1u);
        const unsigned gen = old / nloc;
        if (old + 1u == (gen + 1u) * nloc) {
            __builtin_amdgcn_fence(__ATOMIC_RELEASE, "agent");
            asm volatile("s_waitcnt vmcnt(0)" ::: "memory");
            const unsigned og = xb_add(&bar[XB_TOP], 1u);
            const unsigned tg = og / nx;
            if (og + 1u == (tg + 1u) * nx) xb_add(&bar[XB_TOPGEN], 1u);
            else XB_SPIN(xb_ld(&bar[XB_TOPGEN]) == tg, bar);
            __builtin_amdgcn_fence(__ATOMIC_ACQUIRE, "agent");
            xb_add(&bar[XB_XGEN(b.x)], 1u);
            asm volatile("s_waitcnt vmcnt(0)" ::: "memory");
        } else {
            XB_SPIN(xb_ld(&bar[XB_XGEN(b.x)]) == gen, bar);
            __builtin_amdgcn_fence(__ATOMIC_ACQUIRE, "agent");
            asm volatile("s_waitcnt vmcnt(0)" ::: "memory");
        }
    }
    __syncthreads();
}


#ifndef MK_PER_PHASE
#define MK_PER_PHASE 0
#endif
#define PROBE_MASK 0u
#define PROBE_N 0
#define PROBE_SYNC 0

constexpr int T_ = 16384, D_ = 1024, DFF = 2816, SEQ = 2048;
constexpr float EPS = 1e-6f;
constexpr size_t MiB = 1u << 20;
constexpr size_t WS_MOD = 0, WS_BAR = 768 * 1024, WS_LAML = 1 * MiB, WS_MW = 2 * MiB, WS_V = 14 * MiB, WS_WIN = 18 * MiB, WS_WOUT = 62 * MiB, WS_ABIN = 84 * MiB,
                 WS_ABOUT = 87 * MiB, WS_SSMIN = 89 * MiB, WS_GLU = 91 * MiB, WS_SMALL = 95 * MiB, WS_H = 96 * MiB, WS_F = 128 * MiB, WS_ACT = 160 * MiB,
                 WS_XB = 248 * MiB, WS_END = 280 * MiB;
constexpr size_t WS_Z = WS_ACT, WS_YCAT = WS_ACT + 48 * MiB;
constexpr size_t WS_U = WS_ACT, WS_YI = WS_ACT + 32 * MiB, WS_XS = WS_ACT + 64 * MiB, WS_G = WS_H, WS_SST = WS_F;
constexpr int LDS_BYTES = 135168;
constexpr int NPH = 24;

struct Args { const float* in[26]; float* out; unsigned char* ws; int ph_lo, ph_hi; };

__device__ __forceinline__ float wave_sum(float v) {
#pragma unroll
    for (int o = 1; o < 64; o <<= 1) v += __shfl_xor(v, o);
    return v;
}
__device__ __forceinline__ float bf2f(unsigned b) { return __uint_as_float(b << 16); }
__device__ __forceinline__ unsigned f2bf(float f) { unsigned u = __float_as_uint(f); return (u + 0x7fffu + ((u >> 16) & 1u)) >> 16; }
__device__ __forceinline__ f32x4 ld4bf(const bf16_t* p) { const u32x2 v = *(const u32x2*)p; f32x4 r; r.x = __uint_as_float(v.x << 16); r.y = __uint_as_float(v.x & 0xffff0000u); r.z = __uint_as_float(v.y << 16); r.w = __uint_as_float(v.y & 0xffff0000u); return r; }
__device__ __forceinline__ void st4bf(bf16_t* p, f32x4 v) { u32x2 w; w.x = cvt_pk_bf16(v.x, v.y); w.y = cvt_pk_bf16(v.z, v.w); *(u32x2*)p = w; }
__device__ __forceinline__ float gelu_tanh(float x) { const float t = 1.5957691216f * (x + 0.044715f * x * x * x); return x * __builtin_amdgcn_rcpf(1.0f + __expf(-t)); }

template <int MODE> struct EpiGated {
    static constexpr bool PERM = true, AFTER_DRAIN = false;
    bf16_t* O; int ldc;
    __device__ __forceinline__ void operator()(const f32x4 (&acc)[2][2][4][2], const pg8::Unit& u, int wr, int wc, int fr, int fq) const {
        const int row0 = u.pm * 256 + wr * 64 + fr, col0 = u.pn * 128 + wc * 32 + 8 * fq;
#pragma unroll
        for (int ai = 0; ai < 2; ++ai)
#pragma unroll
            for (int m = 0; m < 4; ++m) {
                bf16_t* rowp = O + (size_t)(row0 + ai * 128 + m * 16) * ldc + col0;
                float v[8];
#pragma unroll
                for (int n = 0; n < 2; ++n)
#pragma unroll
                    for (int i = 0; i < 4; ++i) { const float a = acc[ai][0][m][n][i], b = acc[ai][1][m][n][i];
                        v[n * 4 + i] = (MODE == 0) ? a * b * __builtin_amdgcn_rcpf(1.0f + __expf(-a)) : a * __builtin_amdgcn_rcpf(1.0f + __expf(-b)); }
                u32x4 w; w.x = cvt_pk_bf16(v[0], v[1]); w.y = cvt_pk_bf16(v[2], v[3]); w.z = cvt_pk_bf16(v[4], v[5]); w.w = cvt_pk_bf16(v[6], v[7]);
                *(u32x4*)rowp = w;
            }
    }
};
struct EpiPlain {
    static constexpr bool PERM = true, AFTER_DRAIN = false;
    bf16_t* O; int ldc; int gelu_from;
    __device__ __forceinline__ void operator()(const f32x4 (&acc)[2][2][4][2], const pg8::Unit& u, int wr, int wc, int fr, int fq) const {
        const int row0 = u.pm * 256 + wr * 64 + fr, col0 = u.pn * 256 + wc * 32 + 8 * fq; const bool gl = u.pn >= gelu_from;
#pragma unroll
        for (int ai = 0; ai < 2; ++ai)
#pragma unroll
            for (int m = 0; m < 4; ++m) {
                bf16_t* rowp = O + (size_t)(row0 + ai * 128 + m * 16) * ldc + col0;
#pragma unroll
                for (int bj = 0; bj < 2; ++bj) { f32x4 v0 = acc[ai][bj][m][0], v1 = acc[ai][bj][m][1];
                    if (gl) {
#pragma unroll
                        for (int i = 0; i < 4; ++i) { v0[i] = gelu_tanh(v0[i]); v1[i] = gelu_tanh(v1[i]); } }
                    u32x4 w; w.x = cvt_pk_bf16(v0[0], v0[1]); w.y = cvt_pk_bf16(v0[2], v0[3]); w.z = cvt_pk_bf16(v1[0], v1[1]); w.w = cvt_pk_bf16(v1[2], v1[3]);
                    *(u32x4*)(rowp + bj * 128) = w; }
            }
    }
};

struct TItem { const float* src; bf16_t* dst; int N, K; };
__device__ __forceinline__ TItem t_decode(const Args& a, unsigned char* ws, int r) {
    constexpr int I_IN = 16 * 176, I_OUT = 44 * 32, I_ABIN = 16 * 48, I_SQ = 16 * 32;
    const float* W; bf16_t* WT; int K, N, mode = 0;
    if (r < 4 * I_IN) { const int w = r / I_IN; r -= w * I_IN; W = a.in[6] + (size_t)w * 1024 * 5632; K = 1024; N = 5632; WT = (bf16_t*)(ws + WS_WIN) + (size_t)w * 5632 * 1024; mode = 1; }
    else if ((r -= 4 * I_IN) < 4 * I_OUT) { const int w = r / I_OUT; r -= w * I_OUT; W = a.in[7] + (size_t)w * 2816 * 1024; K = 2816; N = 1024; WT = (bf16_t*)(ws + WS_WOUT) + (size_t)w * 1024 * 2816; }
    else if ((r -= 4 * I_OUT) < I_ABIN) { W = a.in[8]; K = 1024; N = 1536; WT = (bf16_t*)(ws + WS_ABIN); }
    else if ((r -= I_ABIN) < I_SQ) { W = a.in[15]; K = 1024; N = 1024; WT = (bf16_t*)(ws + WS_ABOUT); }
    else if ((r -= I_SQ) < I_SQ) { W = a.in[16]; K = 1024; N = 1024; WT = (bf16_t*)(ws + WS_SSMIN); }
    else { r -= I_SQ; W = a.in[25]; K = 1024; N = 2048; WT = (bf16_t*)(ws + WS_GLU); mode = 1; }
    const int nblk = N / 32, kb = r / nblk, nb = r % nblk, k0 = 64 * kb, n0 = 32 * nb;
    int r0 = n0;
    if (mode) { const int half = N >> 1, hf = (n0 >= half) ? 1 : 0, j = n0 - hf * half; r0 = (j >> 7) * 256 + hf * 128 + (j & 127); }
    TItem t; t.src = W + (size_t)k0 * N + n0; t.dst = WT + (size_t)r0 * K + k0; t.N = N; t.K = K; return t;
}
__device__ __forceinline__ int t_remap(const int set, const int d) {
    if (set == 0) return d < 2816 ? d : 11264 + (d - 2816);
    if (set == 1) return d < 2816 ? 2816 + d : (d < 4224 ? 11264 + 1408 + (d - 2816) : 16896 + (d - 4224));
    if (set == 2) return d < 2816 ? 5632 + d : (d < 4224 ? 11264 + 2816 + (d - 2816) : 18176 + (d - 4224));
    return d < 2816 ? 8448 + d : 11264 + 4224 + (d - 2816);
}
__device__ __forceinline__ void t_run(const Args& a, unsigned char* ws, LAS unsigned char* L, const int wave, const int lane, const int set, const int worker, const int nworkers) {
    const int NIT = (set == 0) ? 4224 : (set == 1) ? 5504 : (set == 2) ? 5760 : 4224;
    LAS float* scr = (LAS float*)(L + wave * 8448);
    int it = worker; TItem cur, nxt; float tv[32];
    if (it < NIT) { cur = t_decode(a, ws, t_remap(set, it));
#pragma unroll
        for (int i = 0; i < 32; ++i) tv[i] = cur.src[(size_t)(2 * i + (lane >> 5)) * cur.N + (lane & 31)]; }
    while (it < NIT) {
#pragma unroll
        for (int i = 0; i < 32; ++i) scr[(2 * i + (lane >> 5)) * 33 + (lane & 31)] = tv[i];
        const int itn = it + nworkers;
        if (itn < NIT) { nxt = t_decode(a, ws, t_remap(set, itn));
#pragma unroll
            for (int i = 0; i < 32; ++i) tv[i] = nxt.src[(size_t)(2 * i + (lane >> 5)) * nxt.N + (lane & 31)]; }
        asm volatile("s_waitcnt lgkmcnt(0)" ::: "memory");
        const int cc = lane & 7;
#pragma unroll
        for (int j = 0; j < 4; ++j) { const int n = (lane >> 3) + 8 * j; const LAS float* s = scr + (8 * cc) * 33 + n;
            u32x4 o; o.x = cvt_pk_bf16(s[0 * 33], s[1 * 33]); o.y = cvt_pk_bf16(s[2 * 33], s[3 * 33]); o.z = cvt_pk_bf16(s[4 * 33], s[5 * 33]); o.w = cvt_pk_bf16(s[6 * 33], s[7 * 33]);
            *(u32x4*)(cur.dst + (size_t)n * cur.K + 8 * cc) = o; }
        asm volatile("s_waitcnt lgkmcnt(0)" ::: "memory");
        cur = nxt; it = itn; }
}

__device__ __forceinline__ void ssm_precompute(const int tidv, int g, const int part, const float* lam_re, const float* lam_im, const float* b_re, const float* b_im, const float* c_re, const float* c_im,
                                               const float* log_dt, const float* dskip, bf16_t* MW, bf16_t* V, float* lamL, LAS unsigned char* L) {
    LAS float* pw = (LAS float*)L;
    LAS float* Bb = pw + 17 * 64 * 2;
    LAS float* Cc = Bb + 2048;
    LAS float* Kk = Cc + 2080;
    const int tid = tidv;
    const float dt = expf(log_dt[g]);
    for (int idx = tid; idx < 17 * 64; idx += 512) { const int j = idx >> 6, p = idx & 63; const float lr = lam_re[g * 64 + p], li = lam_im[g * 64 + p];
        const float mag = expf((float)j * dt * lr); double rev = (double)j * (double)dt * (double)li * 0.15915494309189535; rev -= rint(rev);
        const float ang = (float)(rev * 6.283185307179586); pw[idx * 2] = mag * __cosf(ang); pw[idx * 2 + 1] = mag * __sinf(ang); }
    for (int idx = tid; idx < 1024; idx += 512) { const int p = idx >> 4; const float lr = lam_re[g * 64 + p], li = lam_im[g * 64 + p];
        const float mag = expf(dt * lr); double rev = (double)dt * (double)li * 0.15915494309189535; rev -= rint(rev); const float ang = (float)(rev * 6.283185307179586);
        const float er = mag * __cosf(ang) - 1.0f, ei = mag * __sinf(ang);
        const float den = 1.0f / (lr * lr + li * li); const float qr = (er * lr + ei * li) * den, qi = (ei * lr - er * li) * den;
        const float br = b_re[g * 1024 + idx], bi = b_im[g * 1024 + idx];
        Bb[idx * 2] = qr * br - qi * bi; Bb[idx * 2 + 1] = qr * bi + qi * br; }
    for (int idx = tid; idx < 1024; idx += 512) { const int n = idx >> 6, p = idx & 63; Cc[(n * 65 + p) * 2] = c_re[g * 1024 + idx]; Cc[(n * 65 + p) * 2 + 1] = c_im[g * 1024 + idx]; }
    __syncthreads();
    { const int j = tid >> 5, n = (tid >> 1) & 15, mh = tid & 1; float s[8];
#pragma unroll
      for (int e2 = 0; e2 < 8; ++e2) s[e2] = 0.f;
      for (int p = 0; p < 64; ++p) { const f32x2 cv = *(const LAS f32x2*)(Cc + (n * 65 + p) * 2), pv = *(const LAS f32x2*)(pw + (j * 64 + p) * 2);
          const float xr = cv.x * pv.x - cv.y * pv.y, xi = cv.x * pv.y + cv.y * pv.x;
#pragma unroll
          for (int e2 = 0; e2 < 4; ++e2) { const f32x4 bb = *(const LAS f32x4*)(Bb + (p * 16 + mh * 8 + 2 * e2) * 2); s[2 * e2] += xr * bb.x - xi * bb.y; s[2 * e2 + 1] += xr * bb.z - xi * bb.w; } }
#pragma unroll
      for (int e2 = 0; e2 < 8; ++e2) Kk[(j * 16 + n) * 16 + mh * 8 + e2] = s[e2]; }
    __syncthreads();
    bf16_t* MVg = MW + (size_t)g * 256 * 384; bf16_t* Wg = V + (size_t)g * 128 * 256;
    for (int q = part * 8192 + tid; q < (part + 1) * 8192; q += 512) { const int row = q >> 7, c2 = (q & 127) * 2; const int t = row >> 4, n = row & 15, s = c2 >> 4, m = c2 & 15;
        float v0 = 0.f, v1 = 0.f; if (s <= t) { v0 = Kk[((t - s) * 16 + n) * 16 + m]; v1 = Kk[((t - s) * 16 + n) * 16 + m + 1]; }
        if (s == t) { if (m == n) v0 += dskip[g * 16 + n]; if (m + 1 == n) v1 += dskip[g * 16 + n]; }
        *(unsigned*)(MVg + row * 384 + c2) = cvt_pk_bf16(v0, v1); }
    for (int q = part * 4096 + tid; q < (part + 1) * 4096; q += 512) { const int r = q >> 7, c2 = (q & 127) * 2; const int p = r >> 1, ri = r & 1, s = c2 >> 4, m = c2 & 15;
        const float pr = pw[((15 - s) * 64 + p) * 2], pi = pw[((15 - s) * 64 + p) * 2 + 1]; float v[2];
#pragma unroll
        for (int e = 0; e < 2; ++e) { const float br = Bb[(p * 16 + m + e) * 2], bi = Bb[(p * 16 + m + e) * 2 + 1]; v[e] = ri ? (pr * bi + pi * br) : (pr * br - pi * bi); }
        *(unsigned*)(Wg + r * 256 + c2) = cvt_pk_bf16(v[0], v[1]); }
    for (int q = part * 4096 + tid; q < (part + 1) * 4096; q += 512) { const int row = q >> 6, p = q & 63; const int t = row >> 4, n = row & 15;
        const float cr = Cc[(n * 65 + p) * 2], ci = Cc[(n * 65 + p) * 2 + 1], pr = pw[((t + 1) * 64 + p) * 2], pi = pw[((t + 1) * 64 + p) * 2 + 1];
        *(unsigned*)(MVg + row * 384 + 256 + 2 * p) = cvt_pk_bf16(cr * pr - ci * pi, -(cr * pi + ci * pr)); }
    if (part == 0 && tid < 64) { lamL[(g * 64 + tid) * 2] = pw[(16 * 64 + tid) * 2]; lamL[(g * 64 + tid) * 2 + 1] = pw[(16 * 64 + tid) * 2 + 1]; }
}

__device__ __forceinline__ void p0_phase(const int tidv, const Args& a, LAS unsigned char* L, const bool do_mod) {
    const int tid = tidv, lane = tid & 63, wave = __builtin_amdgcn_readfirstlane(tid >> 6), G = gridDim.x, bx = blockIdx.x;
    unsigned char* ws = a.ws;
    for (int gi = bx; gi < 256; gi += G) { const int g = gi >> 2;
        ssm_precompute(tidv, g, gi & 3, a.in[17], a.in[18], a.in[19], a.in[20], a.in[21], a.in[22], a.in[24], a.in[23], (bf16_t*)(ws + WS_MW), (bf16_t*)(ws + WS_V), (float*)(ws + WS_LAML), L);
        __syncthreads(); }
    { bf16_t* pwt = (bf16_t*)(ws + WS_SMALL); bf16_t* sgw = pwt + 65536; const float* pool_w = a.in[9]; const float* sgu_w = a.in[13];
      for (int i = bx * 512 + tid; i < 65536; i += G * 512) { const int gg = i >> 14, o = (i >> 7) & 127, ii = i & 127;
          pwt[i] = (bf16_t)f2bf(pool_w[(gg * 128 + ii) * 128 + o]); sgw[i] = (ii <= o) ? (bf16_t)f2bf(sgu_w[i]) : (bf16_t)0; } }
    { LAS float* cond = (LAS float*)L; const float* c = a.in[1];
      for (int i = tid; i < 8192; i += 512) { const float v = c[i]; cond[i] = v / (1.0f + __expf(-v)); }
      __syncthreads();
      float* mod = (float*)(ws + WS_MOD); const float* ada_w = a.in[2]; const float* ada_b = a.in[3];
      LAS float* red = cond + 8192;
      if (do_mod) for (int it = bx; it < 256; it += G) { const int l = it >> 7, col0 = (it & 127) * 72, c4 = tid % 18, ks = tid / 18;
          f32x4 acc[8];
#pragma unroll
          for (int b = 0; b < 8; ++b) acc[b] = (f32x4){0.f, 0.f, 0.f, 0.f};
          if (ks < 28) {
              const float* wp = ada_w + (size_t)l * 1024 * 9216 + col0 + 4 * c4;
#pragma unroll 4
              for (int k = ks; k < 1024; k += 28) { const f32x4 w = *(const f32x4*)(wp + (size_t)k * 9216);
#pragma unroll
                  for (int b = 0; b < 8; ++b) acc[b] = acc[b] + w * cond[b * 1024 + k]; }
#pragma unroll
              for (int b = 0; b < 8; ++b) *(LAS f32x4*)(red + (ks * 8 + b) * 72 + 4 * c4) = acc[b]; }
          __syncthreads();
          for (int o = tid; o < 576; o += 512) { const int b = o / 72, cc = o % 72; float s = ada_b[l * 9216 + col0 + cc];
              for (int k2 = 0; k2 < 28; ++k2) s += red[(k2 * 8 + b) * 72 + cc];
              mod[((size_t)l * 8 + b) * 9216 + col0 + cc] = s; }
          __syncthreads(); }
      __syncthreads(); }
    t_run(a, ws, L, wave, lane, 0, bx * 8 + wave, G * 8);
}

template <bool HAS_PREV, bool HAS_NEXT, bool XIN_BF, bool XOUT_BF>
__device__ __forceinline__ void r_phase(const int tidv, const void* xin_, const bf16_t* f, void* xout_, bf16_t* h, const float* gpost, const float* modprev, float rw, const float* gpre, const float* modnext) {
    const int tid = tidv, lane = tid & 63, wave = tid >> 6; const int gw = blockIdx.x * 8 + wave, NGW = gridDim.x * 8;
    for (int rb = gw; rb < T_ / 8; rb += NGW) {
        const int r0 = rb * 8, b = r0 / SEQ;
        f32x4 A1[4], A2[4], A3[4];
#pragma unroll
        for (int c = 0; c < 4; ++c) { const int col = c * 256 + lane * 4;
            if (HAS_PREV) { const f32x4 gp = *(const f32x4*)(gpost + col), gt = *(const f32x4*)(modprev + (size_t)b * 9216 + 2048 + col); A1[c] = gp * gt * rw; }
            if (HAS_NEXT) { const f32x4 gq = *(const f32x4*)(gpre + col), sc = *(const f32x4*)(modnext + (size_t)b * 9216 + 1024 + col); A2[c] = gq * (sc + 1.0f); A3[c] = *(const f32x4*)(modnext + (size_t)b * 9216 + col); } }
        for (int r = r0; r < r0 + 8; ++r) {
            f32x4 xv[4];
#pragma unroll
            for (int c = 0; c < 4; ++c) { if (XIN_BF) xv[c] = ld4bf((const bf16_t*)xin_ + (size_t)r * D_ + c * 256 + lane * 4); else xv[c] = *(const f32x4*)((const float*)xin_ + (size_t)r * D_ + c * 256 + lane * 4); }
            if (HAS_PREV) { f32x4 fv[4]; float ss = 0.f;
#pragma unroll
                for (int c = 0; c < 4; ++c) { fv[c] = ld4bf(f + (size_t)r * D_ + c * 256 + lane * 4); ss += fv[c].x * fv[c].x + fv[c].y * fv[c].y + fv[c].z * fv[c].z + fv[c].w * fv[c].w; }
                const float rs = rsqrtf(wave_sum(ss) * (1.0f / D_) + EPS);
#pragma unroll
                for (int c = 0; c < 4; ++c) { xv[c] = xv[c] + A1[c] * fv[c] * rs;
                    if (XOUT_BF) st4bf((bf16_t*)xout_ + (size_t)r * D_ + c * 256 + lane * 4, xv[c]); else *(f32x4*)((float*)xout_ + (size_t)r * D_ + c * 256 + lane * 4) = xv[c]; } }
            if (HAS_NEXT) { float ss = 0.f;
#pragma unroll
                for (int c = 0; c < 4; ++c) ss += xv[c].x * xv[c].x + xv[c].y * xv[c].y + xv[c].z * xv[c].z + xv[c].w * xv[c].w;
                const float rs = rsqrtf(wave_sum(ss) * (1.0f / D_) + EPS);
#pragma unroll
                for (int c = 0; c < 4; ++c) st4bf(h + (size_t)r * D_ + c * 256 + lane * 4, xv[c] * rs * A2[c] + A3[c]); }
        }
    }
}

template <int W> __device__ __forceinline__ void pool_prep(const int tid, const int q, const bf16_t* z, const int row0, const int g, LAS unsigned char* As) {
    const int i4 = tid & 31, t0 = (tid >> 5) * 8, pos0 = (q & 15) * 128 + t0;
    const bf16_t* zp = z + (size_t)(row0 + t0) * 1536 + g * 128 + 4 * i4;
    u32x2 raw[W + 7];
#pragma unroll
    for (int i = 0; i < W + 7; ++i) { const int rel = i - (W - 1); const bool valid = (pos0 + rel) >= 0; raw[i] = *(const u32x2*)(zp + (ptrdiff_t)(valid ? rel : 0) * 1536); if (!valid) { raw[i].x = 0u; raw[i].y = 0u; } }
    f32x4 sum = {0.f, 0.f, 0.f, 0.f};
#define UNPK(v) ((f32x4){__uint_as_float((v).x << 16), __uint_as_float((v).x & 0xffff0000u), __uint_as_float((v).y << 16), __uint_as_float((v).y & 0xffff0000u)})
#pragma unroll
    for (int i = 0; i < W - 1; ++i) sum = sum + UNPK(raw[i]);
#pragma unroll
    for (int r = 0; r < 8; ++r) { const f32x4 cur = UNPK(raw[W - 1 + r]); sum = sum + cur; if (r > 0) sum = sum - UNPK(raw[r - 1]);
        const float inv = 1.0f / (float)min(pos0 + r + 1, W); const f32x4 d = sum * inv - cur;
        u32x2 o; o.x = cvt_pk_bf16(d.x, d.y); o.y = cvt_pk_bf16(d.z, d.w); *(LAS u32x2*)(As + (t0 + r) * 272 + 8 * i4) = o; }
#undef UNPK
}
__device__ __forceinline__ void mix0_phase(const int tidv, const bf16_t* z, const bf16_t* pool_wt, const float* pool_scale, const float* ln_g, const float* ln_b, const bf16_t* sguw, const float* sgu_b,
                                           bf16_t* ycat, LAS unsigned char* L) {
    LAS unsigned char* As = L; LAS unsigned char* Bs = L + 34816; LAS float* st = (LAS float*)(L + 69632);
    const int tid = tidv, lane = tid & 63, wave = __builtin_amdgcn_readfirstlane(tid >> 6), fr = lane & 15, fq = lane >> 4;
    for (int it = blockIdx.x; it < 1024; it += gridDim.x) {
        const int q = it >> 3, unit = (it & 7) ^ (((it / (int)gridDim.x) & 1) << 2), row0 = q * 128;
        __syncthreads();
        if (unit < 4) {
            const int g = unit;
            if (g == 0) pool_prep<2>(tid, q, z, row0, g, As); else if (g == 1) pool_prep<4>(tid, q, z, row0, g, As); else if (g == 2) pool_prep<8>(tid, q, z, row0, g, As); else pool_prep<16>(tid, q, z, row0, g, As);
#pragma unroll
            for (int e = 0; e < 4; ++e) { const int idx = tid + e * 512, r = idx >> 4, c = idx & 15; *(LAS u32x4*)(Bs + r * 272 + c * 16) = *(const u32x4*)(pool_wt + g * 16384 + r * 128 + c * 8); }
        } else {
            const int hh = unit - 4;
#pragma unroll
            for (int e = 0; e < 4; ++e) { const int idx = tid + e * 512, r = idx >> 4, c = idx & 15; *(LAS u32x4*)(As + r * 272 + c * 16) = *(const u32x4*)(sguw + hh * 16384 + r * 128 + c * 8); }
            unsigned vraw[16];
#pragma unroll
            for (int i = 0; i < 16; ++i) vraw[i] = *(const unsigned*)(z + (size_t)(row0 + wave * 16 + i) * 1536 + 1024 + hh * 128 + 2 * lane);
#pragma unroll
            for (int i = 0; i < 16; ++i) { const int s = wave * 16 + i; const unsigned vv = vraw[i];
                const float v0 = __uint_as_float(vv << 16), v1 = __uint_as_float(vv & 0xffff0000u); const float mean = wave_sum(v0 + v1) * (1.0f / 128.0f);
                const float d0 = v0 - mean, d1 = v1 - mean; const float var = wave_sum(d0 * d0 + d1 * d1) * (1.0f / 128.0f);
                if (lane == 0) { st[s * 2] = mean; st[s * 2 + 1] = rsqrtf(var + EPS); } }
            __syncthreads();
            const int d = tid & 127, sg = tid >> 7; const float gln = ln_g[hh * 128 + d], bln = ln_b[hh * 128 + d];
#pragma unroll
            for (int sb = 0; sb < 4; ++sb) { const int s0 = sg * 32 + sb * 8; float vn[8];
#pragma unroll
                for (int k = 0; k < 8; ++k) { const float v = bf2f(z[(size_t)(row0 + s0 + k) * 1536 + 1024 + hh * 128 + d]); vn[k] = (v - st[(s0 + k) * 2]) * st[(s0 + k) * 2 + 1] * gln + bln; }
                u32x4 o; o.x = cvt_pk_bf16(vn[0], vn[1]); o.y = cvt_pk_bf16(vn[2], vn[3]); o.z = cvt_pk_bf16(vn[4], vn[5]); o.w = cvt_pk_bf16(vn[6], vn[7]);
                *(LAS u32x4*)(Bs + d * 272 + s0 * 2) = o; }
        }
        __syncthreads();
        const int wr = wave >> 1, wc = wave & 1;
        f32x4 acc[2][4];
#pragma unroll
        for (int m = 0; m < 2; ++m)
#pragma unroll
            for (int n = 0; n < 4; ++n) acc[m][n] = (f32x4){0.f, 0.f, 0.f, 0.f};
#pragma unroll
        for (int kk = 0; kk < 4; ++kk) { bf16x8 Af[2];
#pragma unroll
            for (int m = 0; m < 2; ++m) Af[m] = *(const LAS bf16x8*)(As + (32 * wr + 16 * m + fr) * 272 + kk * 64 + fq * 16);
#pragma unroll
            for (int n = 0; n < 4; ++n) { const bf16x8 Bf = *(const LAS bf16x8*)(Bs + (64 * wc + 16 * n + fr) * 272 + kk * 64 + fq * 16);
#pragma unroll
                for (int m = 0; m < 2; ++m) acc[m][n] = __builtin_amdgcn_mfma_f32_16x16x32_bf16(Bf, Af[m], acc[m][n], 0, 0, 0); } }
#pragma unroll
        for (int m = 0; m < 2; ++m) { const int row = 32 * wr + 16 * m + fr;
#pragma unroll
            for (int n = 0; n < 4; ++n) { const int col = 64 * wc + 16 * n + 4 * fq;
                if (unit < 4) { const f32x4 sc = *(const f32x4*)(pool_scale + unit * 128 + col); st4bf(ycat + (size_t)(row0 + row) * 1024 + unit * 128 + col, acc[m][n] * sc); }
                else { const int hh = unit - 4; const f32x4 uu = ld4bf(z + (size_t)(row0 + row) * 1536 + 512 + hh * 128 + col); const float bs = sgu_b[hh * 128 + row];
                    st4bf(ycat + (size_t)(row0 + row) * 1024 + 512 + hh * 128 + col, uu * (acc[m][n] + bs)); } } }
    }
}

__device__ __forceinline__ void s1_phase(const int tidv, const bf16_t* u, const bf16_t* Wm, float* Sst, LAS unsigned char* L) {
    const int tid = tidv, lane = tid & 63, wave = __builtin_amdgcn_readfirstlane(tid >> 6), fr = lane & 15, fq = lane >> 4;
    for (int it = blockIdx.x; it < 256; it += gridDim.x) {
        const int g = it >> 2, cb = it & 3, colw = cb * 256 + wave * 32;
        bf16x8 Bf[2][8];
#pragma unroll
        for (int nt = 0; nt < 2; ++nt)
#pragma unroll
            for (int kk = 0; kk < 8; ++kk) { const int col = colw + nt * 16 + fr; Bf[nt][kk] = *(const bf16x8*)(u + ((size_t)col * 16 + 2 * kk + (fq >> 1)) * 1024 + g * 16 + (fq & 1) * 8); }
        __syncthreads();
#pragma unroll
        for (int e = 0; e < 8; ++e) { const int idx = tid + e * 512, r = idx >> 5, c = idx & 31; *(LAS u32x4*)(L + r * 528 + c * 16) = *(const u32x4*)(Wm + ((size_t)g * 128 + r) * 256 + c * 8); }
        __syncthreads();
        f32x4 acc[8][2];
#pragma unroll
        for (int mt = 0; mt < 8; ++mt) { acc[mt][0] = (f32x4){0.f, 0.f, 0.f, 0.f}; acc[mt][1] = (f32x4){0.f, 0.f, 0.f, 0.f}; }
#pragma unroll
        for (int mt = 0; mt < 8; ++mt)
#pragma unroll
            for (int kk = 0; kk < 8; ++kk) { const bf16x8 Af = *(const LAS bf16x8*)(L + (mt * 16 + fr) * 528 + kk * 64 + fq * 16);
                acc[mt][0] = __builtin_amdgcn_mfma_f32_16x16x32_bf16(Af, Bf[0][kk], acc[mt][0], 0, 0, 0);
                acc[mt][1] = __builtin_amdgcn_mfma_f32_16x16x32_bf16(Af, Bf[1][kk], acc[mt][1], 0, 0, 0); }
#pragma unroll
        for (int mt = 0; mt < 8; ++mt)
#pragma unroll
            for (int nt = 0; nt < 2; ++nt) { const int col = colw + nt * 16 + fr; *(f32x4*)(Sst + ((size_t)col * 64 + g) * 128 + mt * 16 + fq * 4) = acc[mt][nt]; }
    }
}
__device__ __forceinline__ void s2_phase(const int tidv, const float* Sst, const float* lamL, bf16_t* Xs) {
    if (tidv < 128) for (int gt = blockIdx.x * 128 + tidv; gt < 32768; gt += gridDim.x * 128) {
        const int b = gt >> 12, gp = gt & 4095; const float lr = lamL[gp * 2], li = lamL[gp * 2 + 1]; float xr = 0.f, xi = 0.f;
        for (int cb = 0; cb < 4; ++cb) { f32x2 sv[32];
#pragma unroll
            for (int c = 0; c < 32; ++c) sv[c] = *(const f32x2*)(Sst + ((size_t)(b * 128 + cb * 32 + c) * 4096 + gp) * 2);
#pragma unroll
            for (int c = 0; c < 32; ++c) { const size_t idx = ((size_t)(b * 128 + cb * 32 + c) * 4096 + gp) * 2; *(unsigned*)(Xs + idx) = cvt_pk_bf16(xr, xi);
                const float nr = lr * xr - li * xi + sv[c].x, ni = lr * xi + li * xr + sv[c].y; xr = nr; xi = ni; } }
    }
}
template <int HF> __device__ __forceinline__ void s3_half(const int tid, const int fr, const int fq, const int g, const int colw, const bf16_t* MV, const bf16x8 (&Bu)[2][8], const bf16x8 (&Bx)[2][4], bf16_t* gout, LAS unsigned char* L) {
    __syncthreads();
#pragma unroll
    for (int eb = 0; eb < 3; ++eb) {
#pragma unroll
        for (int e = 0; e < 4; ++e) { const int idx = tid + (eb * 4 + e) * 512, r = idx / 48, c = idx % 48; *(LAS u32x4*)(L + r * 784 + c * 16) = *(const u32x4*)(MV + ((size_t)g * 256 + HF * 128 + r) * 384 + c * 8); }
        asm volatile("" ::: "memory"); }
    __syncthreads();
#pragma unroll
    for (int mg = 0; mg < 2; ++mg) {
        f32x4 acc[4][2];
#pragma unroll
        for (int mt = 0; mt < 4; ++mt) { acc[mt][0] = (f32x4){0.f, 0.f, 0.f, 0.f}; acc[mt][1] = (f32x4){0.f, 0.f, 0.f, 0.f}; }
#pragma unroll
        for (int mt = 0; mt < 4; ++mt) {
#pragma unroll
            for (int kk = 0; kk < 12; ++kk) { if (kk < 8 && kk > ((HF * 8 + mg * 4 + mt) >> 1)) continue;
                const bf16x8 Af = *(const LAS bf16x8*)(L + ((mg * 4 + mt) * 16 + fr) * 784 + kk * 64 + fq * 16);
                if (kk < 8) { acc[mt][0] = __builtin_amdgcn_mfma_f32_16x16x32_bf16(Af, Bu[0][kk < 8 ? kk : 0], acc[mt][0], 0, 0, 0); acc[mt][1] = __builtin_amdgcn_mfma_f32_16x16x32_bf16(Af, Bu[1][kk < 8 ? kk : 0], acc[mt][1], 0, 0, 0); }
                else { acc[mt][0] = __builtin_amdgcn_mfma_f32_16x16x32_bf16(Af, Bx[0][kk >= 8 ? kk - 8 : 0], acc[mt][0], 0, 0, 0); acc[mt][1] = __builtin_amdgcn_mfma_f32_16x16x32_bf16(Af, Bx[1][kk >= 8 ? kk - 8 : 0], acc[mt][1], 0, 0, 0); } } }
#pragma unroll
        for (int mt = 0; mt < 4; ++mt)
#pragma unroll
            for (int nt = 0; nt < 2; ++nt) { const int col = colw + nt * 16 + fr, t = HF * 8 + mg * 4 + mt; const size_t o = ((size_t)col * 16 + t) * 1024 + g * 16 + fq * 4; f32x4 r;
#pragma unroll
                for (int i = 0; i < 4; ++i) r[i] = gelu_tanh(acc[mt][nt][i]);
                st4bf(gout + o, r); }
    }
}
__device__ __forceinline__ void s3_phase(const int tidv, const bf16_t* Xs, const bf16_t* MV, const bf16_t* u, bf16_t* gout, LAS unsigned char* L) {
    const int tid = tidv, lane = tid & 63, wave = __builtin_amdgcn_readfirstlane(tid >> 6), fr = lane & 15, fq = lane >> 4;
    for (int it = blockIdx.x; it < 256; it += gridDim.x) {
        const int g = it >> 2, cb = it & 3, colw = cb * 256 + wave * 32;
        bf16x8 Bu[2][8], Bx[2][4];
#pragma unroll
        for (int nt = 0; nt < 2; ++nt) { const int col = colw + nt * 16 + fr;
#pragma unroll
            for (int kk = 0; kk < 8; ++kk) Bu[nt][kk] = *(const bf16x8*)(u + ((size_t)col * 16 + 2 * kk + (fq >> 1)) * 1024 + g * 16 + (fq & 1) * 8);
#pragma unroll
            for (int kk = 0; kk < 4; ++kk) Bx[nt][kk] = *(const bf16x8*)(Xs + ((size_t)col * 64 + g) * 128 + kk * 32 + fq * 8); }
        s3_half<0>(tid, fr, fq, g, colw, MV, Bu, Bx, gout, L);
        s3_half<1>(tid, fr, fq, g, colw, MV, Bu, Bx, gout, L);
    }
}

__global__ void __launch_bounds__(512, 2) mega(Args a) {
    extern __shared__ __attribute__((aligned(16))) unsigned char lds_raw[];
    LAS unsigned char* L = (LAS unsigned char*)lds_raw;
    cg::grid_group grid = cg::this_grid();
    volatile LAS unsigned* stw = (volatile LAS unsigned*)(L + 131072);
    if (threadIdx.x < 2) stw[threadIdx.x] = 0u;
    __syncthreads();
    const XcdBarrier xbar = xcd_barrier_post((unsigned*)(a.ws + WS_BAR), stw);
    if (a.ph_lo > a.ph_hi) grid.sync();
    unsigned char* ws = a.ws;
    const float* x_in = a.in[0]; float* out = a.out;
    const float* norm_pre = a.in[4]; const float* norm_post = a.in[5];
    const float* mod = (const float*)(ws + WS_MOD);
    bf16_t* XB = (bf16_t*)(ws + WS_XB); bf16_t* H = (bf16_t*)(ws + WS_H); bf16_t* F = (bf16_t*)(ws + WS_F); bf16_t* ACT = (bf16_t*)(ws + WS_ACT);
    const int G = gridDim.x, bx = blockIdx.x;
#define MODP(l, s) (mod + (size_t)(l) * 8 * 9216 + (s) * 3072)
#define NPRE(l, s) (norm_pre + ((l) * 3 + (s)) * 1024)
#define NPOST(l, s) (norm_post + ((l) * 3 + (s)) * 1024)
    for (int ph = a.ph_lo; ph < a.ph_hi; ++ph) {
        int nrep = 1; if ((PROBE_MASK >> ph) & 1u) nrep += PROBE_N;
        for (int rep = 0; rep < nrep; ++rep) {
        int tidv = threadIdx.x; asm volatile("" : "+v"(tidv));
        switch (ph) {
        case 0: p0_phase(tidv, a, L, rep == 0); break;
        case 1: r_phase<false, true, false, false>(tidv, x_in, nullptr, nullptr, H, nullptr, nullptr, 0.f, NPRE(0, 0), MODP(0, 0)); break;
        case 4: r_phase<true, true, false, true>(tidv, x_in, F, XB, H, NPOST(0, 0), MODP(0, 0), 0.5f, NPRE(0, 1), MODP(0, 1)); break;
        case 8: case 11: case 14: case 20: {
            int lp, sp, ln, sn; float rw;
            if (ph == 8) { lp = 0; sp = 1; ln = 0; sn = 2; rw = 1.0f; } else if (ph == 11) { lp = 0; sp = 2; ln = 1; sn = 0; rw = 0.5f; }
            else if (ph == 14) { lp = 1; sp = 0; ln = 1; sn = 1; rw = 0.5f; } else { lp = 1; sp = 1; ln = 1; sn = 2; rw = 1.0f; }
            r_phase<true, true, true, true>(tidv, XB, F, XB, H, NPOST(lp, sp), MODP(lp, sp), rw, NPRE(ln, sn), MODP(ln, sn)); } break;
        case 23: r_phase<true, false, true, false>(tidv, XB, F, out, nullptr, NPOST(1, 2), MODP(1, 2), 0.5f, nullptr, nullptr); break;
        case 2: case 9: case 12: case 21: {
            const int w = (ph == 2) ? 0 : (ph == 9) ? 1 : (ph == 12) ? 2 : 3;
            pg8::Gemm g{H, (const bf16_t*)(ws + WS_WIN) + (size_t)w * 5632 * 1024, T_, 2 * DFF, D_}; pg8::StaticOrder S; S.init(T_, 2 * DFF, G, bx);
            EpiGated<0> E{ACT, DFF}; pg8::gemm_phase<EpiGated<0>, pg8::StaticOrder, true, true>(L, g, S, E, tidv); } break;
        case 3: case 10: case 13: case 22: case 5: case 7: case 15: {
            pg8::Gemm g; EpiPlain E;
            if (ph == 5) { g = pg8::Gemm{H, (const bf16_t*)(ws + WS_ABIN), T_, 1536, D_}; E = EpiPlain{(bf16_t*)(ws + WS_Z), 1536, 2}; }
            else if (ph == 7) { g = pg8::Gemm{(const bf16_t*)(ws + WS_YCAT), (const bf16_t*)(ws + WS_ABOUT), T_, D_, D_}; E = EpiPlain{F, D_, 1 << 30}; }
            else if (ph == 15) { g = pg8::Gemm{H, (const bf16_t*)(ws + WS_SSMIN), T_, D_, D_}; E = EpiPlain{(bf16_t*)(ws + WS_U), D_, 1 << 30}; }
            else { const int w = (ph == 3) ? 0 : (ph == 10) ? 1 : (ph == 13) ? 2 : 3;
                g = pg8::Gemm{ACT, (const bf16_t*)(ws + WS_WOUT) + (size_t)w * 1024 * 2816, T_, D_, DFF}; E = EpiPlain{F, D_, 1 << 30}; }
            pg8::StaticOrder S; S.init(g.M, g.N, G, bx);
            pg8::gemm_phase<EpiPlain, pg8::StaticOrder, true, true>(L, g, S, E, tidv); } break;
        case 6: mix0_phase(tidv, (const bf16_t*)(ws + WS_Z), (const bf16_t*)(ws + WS_SMALL), a.in[10], a.in[11], a.in[12], (const bf16_t*)(ws + WS_SMALL) + 65536, a.in[14], (bf16_t*)(ws + WS_YCAT), L); break;
        case 16: s1_phase(tidv, (const bf16_t*)(ws + WS_U), (const bf16_t*)(ws + WS_V), (float*)(ws + WS_SST), L); break;
        case 17: s2_phase(tidv, (const float*)(ws + WS_SST), (const float*)(ws + WS_LAML), (bf16_t*)(ws + WS_XS)); break;
        case 18: s3_phase(tidv, (const bf16_t*)(ws + WS_XS), (const bf16_t*)(ws + WS_MW), (const bf16_t*)(ws + WS_U), (bf16_t*)(ws + WS_G), L); break;
        case 19: { pg8::Gemm g{(const bf16_t*)(ws + WS_G), (const bf16_t*)(ws + WS_GLU), T_, 2 * D_, D_}; pg8::StaticOrder S; S.init(T_, 2 * D_, G, bx);
            EpiGated<1> E{F, D_}; pg8::gemm_phase<EpiGated<1>, pg8::StaticOrder, true, true>(L, g, S, E, tidv); } break;
        default: break;
        }
        }
        if (ph == 2 || ph == 9 || ph == 12) {
            int first = 1408 - 5 * G; if (first < 0 || first >= G) first = 0;
            if (bx >= first) { int t2 = threadIdx.x; asm volatile("" : "+v"(t2)); const int wv = __builtin_amdgcn_readfirstlane(t2 >> 6);
                t_run(a, ws, L, wv, t2 & 63, ph == 2 ? 1 : (ph == 9 ? 2 : 3), (bx - first) * 8 + wv, (G - first) * 8); } }
        if (ph + 1 < a.ph_hi) { xcd_barrier(xbar); for (int s = 0; s < PROBE_SYNC; ++s) xcd_barrier(xbar); }
    }
}

extern "C" void kernel_launch(void* const* d_in, const int* in_sizes, int n_in, void* d_out, int out_size, void* d_ws, size_t ws_size, hipStream_t stream) {
    static int grid = 0;
    if (grid == 0) {
        if (n_in != 26 || in_sizes[0] != T_ * D_ || out_size != T_ * D_ || ws_size < WS_END) { fprintf(stderr, "kernel_launch: unexpected shapes (n_in %d, in0 %d, out %d, ws %zu)\n", n_in, n_in > 0 ? in_sizes[0] : -1, out_size, ws_size); grid = -1; return; }
        int dev = 0, cus = 0, per_cu = 0;
        if (hipGetDevice(&dev) != hipSuccess || hipDeviceGetAttribute(&cus, hipDeviceAttributeMultiprocessorCount, dev) != hipSuccess) { grid = -1; return; }
        if (hipFuncSetAttribute((const void*)mega, hipFuncAttributeMaxDynamicSharedMemorySize, LDS_BYTES) != hipSuccess) { fprintf(stderr, "kernel_launch: hipFuncSetAttribute failed\n"); grid = -1; return; }
        if (hipOccupancyMaxActiveBlocksPerMultiprocessor(&per_cu, (const void*)mega, 512, LDS_BYTES) != hipSuccess || per_cu < 1) { fprintf(stderr, "kernel_launch: occupancy query gave %d\n", per_cu); per_cu = 1; (void)hipGetLastError(); }
        grid = cus * per_cu;
    }
    if (grid < 0) return;
    (void)hipMemsetAsync((char*)d_ws, 0, 1 * MiB, stream);
    Args a{};
    for (int i = 0; i < 26; ++i) a.in[i] = (const float*)d_in[i];
    a.out = (float*)d_out; a.ws = (unsigned char*)d_ws;
#if MK_PER_PHASE
    for (int ph = 0; ph < NPH; ++ph) { a.ph_lo = ph; a.ph_hi = ph + 1; hipLaunchKernelGGL(mega, dim3(grid), dim3(512), LDS_BYTES, stream, a); }
#else
    a.ph_lo = 0; a.ph_hi = NPH;
    void* args[] = {&a};
    hipError_t e = hipLaunchCooperativeKernel((const void*)mega, dim3(grid), dim3(512), args, LDS_BYTES, stream);
    if (e != hipSuccess) fprintf(stderr, "kernel_launch: cooperative launch failed: %s (grid %d)\n", hipGetErrorString(e), grid);
#endif
}
```

```cpp
#include <hip/hip_runtime.h>
#include <hip/hip_cooperative_groups.h>
#include <cstdio>
#include <cstdint>
namespace cg = cooperative_groups;
namespace pg8 {
#define PG8_LAS __attribute__((address_space(3)))
typedef unsigned short bf16_t;
typedef short bf16x8 __attribute__((ext_vector_type(8)));
typedef float f32x4 __attribute__((ext_vector_type(4)));
typedef unsigned u32x4 __attribute__((ext_vector_type(4)));
constexpr int BM = 256, BK = 64, HALF = 128, HTB = HALF * BK * 2  , STAGE_BYTES = 8 * HTB, NXCD = 8, WGM = 8;

__host__ __device__ __forceinline__ int lds_byte(int r, int c) { const int st = (r >> 4) * 2 + (c >> 5), rr = r & 15, cc = c & 31, ob = rr * 64 + cc * 2; return st * 1024 + (ob ^ (((ob >> 9) & 1) << 5)); }
__host__ __device__ __forceinline__ void stage_rc(int b, int& R, int& C) { const int st = b / 1024, sb = b % 1024, swz = sb ^ (((sb >> 9) & 1) << 5); R = (st >> 1) * 16 + swz / 64; C = (st & 1) * 32 + (swz % 64) / 2; }
__host__ __device__ __forceinline__ int perm32(int rho) { const int n = rho >> 4, i = rho & 15; return 8 * (i >> 2) + 4 * n + (i & 3); }

struct Unit { int pm, pn; };
struct Gemm { const bf16_t* A; const bf16_t* Bt; int M, N, K; };

struct StaticOrder {
    int nM, nN, nwg, G, c;
    __host__ __device__ void init(int M, int N, int G_, int c_) { nM = M / BM; nN = N / BM; nwg = nM * nN; G = G_; c = c_; }
    __host__ __device__ bool next(int i, Unit& u) const {
        const long L = (long)i * G + c; if (L >= nwg) return false;
        int wgid = (int)L; { const int q = nwg / NXCD, r = nwg % NXCD, xcd = wgid % NXCD, off = wgid / NXCD; wgid = (xcd < r ? xcd * (q + 1) : r * (q + 1) + (xcd - r) * q) + off; }
        const int nig = WGM * nN, gid = wgid / nig, fm = gid * WGM, gsz = (nM - fm) < WGM ? (nM - fm) : WGM;
        u.pm = fm + ((wgid % nig) % gsz); u.pn = (wgid % nig) / gsz; return true;
    }
    __device__ __forceinline__ void a_ready(const Unit&) const {}
    __device__ __forceinline__ void done(const Unit&) const {}
};

__device__ __forceinline__ unsigned cvt_pk_bf16(float lo, float hi) { unsigned r; asm volatile("v_cvt_pk_bf16_f32 %0, %1, %2" : "=v"(r) : "v"(lo), "v"(hi)); return r; }
typedef float f32x2 __attribute__((ext_vector_type(2)));
template <class Epi, class Sched, bool ALIGN_EPI = false, bool SP2 = false>
__device__ __forceinline__ void gemm_phase(PG8_LAS unsigned char* lds, const Gemm g, const Sched& S, const Epi& E, const int tid_in) {
    const int tid = tid_in, wid = __builtin_amdgcn_readfirstlane(tid >> 6), lane = tid & 63, wr = wid >> 2, wc = wid & 3, fr = lane & 15, fq = lane >> 4;
    const int K = g.K, nt = K / BK;
    unsigned voffA[2], voffB[2];
#pragma unroll
    for (int i = 0; i < 2; ++i) { int R, C; stage_rc(tid * 16 + i * 8192, R, C); const int Rb = Epi::PERM ? ((R & ~31) + perm32(R & 31)) : R;
        voffA[i] = (unsigned)(R * K + C) * 2u; voffB[i] = (unsigned)(Rb * K + C) * 2u; }
    const size_t kstep = (size_t)(BK * 2);
    const size_t hstep = (size_t)HALF * K * 2;
    const size_t tstep = 2 * hstep;
    const unsigned ldsw = (unsigned)wid * 1024u;
    const int aoff = lds_byte(wr * 64 + fr, fq * 8), boff = lds_byte(wc * 32 + fr, fq * 8);
#define PG8_SA(b, h) (((b) * 2 + (h)) * HTB)
#define PG8_SB(b, h) ((4 + (b) * 2 + (h)) * HTB)
#define PG8_STAGE(bufoff, gbase, voff) do { _Pragma("unroll") for (int _i = 0; _i < 2; ++_i) \
        __builtin_amdgcn_global_load_lds((const unsigned*)((const char*)(gbase) + (voff)[_i]), (PG8_LAS unsigned*)(lds + (bufoff) + ldsw + _i * 8192), 16, 0, 0); } while (0)
#define PG8_LDA(dst, b, h) do { _Pragma("unroll") for (int m = 0; m < 4; ++m) _Pragma("unroll") for (int k = 0; k < 2; ++k) dst[m][k] = *(const PG8_LAS bf16x8*)(lds + PG8_SA(b, h) + aoff + m * 2048 + k * 1024); } while (0)
#define PG8_LDB(dst, b, h) do { _Pragma("unroll") for (int n = 0; n < 2; ++n) _Pragma("unroll") for (int k = 0; k < 2; ++k) dst[n][k] = *(const PG8_LAS bf16x8*)(lds + PG8_SB(b, h) + boff + n * 2048 + k * 1024); } while (0)
#define PG8_MMA(ai, bj, At, Bt) do { __builtin_amdgcn_s_setprio(1); _Pragma("unroll") for (int m = 0; m < 4; ++m) _Pragma("unroll") for (int n = 0; n < 2; ++n) _Pragma("unroll") for (int k = 0; k < 2; ++k) \
        acc[ai][bj][m][n] = __builtin_amdgcn_mfma_f32_16x16x32_bf16(Bt[n][k], At[m][k], acc[ai][bj][m][n], 0, 0, 0); __builtin_amdgcn_s_setprio(0); } while (0)
#define PG8_WAIT_V(n) asm volatile("s_waitcnt vmcnt(" #n ")" ::: "memory")
#define PG8_WAIT_L(n) asm volatile("s_waitcnt lgkmcnt(" #n ")" ::: "memory")
#define PG8_BAR __builtin_amdgcn_s_barrier()
#define PG8_SCHED __builtin_amdgcn_sched_barrier(0)
    Unit cur, nxt; int ui = 0;
    if (!S.next(0, cur)) return;
    f32x4 acc[2][2][4][2];
#pragma unroll
    for (int a = 0; a < 2; ++a)
#pragma unroll
        for (int b = 0; b < 2; ++b)
#pragma unroll
            for (int m = 0; m < 4; ++m)
#pragma unroll
                for (int n = 0; n < 2; ++n) acc[a][b][m][n] = (f32x4){0.f, 0.f, 0.f, 0.f};
    bf16x8 At[4][2], B0[2][2], B1[2][2];
    const char* cA = (const char*)g.A + (size_t)cur.pm * tstep; const char* cB = (const char*)g.Bt + (size_t)cur.pn * tstep;
    S.a_ready(cur);
    if constexpr (SP2) {
        PG8_STAGE(PG8_SB(0, 0), cB, voffB); PG8_STAGE(PG8_SB(0, 1), cB + hstep, voffB); PG8_STAGE(PG8_SA(0, 0), cA, voffA); PG8_STAGE(PG8_SA(0, 1), cA + hstep, voffA);
        if (wr == 1) PG8_BAR;
        PG8_WAIT_V(2); PG8_BAR;
        PG8_STAGE(PG8_SB(1, 0), cB + kstep, voffB); PG8_STAGE(PG8_SA(1, 0), cA + kstep, voffA); PG8_STAGE(PG8_SB(1, 1), cB + hstep + kstep, voffB);
        PG8_WAIT_V(6); PG8_BAR;
    } else {
        PG8_STAGE(PG8_SB(0, 0), cB, voffB); PG8_STAGE(PG8_SA(0, 0), cA, voffA); PG8_STAGE(PG8_SB(0, 1), cB + hstep, voffB); PG8_STAGE(PG8_SA(0, 1), cA + hstep, voffA);
        if (wr == 1) PG8_BAR;
        PG8_WAIT_V(4); PG8_BAR;
        PG8_STAGE(PG8_SB(1, 0), cB + kstep, voffB); PG8_STAGE(PG8_SA(1, 0), cA + kstep, voffA); PG8_STAGE(PG8_SB(1, 1), cB + hstep + kstep, voffB);
        PG8_WAIT_V(6); PG8_BAR;
    }
    for (;;) {
        const bool has_next = S.next(ui + 1, nxt);
        const char* nA = has_next ? (const char*)g.A + (size_t)nxt.pm * tstep : cA; const char* nB = has_next ? (const char*)g.Bt + (size_t)nxt.pn * tstep : cB;
        for (int t = 0; t < nt; t += 2) {
            const bool last = (t == nt - 2);
            const char* a1 = cA + (size_t)(t + 1) * kstep;
            const char* a2 = last ? nA : cA + (size_t)(t + 2) * kstep; const char* b2 = last ? nB : cB + (size_t)(t + 2) * kstep;
            const char* a3 = a2 + kstep; const char* b3 = b2 + kstep;
            if (last && has_next) S.a_ready(nxt);
            if constexpr (SP2) {
            PG8_LDB(B0, 0, 0); PG8_LDB(B1, 0, 1); PG8_SCHED; PG8_LDA(At, 0, 0); PG8_STAGE(PG8_SA(1, 1), a1 + hstep, voffA);
            PG8_WAIT_V(8); PG8_WAIT_L(0); PG8_BAR; PG8_MMA(0, 0, At, B0); PG8_MMA(0, 1, At, B1); PG8_BAR; PG8_SCHED;
            PG8_LDA(At, 0, 1); PG8_STAGE(PG8_SB(0, 0), b2, voffB); PG8_STAGE(PG8_SB(0, 1), b2 + hstep, voffB); PG8_STAGE(PG8_SA(0, 0), a2, voffA);
            PG8_WAIT_V(8); PG8_WAIT_L(0); PG8_BAR; PG8_MMA(1, 0, At, B0); PG8_MMA(1, 1, At, B1); PG8_BAR; PG8_SCHED;
            PG8_LDB(B0, 1, 0); PG8_LDB(B1, 1, 1); PG8_SCHED; PG8_LDA(At, 1, 0); PG8_STAGE(PG8_SA(0, 1), a2 + hstep, voffA);
            PG8_WAIT_V(8); PG8_WAIT_L(0); PG8_BAR; PG8_MMA(0, 0, At, B0); PG8_MMA(0, 1, At, B1); PG8_BAR; PG8_SCHED;
            PG8_LDA(At, 1, 1); PG8_STAGE(PG8_SB(1, 0), b3, voffB); PG8_STAGE(PG8_SB(1, 1), b3 + hstep, voffB); PG8_STAGE(PG8_SA(1, 0), a3, voffA);
            PG8_WAIT_V(8); PG8_WAIT_L(0); PG8_BAR; PG8_MMA(1, 0, At, B0); PG8_MMA(1, 1, At, B1); PG8_BAR; PG8_SCHED;
            } else {
            PG8_LDB(B0, 0, 0); PG8_SCHED; PG8_LDA(At, 0, 0); PG8_STAGE(PG8_SA(1, 1), a1 + hstep, voffA);
            PG8_WAIT_L(8); PG8_BAR; PG8_WAIT_L(0); PG8_MMA(0, 0, At, B0); PG8_BAR; PG8_SCHED;
            PG8_LDB(B1, 0, 1); PG8_STAGE(PG8_SB(0, 0), b2, voffB);
            PG8_BAR; PG8_WAIT_L(0); PG8_MMA(0, 1, At, B1); PG8_BAR;
            PG8_LDA(At, 0, 1); PG8_STAGE(PG8_SA(0, 0), a2, voffA);
            PG8_BAR; PG8_WAIT_L(0); PG8_MMA(1, 0, At, B0); PG8_BAR; PG8_SCHED;
            PG8_STAGE(PG8_SB(0, 1), b2 + hstep, voffB);
            PG8_WAIT_V(6); PG8_BAR; PG8_MMA(1, 1, At, B1); PG8_BAR;
            PG8_LDB(B0, 1, 0); PG8_SCHED; PG8_LDA(At, 1, 0); PG8_STAGE(PG8_SA(0, 1), a2 + hstep, voffA);
            PG8_WAIT_L(8); PG8_BAR; PG8_WAIT_L(0); PG8_MMA(0, 0, At, B0); PG8_BAR; PG8_SCHED;
            PG8_LDB(B1, 1, 1); PG8_STAGE(PG8_SB(1, 0), b3, voffB);
            PG8_BAR; PG8_WAIT_L(0); PG8_MMA(0, 1, At, B1); PG8_BAR;
            PG8_LDA(At, 1, 1); PG8_STAGE(PG8_SA(1, 0), a3, voffA);
            PG8_BAR; PG8_WAIT_L(0); PG8_MMA(1, 0, At, B0); PG8_BAR; PG8_SCHED;
            PG8_STAGE(PG8_SB(1, 1), b3 + hstep, voffB);
            PG8_WAIT_V(6); PG8_BAR; PG8_MMA(1, 1, At, B1); PG8_BAR;
            }
        }
        if constexpr (ALIGN_EPI) { if (wr == 0) PG8_BAR; }
        if constexpr (!Epi::AFTER_DRAIN) { E(acc, cur, wr, wc, fr, fq); S.done(cur); }
        if (!has_next) break;
#pragma unroll
        for (int a = 0; a < 2; ++a)
#pragma unroll
            for (int b = 0; b < 2; ++b)
#pragma unroll
                for (int m = 0; m < 4; ++m)
#pragma unroll
                    for (int n = 0; n < 2; ++n) acc[a][b][m][n] = (f32x4){0.f, 0.f, 0.f, 0.f};
        cur = nxt; cA = nA; cB = nB; ++ui;
        if constexpr (ALIGN_EPI) { if (wr == 1) PG8_BAR; }
    }
    PG8_WAIT_V(0);
    if constexpr (!ALIGN_EPI) { if (wr == 0) PG8_BAR; }
    PG8_BAR;
    if constexpr (Epi::AFTER_DRAIN) { E.fused(acc, cur, wr, wc, fr, fq, lds, wid, lane); S.done(cur); }
#undef PG8_SA
#undef PG8_SB
#undef PG8_STAGE
#undef PG8_LDA
#undef PG8_LDB
#undef PG8_MMA
#undef PG8_WAIT_V
#undef PG8_WAIT_L
#undef PG8_BAR
#undef PG8_SCHED
}
}
using pg8::bf16_t; using pg8::bf16x8; using pg8::f32x4; using pg8::u32x4; using pg8::cvt_pk_bf16; using pg8::f32x2;
#define LAS __attribute__((address_space(3)))
typedef unsigned u32x2 __attribute__((ext_vector_type(2)));
#define XB_TMO      128
#define XB_XCNT(j)  (256  + 64 * (j))
#define XB_XSUB(j)  (1280 + 64 * (j))
#define XB_XGEN(j)  (2304 + 64 * (j))
#define XB_TOP      3328
#define XB_TOPGEN   3392
#define XCD_BAR_WORDS 3456
#define XB_SPIN_CAP (1u << 18)

__device__ __forceinline__ unsigned xb_ld(unsigned* p)              { return __hip_atomic_load(p, __ATOMIC_RELAXED, __HIP_MEMORY_SCOPE_AGENT); }
__device__ __forceinline__ unsigned xb_add(unsigned* p, unsigned v) { return __hip_atomic_fetch_add(p, v, __ATOMIC_RELAXED, __HIP_MEMORY_SCOPE_AGENT); }
__device__ __forceinline__ unsigned xb_xcc_id() { return (unsigned)__builtin_amdgcn_s_getreg((3 << 11) | 20) & 0xFu; }
#define XB_SPIN(cond, bar) do { unsigned _sp = 0; while (cond) { __builtin_amdgcn_s_sleep(1); \
    if ((++_sp & 255u) == 0u) { if (xb_ld(&(bar)[XB_TMO])) break; if (_sp > XB_SPIN_CAP) { atomicAdd(&(bar)[XB_TMO], 1u); break; } } } } while (0)

struct XcdBarrier {
    unsigned* bar; unsigned x;
    volatile LAS unsigned* st;
};

__device__ __forceinline__ XcdBarrier xcd_barrier_post(unsigned* bar, volatile LAS unsigned* st) {
    XcdBarrier b; b.bar = bar; b.x = xb_xcc_id(); b.st = st;
    if (threadIdx.x == 0) (void)xb_add(&bar[XB_XCNT(b.x)], 1u);
    return b;
}
__device__ __forceinline__ void xcd_barrier_complete(unsigned* bar, unsigned x, unsigned& nloc, unsigned& nx) {
    const unsigned G = gridDim.x * gridDim.y * gridDim.z;
    unsigned sum, cnt, mine, sp = 0u;
    for (;;) {
        sum = 0u; cnt = 0u; mine = 0u;
#pragma unroll
        for (unsigned j = 0; j < 16; ++j) { const unsigned c = xb_ld(&bar[XB_XCNT(j)]); sum += c; cnt += (c > 0u) ? 1u : 0u; mine = (j == x) ? c : mine; }
        if (sum == G) break;
        __builtin_amdgcn_s_sleep(1);
        if ((++sp & 255u) == 0u) { if (xb_ld(&bar[XB_TMO])) break; if (sp > XB_SPIN_CAP) { atomicAdd(&bar[XB_TMO], 1u); break; } }
    }
    nloc = mine > 0u ? mine : 1u; nx = cnt > 0u ? cnt : 1u;
}

__device__ __forceinline__ void xcd_barrier(const XcdBarrier& b) {
    asm volatile("s_waitcnt vmcnt(0)" ::: "memory");
    __syncthreads();
    if (threadIdx.x == 0) {
        unsigned* bar = b.bar;
        __builtin_amdgcn_s_waitcnt(0);
        unsigned nloc = b.st[0], nx = b.st[1];
        if (nloc == 0u) { xcd_barrier_complete(bar, b.x, nloc, nx); b.st[0] = nloc; b.st[1] = nx; }
        const unsigned old = xb_add(&bar[XB_XSUB(b.x)], 1u);
        const unsigned gen = old / nloc;
        if (old + 1u == (gen + 1u) * nloc) {
            __builtin_amdgcn_fence(__ATOMIC_RELEASE, "agent");
            asm volatile("s_waitcnt vmcnt(0)" ::: "memory");
            const unsigned og = xb_add(&bar[XB_TOP], 1u);
            const unsigned tg = og / nx;
            if (og + 1u == (tg + 1u) * nx) xb_add(&bar[XB_TOPGEN], 1u);
            else XB_SPIN(xb_ld(&bar[XB_TOPGEN]) == tg, bar);
            __builtin_amdgcn_fence(__ATOMIC_ACQUIRE, "agent");
            xb_add(&bar[XB_XGEN(b.x)], 1u);
            asm volatile("s_waitcnt vmcnt(0)" ::: "memory");
        } else {
            XB_SPIN(xb_ld(&bar[XB_XGEN(b.x)]) == gen, bar);
            __builtin_amdgcn_fence(__ATOMIC_ACQUIRE, "agent");
            asm volatile("s_waitcnt vmcnt(0)" ::: "memory");
        }
    }
    __syncthreads();
}


#ifndef MK_PER_PHASE
#define MK_PER_PHASE 0
#endif
#define PROBE_MASK 0u
#define PROBE_N 0
#define PROBE_SYNC 0

constexpr int T_ = 16384, D_ = 1024, DFF = 2816, SEQ = 2048;
constexpr float EPS = 1e-6f;
constexpr size_t MiB = 1u << 20;
constexpr size_t WS_MOD = 0, WS_BAR = 768 * 1024, WS_LAML = 1 * MiB, WS_MW = 2 * MiB, WS_V = 14 * MiB, WS_WIN = 18 * MiB, WS_WOUT = 62 * MiB, WS_ABIN = 84 * MiB,
                 WS_ABOUT = 87 * MiB, WS_SSMIN = 89 * MiB, WS_GLU = 91 * MiB, WS_SMALL = 95 * MiB, WS_H = 96 * MiB, WS_F = 128 * MiB, WS_ACT = 160 * MiB,
                 WS_XB = 248 * MiB, WS_END = 280 * MiB;
constexpr size_t WS_Z = WS_ACT, WS_YCAT = WS_ACT + 48 * MiB;
constexpr size_t WS_U = WS_ACT, WS_YI = WS_ACT + 32 * MiB, WS_XS = WS_ACT + 64 * MiB, WS_G = WS_H, WS_SST = WS_F;
constexpr int LDS_BYTES = 135168;
constexpr int NPH = 24;

struct Args { const float* in[26]; float* out; unsigned char* ws; int ph_lo, ph_hi; };

__device__ __forceinline__ float dpp_f(float v, const int ctrl) { return v; }
#define DPP_ADD(v, ctrl) ((v) + __builtin_bit_cast(float, __builtin_amdgcn_update_dpp(0, __builtin_bit_cast(int, (v)), (ctrl), 0xf, 0xf, true)))
__device__ __forceinline__ float wave_sum(float v) {
    v = DPP_ADD(v, 0xB1);
    v = DPP_ADD(v, 0x4E);
    v = DPP_ADD(v, 0x141);
    v = DPP_ADD(v, 0x140);
    const int iv = __builtin_bit_cast(int, v);
    return (__builtin_bit_cast(float, __builtin_amdgcn_readlane(iv, 0)) + __builtin_bit_cast(float, __builtin_amdgcn_readlane(iv, 16))) +
           (__builtin_bit_cast(float, __builtin_amdgcn_readlane(iv, 32)) + __builtin_bit_cast(float, __builtin_amdgcn_readlane(iv, 48)));
}
__device__ __forceinline__ float bf2f(unsigned b) { return __uint_as_float(b << 16); }
__device__ __forceinline__ unsigned f2bf(float f) { unsigned u = __float_as_uint(f); return (u + 0x7fffu + ((u >> 16) & 1u)) >> 16; }
__device__ __forceinline__ f32x4 ld4bf(const bf16_t* p) { const u32x2 v = *(const u32x2*)p; f32x4 r; r.x = __uint_as_float(v.x << 16); r.y = __uint_as_float(v.x & 0xffff0000u); r.z = __uint_as_float(v.y << 16); r.w = __uint_as_float(v.y & 0xffff0000u); return r; }
__device__ __forceinline__ void st4bf(bf16_t* p, f32x4 v) { u32x2 w; w.x = cvt_pk_bf16(v.x, v.y); w.y = cvt_pk_bf16(v.z, v.w); *(u32x2*)p = w; }
__device__ __forceinline__ float gelu_tanh(float x) { const float t = 1.5957691216f * (x + 0.044715f * x * x * x); return x * __builtin_amdgcn_rcpf(1.0f + __expf(-t)); }

template <int MODE> struct EpiGated {
    static constexpr bool PERM = true, AFTER_DRAIN = false;
    bf16_t* O; int ldc;
    __device__ __forceinline__ void operator()(const f32x4 (&acc)[2][2][4][2], const pg8::Unit& u, int wr, int wc, int fr, int fq) const {
        const int row0 = u.pm * 256 + wr * 64 + fr, col0 = u.pn * 128 + wc * 32 + 8 * fq;
#pragma unroll
        for (int ai = 0; ai < 2; ++ai)
#pragma unroll
            for (int m = 0; m < 4; ++m) {
                bf16_t* rowp = O + (size_t)(row0 + ai * 128 + m * 16) * ldc + col0;
                float v[8];
#pragma unroll
                for (int n = 0; n < 2; ++n)
#pragma unroll
                    for (int i = 0; i < 4; ++i) { const float a = acc[ai][0][m][n][i], b = acc[ai][1][m][n][i];
                        v[n * 4 + i] = (MODE == 0) ? a * b * __builtin_amdgcn_rcpf(1.0f + __expf(-a)) : a * __builtin_amdgcn_rcpf(1.0f + __expf(-b)); }
                u32x4 w; w.x = cvt_pk_bf16(v[0], v[1]); w.y = cvt_pk_bf16(v[2], v[3]); w.z = cvt_pk_bf16(v[4], v[5]); w.w = cvt_pk_bf16(v[6], v[7]);
                *(u32x4*)rowp = w;
            }
    }
};
struct EpiPlain {
    static constexpr bool PERM = true, AFTER_DRAIN = false;
    bf16_t* O; int ldc; int gelu_from;
    __device__ __forceinline__ void operator()(const f32x4 (&acc)[2][2][4][2], const pg8::Unit& u, int wr, int wc, int fr, int fq) const {
        const int row0 = u.pm * 256 + wr * 64 + fr, col0 = u.pn * 256 + wc * 32 + 8 * fq; const bool gl = u.pn >= gelu_from;
#pragma unroll
        for (int ai = 0; ai < 2; ++ai)
#pragma unroll
            for (int m = 0; m < 4; ++m) {
                bf16_t* rowp = O + (size_t)(row0 + ai * 128 + m * 16) * ldc + col0;
#pragma unroll
                for (int bj = 0; bj < 2; ++bj) { f32x4 v0 = acc[ai][bj][m][0], v1 = acc[ai][bj][m][1];
                    if (gl) {
#pragma unroll
                        for (int i = 0; i < 4; ++i) { v0[i] = gelu_tanh(v0[i]); v1[i] = gelu_tanh(v1[i]); } }
                    u32x4 w; w.x = cvt_pk_bf16(v0[0], v0[1]); w.y = cvt_pk_bf16(v0[2], v0[3]); w.z = cvt_pk_bf16(v1[0], v1[1]); w.w = cvt_pk_bf16(v1[2], v1[3]);
                    *(u32x4*)(rowp + bj * 128) = w; }
            }
    }
};

struct TItem { const float* src; bf16_t* dst; int N, K; };
__device__ __forceinline__ TItem t_decode(const Args& a, unsigned char* ws, int r) {
    constexpr int I_IN = 16 * 176, I_OUT = 44 * 32, I_ABIN = 16 * 48, I_SQ = 16 * 32;
    const float* W; bf16_t* WT; int K, N, mode = 0;
    if (r < 4 * I_IN) { const int w = r / I_IN; r -= w * I_IN; W = a.in[6] + (size_t)w * 1024 * 5632; K = 1024; N = 5632; WT = (bf16_t*)(ws + WS_WIN) + (size_t)w * 5632 * 1024; mode = 1; }
    else if ((r -= 4 * I_IN) < 4 * I_OUT) { const int w = r / I_OUT; r -= w * I_OUT; W = a.in[7] + (size_t)w * 2816 * 1024; K = 2816; N = 1024; WT = (bf16_t*)(ws + WS_WOUT) + (size_t)w * 1024 * 2816; }
    else if ((r -= 4 * I_OUT) < I_ABIN) { W = a.in[8]; K = 1024; N = 1536; WT = (bf16_t*)(ws + WS_ABIN); }
    else if ((r -= I_ABIN) < I_SQ) { W = a.in[15]; K = 1024; N = 1024; WT = (bf16_t*)(ws + WS_ABOUT); }
    else if ((r -= I_SQ) < I_SQ) { W = a.in[16]; K = 1024; N = 1024; WT = (bf16_t*)(ws + WS_SSMIN); }
    else { r -= I_SQ; W = a.in[25]; K = 1024; N = 2048; WT = (bf16_t*)(ws + WS_GLU); mode = 1; }
    const int nblk = N / 32, kb = r / nblk, nb = r % nblk, k0 = 64 * kb, n0 = 32 * nb;
    int r0 = n0;
    if (mode) { const int half = N >> 1, hf = (n0 >= half) ? 1 : 0, j = n0 - hf * half; r0 = (j >> 7) * 256 + hf * 128 + (j & 127); }
    TItem t; t.src = W + (size_t)k0 * N + n0; t.dst = WT + (size_t)r0 * K + k0; t.N = N; t.K = K; return t;
}
__device__ __forceinline__ int t_remap(const int set, const int d) {
    if (set == 0) return d < 2816 ? d : 11264 + (d - 2816);
    if (set == 1) return d < 2816 ? 2816 + d : (d < 4224 ? 11264 + 1408 + (d - 2816) : 16896 + (d - 4224));
    if (set == 2) return d < 2816 ? 5632 + d : (d < 4224 ? 11264 + 2816 + (d - 2816) : 18176 + (d - 4224));
    return d < 2816 ? 8448 + d : 11264 + 4224 + (d - 2816);
}
__device__ __forceinline__ void t_run(const Args& a, unsigned char* ws, LAS unsigned char* L, const int wave, const int lane, const int set, const int worker, const int nworkers) {
    const int NIT = (set == 0) ? 4224 : (set == 1) ? 5504 : (set == 2) ? 5760 : 4224;
    LAS float* scr = (LAS float*)(L + wave * 8448);
    int it = worker; TItem cur, nxt; float tv[32];
    if (it < NIT) { cur = t_decode(a, ws, t_remap(set, it));
#pragma unroll
        for (int i = 0; i < 32; ++i) tv[i] = cur.src[(size_t)(2 * i + (lane >> 5)) * cur.N + (lane & 31)]; }
    while (it < NIT) {
#pragma unroll
        for (int i = 0; i < 32; ++i) scr[(2 * i + (lane >> 5)) * 33 + (lane & 31)] = tv[i];
        const int itn = it + nworkers;
        if (itn < NIT) { nxt = t_decode(a, ws, t_remap(set, itn));
#pragma unroll
            for (int i = 0; i < 32; ++i) tv[i] = nxt.src[(size_t)(2 * i + (lane >> 5)) * nxt.N + (lane & 31)]; }
        asm volatile("s_waitcnt lgkmcnt(0)" ::: "memory");
        const int cc = lane & 7;
#pragma unroll
        for (int j = 0; j < 4; ++j) { const int n = (lane >> 3) + 8 * j; const LAS float* s = scr + (8 * cc) * 33 + n;
            u32x4 o; o.x = cvt_pk_bf16(s[0 * 33], s[1 * 33]); o.y = cvt_pk_bf16(s[2 * 33], s[3 * 33]); o.z = cvt_pk_bf16(s[4 * 33], s[5 * 33]); o.w = cvt_pk_bf16(s[6 * 33], s[7 * 33]);
            *(u32x4*)(cur.dst + (size_t)n * cur.K + 8 * cc) = o; }
        asm volatile("s_waitcnt lgkmcnt(0)" ::: "memory");
        cur = nxt; it = itn; }
}

__device__ __forceinline__ void ssm_precompute(const int tidv, int g, const int part, const float* lam_re, const float* lam_im, const float* b_re, const float* b_im, const float* c_re, const float* c_im,
                                               const float* log_dt, const float* dskip, bf16_t* MW, bf16_t* V, float* lamL, LAS unsigned char* L) {
    LAS float* pw = (LAS float*)L;
    LAS float* Bb = pw + 17 * 64 * 2;
    LAS float* Cc = Bb + 2048;
    LAS float* Kk = Cc + 2080;
    const int tid = tidv;
    const float dt = expf(log_dt[g]);
    for (int idx = tid; idx < 17 * 64; idx += 512) { const int j = idx >> 6, p = idx & 63; const float lr = lam_re[g * 64 + p], li = lam_im[g * 64 + p];
        const float mag = expf((float)j * dt * lr); double rev = (double)j * (double)dt * (double)li * 0.15915494309189535; rev -= rint(rev);
        const float ang = (float)(rev * 6.283185307179586); pw[idx * 2] = mag * __cosf(ang); pw[idx * 2 + 1] = mag * __sinf(ang); }
    for (int idx = tid; idx < 1024; idx += 512) { const int p = idx >> 4; const float lr = lam_re[g * 64 + p], li = lam_im[g * 64 + p];
        const float mag = expf(dt * lr); double rev = (double)dt * (double)li * 0.15915494309189535; rev -= rint(rev); const float ang = (float)(rev * 6.283185307179586);
        const float er = mag * __cosf(ang) - 1.0f, ei = mag * __sinf(ang);
        const float den = 1.0f / (lr * lr + li * li); const float qr = (er * lr + ei * li) * den, qi = (ei * lr - er * li) * den;
        const float br = b_re[g * 1024 + idx], bi = b_im[g * 1024 + idx];
        Bb[idx * 2] = qr * br - qi * bi; Bb[idx * 2 + 1] = qr * bi + qi * br; }
    for (int idx = tid; idx < 1024; idx += 512) { const int n = idx >> 6, p = idx & 63; Cc[(n * 65 + p) * 2] = c_re[g * 1024 + idx]; Cc[(n * 65 + p) * 2 + 1] = c_im[g * 1024 + idx]; }
    __syncthreads();
    { const int j = tid >> 5, n = (tid >> 1) & 15, mh = tid & 1; float s[8];
#pragma unroll
      for (int e2 = 0; e2 < 8; ++e2) s[e2] = 0.f;
      for (int p = 0; p < 64; ++p) { const f32x2 cv = *(const LAS f32x2*)(Cc + (n * 65 + p) * 2), pv = *(const LAS f32x2*)(pw + (j * 64 + p) * 2);
          const float xr = cv.x * pv.x - cv.y * pv.y, xi = cv.x * pv.y + cv.y * pv.x;
#pragma unroll
          for (int e2 = 0; e2 < 4; ++e2) { const f32x4 bb = *(const LAS f32x4*)(Bb + (p * 16 + mh * 8 + 2 * e2) * 2); s[2 * e2] += xr * bb.x - xi * bb.y; s[2 * e2 + 1] += xr * bb.z - xi * bb.w; } }
#pragma unroll
      for (int e2 = 0; e2 < 8; ++e2) Kk[(j * 16 + n) * 16 + mh * 8 + e2] = s[e2]; }
    __syncthreads();
    bf16_t* MVg = MW + (size_t)g * 256 * 384; bf16_t* Wg = V + (size_t)g * 128 * 256;
    for (int q = part * 8192 + tid; q < (part + 1) * 8192; q += 512) { const int row = q >> 7, c2 = (q & 127) * 2; const int t = row >> 4, n = row & 15, s = c2 >> 4, m = c2 & 15;
        float v0 = 0.f, v1 = 0.f; if (s <= t) { v0 = Kk[((t - s) * 16 + n) * 16 + m]; v1 = Kk[((t - s) * 16 + n) * 16 + m + 1]; }
        if (s == t) { if (m == n) v0 += dskip[g * 16 + n]; if (m + 1 == n) v1 += dskip[g * 16 + n]; }
        *(unsigned*)(MVg + row * 384 + c2) = cvt_pk_bf16(v0, v1); }
    for (int q = part * 4096 + tid; q < (part + 1) * 4096; q += 512) { const int r = q >> 7, c2 = (q & 127) * 2; const int p = r >> 1, ri = r & 1, s = c2 >> 4, m = c2 & 15;
        const float pr = pw[((15 - s) * 64 + p) * 2], pi = pw[((15 - s) * 64 + p) * 2 + 1]; float v[2];
#pragma unroll
        for (int e = 0; e < 2; ++e) { const float br = Bb[(p * 16 + m + e) * 2], bi = Bb[(p * 16 + m + e) * 2 + 1]; v[e] = ri ? (pr * bi + pi * br) : (pr * br - pi * bi); }
        *(unsigned*)(Wg + r * 256 + c2) = cvt_pk_bf16(v[0], v[1]); }
    for (int q = part * 4096 + tid; q < (part + 1) * 4096; q += 512) { const int row = q >> 6, p = q & 63; const int t = row >> 4, n = row & 15;
        const float cr = Cc[(n * 65 + p) * 2], ci = Cc[(n * 65 + p) * 2 + 1], pr = pw[((t + 1) * 64 + p) * 2], pi = pw[((t + 1) * 64 + p) * 2 + 1];
        *(unsigned*)(MVg + row * 384 + 256 + 2 * p) = cvt_pk_bf16(cr * pr - ci * pi, -(cr * pi + ci * pr)); }
    if (part == 0 && tid < 64) { lamL[(g * 64 + tid) * 2] = pw[(16 * 64 + tid) * 2]; lamL[(g * 64 + tid) * 2 + 1] = pw[(16 * 64 + tid) * 2 + 1]; }
}

__device__ __forceinline__ void p0_phase(const int tidv, const Args& a, LAS unsigned char* L, const bool do_mod) {
    const int tid = tidv, lane = tid & 63, wave = __builtin_amdgcn_readfirstlane(tid >> 6), G = gridDim.x, bx = blockIdx.x;
    unsigned char* ws = a.ws;
    for (int gi = bx; gi < 256; gi += G) { const int g = gi >> 2;
        ssm_precompute(tidv, g, gi & 3, a.in[17], a.in[18], a.in[19], a.in[20], a.in[21], a.in[22], a.in[24], a.in[23], (bf16_t*)(ws + WS_MW), (bf16_t*)(ws + WS_V), (float*)(ws + WS_LAML), L);
        __syncthreads(); }
    { bf16_t* pwt = (bf16_t*)(ws + WS_SMALL); bf16_t* sgw = pwt + 65536; const float* pool_w = a.in[9]; const float* sgu_w = a.in[13];
      for (int i = bx * 512 + tid; i < 65536; i += G * 512) { const int gg = i >> 14, o = (i >> 7) & 127, ii = i & 127;
          pwt[i] = (bf16_t)f2bf(pool_w[(gg * 128 + ii) * 128 + o]); sgw[i] = (ii <= o) ? (bf16_t)f2bf(sgu_w[i]) : (bf16_t)0; } }
    { LAS float* cond = (LAS float*)L; const float* c = a.in[1];
      for (int i = tid; i < 8192; i += 512) { const float v = c[i]; cond[i] = v / (1.0f + __expf(-v)); }
      __syncthreads();
      float* mod = (float*)(ws + WS_MOD); const float* ada_w = a.in[2]; const float* ada_b = a.in[3];
      LAS float* red = cond + 8192;
      if (do_mod) for (int it = bx; it < 256; it += G) { const int l = it >> 7, col0 = (it & 127) * 72, c4 = tid % 18, ks = tid / 18;
          f32x4 acc[8];
#pragma unroll
          for (int b = 0; b < 8; ++b) acc[b] = (f32x4){0.f, 0.f, 0.f, 0.f};
          if (ks < 28) {
              const float* wp = ada_w + (size_t)l * 1024 * 9216 + col0 + 4 * c4;
#pragma unroll 4
              for (int k = ks; k < 1024; k += 28) { const f32x4 w = *(const f32x4*)(wp + (size_t)k * 9216);
#pragma unroll
                  for (int b = 0; b < 8; ++b) acc[b] = acc[b] + w * cond[b * 1024 + k]; }
#pragma unroll
              for (int b = 0; b < 8; ++b) *(LAS f32x4*)(red + (ks * 8 + b) * 72 + 4 * c4) = acc[b]; }
          __syncthreads();
          for (int o = tid; o < 576; o += 512) { const int b = o / 72, cc = o % 72; float s = ada_b[l * 9216 + col0 + cc];
              for (int k2 = 0; k2 < 28; ++k2) s += red[(k2 * 8 + b) * 72 + cc];
              mod[((size_t)l * 8 + b) * 9216 + col0 + cc] = s; }
          __syncthreads(); }
      __syncthreads(); }
    t_run(a, ws, L, wave, lane, 0, bx * 8 + wave, G * 8);
}

template <bool HAS_PREV, bool HAS_NEXT, bool XIN_BF, bool XOUT_BF>
__device__ __forceinline__ void r_phase(const int tidv, const void* xin_, const bf16_t* f, void* xout_, bf16_t* h, const float* gpost, const float* modprev, float rw, const float* gpre, const float* modnext) {
    const int tid = tidv, lane = tid & 63, wave = tid >> 6; const int gw = blockIdx.x * 8 + wave, NGW = gridDim.x * 8;
    for (int rb = gw; rb < T_ / 8; rb += NGW) {
        const int r0 = rb * 8, b = r0 / SEQ;
        f32x4 A1[4], A2[4], A3[4];
#pragma unroll
        for (int c = 0; c < 4; ++c) { const int col = c * 256 + lane * 4;
            if (HAS_PREV) { const f32x4 gp = *(const f32x4*)(gpost + col), gt = *(const f32x4*)(modprev + (size_t)b * 9216 + 2048 + col); A1[c] = gp * gt * rw; }
            if (HAS_NEXT) { const f32x4 gq = *(const f32x4*)(gpre + col), sc = *(const f32x4*)(modnext + (size_t)b * 9216 + 1024 + col); A2[c] = gq * (sc + 1.0f); A3[c] = *(const f32x4*)(modnext + (size_t)b * 9216 + col); } }
        for (int r = r0; r < r0 + 8; ++r) {
            f32x4 xv[4];
#pragma unroll
            for (int c = 0; c < 4; ++c) { if (XIN_BF) xv[c] = ld4bf((const bf16_t*)xin_ + (size_t)r * D_ + c * 256 + lane * 4); else xv[c] = *(const f32x4*)((const float*)xin_ + (size_t)r * D_ + c * 256 + lane * 4); }
            if (HAS_PREV) { f32x4 fv[4]; float ss = 0.f;
#pragma unroll
                for (int c = 0; c < 4; ++c) { fv[c] = ld4bf(f + (size_t)r * D_ + c * 256 + lane * 4); ss += fv[c].x * fv[c].x + fv[c].y * fv[c].y + fv[c].z * fv[c].z + fv[c].w * fv[c].w; }
                const float rs = rsqrtf(wave_sum(ss) * (1.0f / D_) + EPS);
#pragma unroll
                for (int c = 0; c < 4; ++c) { xv[c] = xv[c] + A1[c] * fv[c] * rs;
                    if (XOUT_BF) st4bf((bf16_t*)xout_ + (size_t)r * D_ + c * 256 + lane * 4, xv[c]); else *(f32x4*)((float*)xout_ + (size_t)r * D_ + c * 256 + lane * 4) = xv[c]; } }
            if (HAS_NEXT) { float ss = 0.f;
#pragma unroll
                for (int c = 0; c < 4; ++c) ss += xv[c].x * xv[c].x + xv[c].y * xv[c].y + xv[c].z * xv[c].z + xv[c].w * xv[c].w;
                const float rs = rsqrtf(wave_sum(ss) * (1.0f / D_) + EPS);
#pragma unroll
                for (int c = 0; c < 4; ++c) st4bf(h + (size_t)r * D_ + c * 256 + lane * 4, xv[c] * rs * A2[c] + A3[c]); }
        }
    }
}

template <int W> __device__ __forceinline__ void pool_prep(const int tid, const int q, const bf16_t* z, const int row0, const int g, LAS unsigned char* As) {
    const int i4 = tid & 31, t0 = (tid >> 5) * 8, pos0 = (q & 15) * 128 + t0;
    const bf16_t* zp = z + (size_t)(row0 + t0) * 1536 + g * 128 + 4 * i4;
    u32x2 raw[W + 7];
#pragma unroll
    for (int i = 0; i < W + 7; ++i) { const int rel = i - (W - 1); const bool valid = (pos0 + rel) >= 0; raw[i] = *(const u32x2*)(zp + (ptrdiff_t)(valid ? rel : 0) * 1536); if (!valid) { raw[i].x = 0u; raw[i].y = 0u; } }
    f32x4 sum = {0.f, 0.f, 0.f, 0.f};
#define UNPK(v) ((f32x4){__uint_as_float((v).x << 16), __uint_as_float((v).x & 0xffff0000u), __uint_as_float((v).y << 16), __uint_as_float((v).y & 0xffff0000u)})
#pragma unroll
    for (int i = 0; i < W - 1; ++i) sum = sum + UNPK(raw[i]);
#pragma unroll
    for (int r = 0; r < 8; ++r) { const f32x4 cur = UNPK(raw[W - 1 + r]); sum = sum + cur; if (r > 0) sum = sum - UNPK(raw[r - 1]);
        const float inv = 1.0f / (float)min(pos0 + r + 1, W); const f32x4 d = sum * inv - cur;
        u32x2 o; o.x = cvt_pk_bf16(d.x, d.y); o.y = cvt_pk_bf16(d.z, d.w); *(LAS u32x2*)(As + (t0 + r) * 272 + 8 * i4) = o; }
#undef UNPK
}
__device__ __forceinline__ void mix0_phase(const int tidv, const bf16_t* z, const bf16_t* pool_wt, const float* pool_scale, const float* ln_g, const float* ln_b, const bf16_t* sguw, const float* sgu_b,
                                           bf16_t* ycat, LAS unsigned char* L) {
    LAS unsigned char* As = L; LAS unsigned char* Bs = L + 34816; LAS float* st = (LAS float*)(L + 69632);
    const int tid = tidv, lane = tid & 63, wave = __builtin_amdgcn_readfirstlane(tid >> 6), fr = lane & 15, fq = lane >> 4;
    for (int it = blockIdx.x; it < 1024; it += gridDim.x) {
        const int q = it >> 3, unit = (it & 7) ^ (((it / (int)gridDim.x) & 1) << 2), row0 = q * 128;
        __syncthreads();
        if (unit < 4) {
            const int g = unit;
            if (g == 0) pool_prep<2>(tid, q, z, row0, g, As); else if (g == 1) pool_prep<4>(tid, q, z, row0, g, As); else if (g == 2) pool_prep<8>(tid, q, z, row0, g, As); else pool_prep<16>(tid, q, z, row0, g, As);
#pragma unroll
            for (int e = 0; e < 4; ++e) { const int idx = tid + e * 512, r = idx >> 4, c = idx & 15; *(LAS u32x4*)(Bs + r * 272 + c * 16) = *(const u32x4*)(pool_wt + g * 16384 + r * 128 + c * 8); }
        } else {
            const int hh = unit - 4;
#pragma unroll
            for (int e = 0; e < 4; ++e) { const int idx = tid + e * 512, r = idx >> 4, c = idx & 15; *(LAS u32x4*)(As + r * 272 + c * 16) = *(const u32x4*)(sguw + hh * 16384 + r * 128 + c * 8); }
            unsigned vraw[16];
#pragma unroll
            for (int i = 0; i < 16; ++i) vraw[i] = *(const unsigned*)(z + (size_t)(row0 + wave * 16 + i) * 1536 + 1024 + hh * 128 + 2 * lane);
#pragma unroll
            for (int i = 0; i < 16; ++i) { const int s = wave * 16 + i; const unsigned vv = vraw[i];
                const float v0 = __uint_as_float(vv << 16), v1 = __uint_as_float(vv & 0xffff0000u); const float mean = wave_sum(v0 + v1) * (1.0f / 128.0f);
                const float d0 = v0 - mean, d1 = v1 - mean; const float var = wave_sum(d0 * d0 + d1 * d1) * (1.0f / 128.0f);
                if (lane == 0) { st[s * 2] = mean; st[s * 2 + 1] = rsqrtf(var + EPS); } }
            __syncthreads();
            const int d = tid & 127, sg = tid >> 7; const float gln = ln_g[hh * 128 + d], bln = ln_b[hh * 128 + d];
#pragma unroll
            for (int sb = 0; sb < 4; ++sb) { const int s0 = sg * 32 + sb * 8; float vn[8];
#pragma unroll
                for (int k = 0; k < 8; ++k) { const float v = bf2f(z[(size_t)(row0 + s0 + k) * 1536 + 1024 + hh * 128 + d]); vn[k] = (v - st[(s0 + k) * 2]) * st[(s0 + k) * 2 + 1] * gln + bln; }
                u32x4 o; o.x = cvt_pk_bf16(vn[0], vn[1]); o.y = cvt_pk_bf16(vn[2], vn[3]); o.z = cvt_pk_bf16(vn[4], vn[5]); o.w = cvt_pk_bf16(vn[6], vn[7]);
                *(LAS u32x4*)(Bs + d * 272 + s0 * 2) = o; }
        }
        __syncthreads();
        const int wr = wave >> 1, wc = wave & 1;
        f32x4 acc[2][4];
#pragma unroll
        for (int m = 0; m < 2; ++m)
#pragma unroll
            for (int n = 0; n < 4; ++n) acc[m][n] = (f32x4){0.f, 0.f, 0.f, 0.f};
#pragma unroll
        for (int kk = 0; kk < 4; ++kk) { bf16x8 Af[2];
#pragma unroll
            for (int m = 0; m < 2; ++m) Af[m] = *(const LAS bf16x8*)(As + (32 * wr + 16 * m + fr) * 272 + kk * 64 + fq * 16);
#pragma unroll
            for (int n = 0; n < 4; ++n) { const bf16x8 Bf = *(const LAS bf16x8*)(Bs + (64 * wc + 16 * n + fr) * 272 + kk * 64 + fq * 16);
#pragma unroll
                for (int m = 0; m < 2; ++m) acc[m][n] = __builtin_amdgcn_mfma_f32_16x16x32_bf16(Bf, Af[m], acc[m][n], 0, 0, 0); } }
#pragma unroll
        for (int m = 0; m < 2; ++m) { const int row = 32 * wr + 16 * m + fr;
#pragma unroll
            for (int n = 0; n < 4; ++n) { const int col = 64 * wc + 16 * n + 4 * fq;
                if (unit < 4) { const f32x4 sc = *(const f32x4*)(pool_scale + unit * 128 + col); st4bf(ycat + (size_t)(row0 + row) * 1024 + unit * 128 + col, acc[m][n] * sc); }
                else { const int hh = unit - 4; const f32x4 uu = ld4bf(z + (size_t)(row0 + row) * 1536 + 512 + hh * 128 + col); const float bs = sgu_b[hh * 128 + row];
                    st4bf(ycat + (size_t)(row0 + row) * 1024 + 512 + hh * 128 + col, uu * (acc[m][n] + bs)); } } }
    }
}

__device__ __forceinline__ void s1_phase(const int tidv, const bf16_t* u, const bf16_t* Wm, float* Sst, LAS unsigned char* L) {
    const int tid = tidv, lane = tid & 63, wave = __builtin_amdgcn_readfirstlane(tid >> 6), fr = lane & 15, fq = lane >> 4;
    for (int it = blockIdx.x; it < 256; it += gridDim.x) {
        const int g = it >> 2, cb = it & 3, colw = cb * 256 + wave * 32;
        bf16x8 Bf[2][8];
#pragma unroll
        for (int nt = 0; nt < 2; ++nt)
#pragma unroll
            for (int kk = 0; kk < 8; ++kk) { const int col = colw + nt * 16 + fr; Bf[nt][kk] = *(const bf16x8*)(u + ((size_t)col * 16 + 2 * kk + (fq >> 1)) * 1024 + g * 16 + (fq & 1) * 8); }
        __syncthreads();
#pragma unroll
        for (int e = 0; e < 8; ++e) { const int idx = tid + e * 512, r = idx >> 5, c = idx & 31; *(LAS u32x4*)(L + r * 528 + c * 16) = *(const u32x4*)(Wm + ((size_t)g * 128 + r) * 256 + c * 8); }
        __syncthreads();
        f32x4 acc[8][2];
#pragma unroll
        for (int mt = 0; mt < 8; ++mt) { acc[mt][0] = (f32x4){0.f, 0.f, 0.f, 0.f}; acc[mt][1] = (f32x4){0.f, 0.f, 0.f, 0.f}; }
#pragma unroll
        for (int mt = 0; mt < 8; ++mt)
#pragma unroll
            for (int kk = 0; kk < 8; ++kk) { const bf16x8 Af = *(const LAS bf16x8*)(L + (mt * 16 + fr) * 528 + kk * 64 + fq * 16);
                acc[mt][0] = __builtin_amdgcn_mfma_f32_16x16x32_bf16(Af, Bf[0][kk], acc[mt][0], 0, 0, 0);
                acc[mt][1] = __builtin_amdgcn_mfma_f32_16x16x32_bf16(Af, Bf[1][kk], acc[mt][1], 0, 0, 0); }
#pragma unroll
        for (int mt = 0; mt < 8; ++mt)
#pragma unroll
            for (int nt = 0; nt < 2; ++nt) { const int col = colw + nt * 16 + fr; *(f32x4*)(Sst + ((size_t)col * 64 + g) * 128 + mt * 16 + fq * 4) = acc[mt][nt]; }
    }
}
__device__ __forceinline__ void s2_phase(const int tidv, const float* Sst, const float* lamL, bf16_t* Xs) {
    if (tidv < 128) for (int gt = blockIdx.x * 128 + tidv; gt < 32768; gt += gridDim.x * 128) {
        const int b = gt >> 12, gp = gt & 4095; const float lr = lamL[gp * 2], li = lamL[gp * 2 + 1]; float xr = 0.f, xi = 0.f;
        for (int cb = 0; cb < 4; ++cb) { f32x2 sv[32];
#pragma unroll
            for (int c = 0; c < 32; ++c) sv[c] = *(const f32x2*)(Sst + ((size_t)(b * 128 + cb * 32 + c) * 4096 + gp) * 2);
#pragma unroll
            for (int c = 0; c < 32; ++c) { const size_t idx = ((size_t)(b * 128 + cb * 32 + c) * 4096 + gp) * 2; *(unsigned*)(Xs + idx) = cvt_pk_bf16(xr, xi);
                const float nr = lr * xr - li * xi + sv[c].x, ni = lr * xi + li * xr + sv[c].y; xr = nr; xi = ni; } }
    }
}
template <int HF> __device__ __forceinline__ void s3_half(const int tid, const int fr, const int fq, const int g, const int colw, const bf16_t* MV, const bf16x8 (&Bu)[2][8], const bf16x8 (&Bx)[2][4], bf16_t* gout, LAS unsigned char* L) {
    __syncthreads();
#pragma unroll
    for (int eb = 0; eb < 3; ++eb) {
#pragma unroll
        for (int e = 0; e < 4; ++e) { const int idx = tid + (eb * 4 + e) * 512, r = idx / 48, c = idx % 48; *(LAS u32x4*)(L + r * 784 + c * 16) = *(const u32x4*)(MV + ((size_t)g * 256 + HF * 128 + r) * 384 + c * 8); }
        asm volatile("" ::: "memory"); }
    __syncthreads();
#pragma unroll
    for (int mg = 0; mg < 2; ++mg) {
        f32x4 acc[4][2];
#pragma unroll
        for (int mt = 0; mt < 4; ++mt) { acc[mt][0] = (f32x4){0.f, 0.f, 0.f, 0.f}; acc[mt][1] = (f32x4){0.f, 0.f, 0.f, 0.f}; }
#pragma unroll
        for (int mt = 0; mt < 4; ++mt) {
#pragma unroll
            for (int kk = 0; kk < 12; ++kk) { if (kk < 8 && kk > ((HF * 8 + mg * 4 + mt) >> 1)) continue;
                const bf16x8 Af = *(const LAS bf16x8*)(L + ((mg * 4 + mt) * 16 + fr) * 784 + kk * 64 + fq * 16);
                if (kk < 8) { acc[mt][0] = __builtin_amdgcn_mfma_f32_16x16x32_bf16(Af, Bu[0][kk < 8 ? kk : 0], acc[mt][0], 0, 0, 0); acc[mt][1] = __builtin_amdgcn_mfma_f32_16x16x32_bf16(Af, Bu[1][kk < 8 ? kk : 0], acc[mt][1], 0, 0, 0); }
                else { acc[mt][0] = __builtin_amdgcn_mfma_f32_16x16x32_bf16(Af, Bx[0][kk >= 8 ? kk - 8 : 0], acc[mt][0], 0, 0, 0); acc[mt][1] = __builtin_amdgcn_mfma_f32_16x16x32_bf16(Af, Bx[1][kk >= 8 ? kk - 8 : 0], acc[mt][1], 0, 0, 0); } } }
#pragma unroll
        for (int mt = 0; mt < 4; ++mt)
#pragma unroll
            for (int nt = 0; nt < 2; ++nt) { const int col = colw + nt * 16 + fr, t = HF * 8 + mg * 4 + mt; const size_t o = ((size_t)col * 16 + t) * 1024 + g * 16 + fq * 4; f32x4 r;
#pragma unroll
                for (int i = 0; i < 4; ++i) r[i] = gelu_tanh(acc[mt][nt][i]);
                st4bf(gout + o, r); }
    }
}
__device__ __forceinline__ void s3_phase(const int tidv, const bf16_t* Xs, const bf16_t* MV, const bf16_t* u, bf16_t* gout, LAS unsigned char* L) {
    const int tid = tidv, lane = tid & 63, wave = __builtin_amdgcn_readfirstlane(tid >> 6), fr = lane & 15, fq = lane >> 4;
    for (int it = blockIdx.x; it < 256; it += gridDim.x) {
        const int g = it >> 2, cb = it & 3, colw = cb * 256 + wave * 32;
        bf16x8 Bu[2][8], Bx[2][4];
#pragma unroll
        for (int nt = 0; nt < 2; ++nt) { const int col = colw + nt * 16 + fr;
#pragma unroll
            for (int kk = 0; kk < 8; ++kk) Bu[nt][kk] = *(const bf16x8*)(u + ((size_t)col * 16 + 2 * kk + (fq >> 1)) * 1024 + g * 16 + (fq & 1) * 8);
#pragma unroll
            for (int kk = 0; kk < 4; ++kk) Bx[nt][kk] = *(const bf16x8*)(Xs + ((size_t)col * 64 + g) * 128 + kk * 32 + fq * 8); }
        s3_half<0>(tid, fr, fq, g, colw, MV, Bu, Bx, gout, L);
        s3_half<1>(tid, fr, fq, g, colw, MV, Bu, Bx, gout, L);
    }
}

__global__ void __launch_bounds__(512, 2) mega(Args a) {
    extern __shared__ __attribute__((aligned(16))) unsigned char lds_raw[];
    LAS unsigned char* L = (LAS unsigned char*)lds_raw;
    cg::grid_group grid = cg::this_grid();
    volatile LAS unsigned* stw = (volatile LAS unsigned*)(L + 131072);
    if (threadIdx.x < 2) stw[threadIdx.x] = 0u;
    __syncthreads();
    const XcdBarrier xbar = xcd_barrier_post((unsigned*)(a.ws + WS_BAR), stw);
    if (a.ph_lo > a.ph_hi) grid.sync();
    unsigned char* ws = a.ws;
    const float* x_in = a.in[0]; float* out = a.out;
    const float* norm_pre = a.in[4]; const float* norm_post = a.in[5];
    const float* mod = (const float*)(ws + WS_MOD);
    bf16_t* XB = (bf16_t*)(ws + WS_XB); bf16_t* H = (bf16_t*)(ws + WS_H); bf16_t* F = (bf16_t*)(ws + WS_F); bf16_t* ACT = (bf16_t*)(ws + WS_ACT);
    const int G = gridDim.x, bx = blockIdx.x;
#define MODP(l, s) (mod + (size_t)(l) * 8 * 9216 + (s) * 3072)
#define NPRE(l, s) (norm_pre + ((l) * 3 + (s)) * 1024)
#define NPOST(l, s) (norm_post + ((l) * 3 + (s)) * 1024)
    for (int ph = a.ph_lo; ph < a.ph_hi; ++ph) {
        int nrep = 1; if ((PROBE_MASK >> ph) & 1u) nrep += PROBE_N;
        for (int rep = 0; rep < nrep; ++rep) {
        int tidv = threadIdx.x; asm volatile("" : "+v"(tidv));
        switch (ph) {
        case 0: p0_phase(tidv, a, L, rep == 0); break;
        case 1: r_phase<false, true, false, false>(tidv, x_in, nullptr, nullptr, H, nullptr, nullptr, 0.f, NPRE(0, 0), MODP(0, 0)); break;
        case 4: r_phase<true, true, false, true>(tidv, x_in, F, XB, H, NPOST(0, 0), MODP(0, 0), 0.5f, NPRE(0, 1), MODP(0, 1)); break;
        case 8: case 11: case 14: case 20: {
            int lp, sp, ln, sn; float rw;
            if (ph == 8) { lp = 0; sp = 1; ln = 0; sn = 2; rw = 1.0f; } else if (ph == 11) { lp = 0; sp = 2; ln = 1; sn = 0; rw = 0.5f; }
            else if (ph == 14) { lp = 1; sp = 0; ln = 1; sn = 1; rw = 0.5f; } else { lp = 1; sp = 1; ln = 1; sn = 2; rw = 1.0f; }
            r_phase<true, true, true, true>(tidv, XB, F, XB, H, NPOST(lp, sp), MODP(lp, sp), rw, NPRE(ln, sn), MODP(ln, sn)); } break;
        case 23: r_phase<true, false, true, false>(tidv, XB, F, out, nullptr, NPOST(1, 2), MODP(1, 2), 0.5f, nullptr, nullptr); break;
        case 2: case 9: case 12: case 21: {
            const int w = (ph == 2) ? 0 : (ph == 9) ? 1 : (ph == 12) ? 2 : 3;
            pg8::Gemm g{H, (const bf16_t*)(ws + WS_WIN) + (size_t)w * 5632 * 1024, T_, 2 * DFF, D_}; pg8::StaticOrder S; S.init(T_, 2 * DFF, G, bx);
            EpiGated<0> E{ACT, DFF}; pg8::gemm_phase<EpiGated<0>, pg8::StaticOrder, true, true>(L, g, S, E, tidv); } break;
        case 3: case 10: case 13: case 22: case 5: case 7: case 15: {
            pg8::Gemm g; EpiPlain E;
            if (ph == 5) { g = pg8::Gemm{H, (const bf16_t*)(ws + WS_ABIN), T_, 1536, D_}; E = EpiPlain{(bf16_t*)(ws + WS_Z), 1536, 2}; }
            else if (ph == 7) { g = pg8::Gemm{(const bf16_t*)(ws + WS_YCAT), (const bf16_t*)(ws + WS_ABOUT), T_, D_, D_}; E = EpiPlain{F, D_, 1 << 30}; }
            else if (ph == 15) { g = pg8::Gemm{H, (const bf16_t*)(ws + WS_SSMIN), T_, D_, D_}; E = EpiPlain{(bf16_t*)(ws + WS_U), D_, 1 << 30}; }
            else { const int w = (ph == 3) ? 0 : (ph == 10) ? 1 : (ph == 13) ? 2 : 3;
                g = pg8::Gemm{ACT, (const bf16_t*)(ws + WS_WOUT) + (size_t)w * 1024 * 2816, T_, D_, DFF}; E = EpiPlain{F, D_, 1 << 30}; }
            pg8::StaticOrder S; S.init(g.M, g.N, G, bx);
            pg8::gemm_phase<EpiPlain, pg8::StaticOrder, true, true>(L, g, S, E, tidv); } break;
        case 6: mix0_phase(tidv, (const bf16_t*)(ws + WS_Z), (const bf16_t*)(ws + WS_SMALL), a.in[10], a.in[11], a.in[12], (const bf16_t*)(ws + WS_SMALL) + 65536, a.in[14], (bf16_t*)(ws + WS_YCAT), L); break;
        case 16: s1_phase(tidv, (const bf16_t*)(ws + WS_U), (const bf16_t*)(ws + WS_V), (float*)(ws + WS_SST), L); break;
        case 17: s2_phase(tidv, (const float*)(ws + WS_SST), (const float*)(ws + WS_LAML), (bf16_t*)(ws + WS_XS)); break;
        case 18: s3_phase(tidv, (const bf16_t*)(ws + WS_XS), (const bf16_t*)(ws + WS_MW), (const bf16_t*)(ws + WS_U), (bf16_t*)(ws + WS_G), L); break;
        case 19: { pg8::Gemm g{(const bf16_t*)(ws + WS_G), (const bf16_t*)(ws + WS_GLU), T_, 2 * D_, D_}; pg8::StaticOrder S; S.init(T_, 2 * D_, G, bx);
            EpiGated<1> E{F, D_}; pg8::gemm_phase<EpiGated<1>, pg8::StaticOrder, true, true>(L, g, S, E, tidv); } break;
        default: break;
        }
        }
        if (ph == 2 || ph == 9 || ph == 12) {
            int first = 1408 - 5 * G; if (first < 0 || first >= G) first = 0;
            if (bx >= first) { int t2 = threadIdx.x; asm volatile("" : "+v"(t2)); const int wv = __builtin_amdgcn_readfirstlane(t2 >> 6);
                t_run(a, ws, L, wv, t2 & 63, ph == 2 ? 1 : (ph == 9 ? 2 : 3), (bx - first) * 8 + wv, (G - first) * 8); } }
        if (ph + 1 < a.ph_hi) { xcd_barrier(xbar); for (int s = 0; s < PROBE_SYNC; ++s) xcd_barrier(xbar); }
    }
}

extern "C" void kernel_launch(void* const* d_in, const int* in_sizes, int n_in, void* d_out, int out_size, void* d_ws, size_t ws_size, hipStream_t stream) {
    static int grid = 0;
    if (grid == 0) {
        if (n_in != 26 || in_sizes[0] != T_ * D_ || out_size != T_ * D_ || ws_size < WS_END) { fprintf(stderr, "kernel_launch: unexpected shapes (n_in %d, in0 %d, out %d, ws %zu)\n", n_in, n_in > 0 ? in_sizes[0] : -1, out_size, ws_size); grid = -1; return; }
        int dev = 0, cus = 0, per_cu = 0;
        if (hipGetDevice(&dev) != hipSuccess || hipDeviceGetAttribute(&cus, hipDeviceAttributeMultiprocessorCount, dev) != hipSuccess) { grid = -1; return; }
        if (hipFuncSetAttribute((const void*)mega, hipFuncAttributeMaxDynamicSharedMemorySize, LDS_BYTES) != hipSuccess) { fprintf(stderr, "kernel_launch: hipFuncSetAttribute failed\n"); grid = -1; return; }
        if (hipOccupancyMaxActiveBlocksPerMultiprocessor(&per_cu, (const void*)mega, 512, LDS_BYTES) != hipSuccess || per_cu < 1) { fprintf(stderr, "kernel_launch: occupancy query gave %d\n", per_cu); per_cu = 1; (void)hipGetLastError(); }
        grid = cus * per_cu;
    }
    if (grid < 0) return;
    (void)hipMemsetAsync((char*)d_ws, 0, 1 * MiB, stream);
    Args a{};
    for (int i = 0; i < 26; ++i) a.in[i] = (const float*)d_in[i];
    a.out = (float*)d_out; a.ws = (unsigned char*)d_ws;
#if MK_PER_PHASE
    for (int ph = 0; ph < NPH; ++ph) { a.ph_lo = ph; a.ph_hi = ph + 1; hipLaunchKernelGGL(mega, dim3(grid), dim3(512), LDS_BYTES, stream, a); }
#else
    a.ph_lo = 0; a.ph_hi = NPH;
    void* args[] = {&a};
    hipError_t e = hipLaunchCooperativeKernel((const void*)mega, dim3(grid), dim3(512), args, LDS_BYTES, stream);
    if (e != hipSuccess) fprintf(stderr, "kernel_launch: cooperative launch failed: %s (grid %d)\n", hipGetErrorString(e), grid);
#endif
}
```

```cpp
#include <hip/hip_runtime.h>
#include <hip/hip_cooperative_groups.h>
#include <cstdio>
#include <cstdint>
namespace cg = cooperative_groups;
namespace pg8 {
#define PG8_LAS __attribute__((address_space(3)))
typedef unsigned short bf16_t;
typedef short bf16x8 __attribute__((ext_vector_type(8)));
typedef float f32x4 __attribute__((ext_vector_type(4)));
typedef unsigned u32x4 __attribute__((ext_vector_type(4)));
constexpr int BM = 256, BK = 64, HALF = 128, HTB = HALF * BK * 2  , STAGE_BYTES = 8 * HTB, NXCD = 8, WGM = 8;

__host__ __device__ __forceinline__ int lds_byte(int r, int c) { const int st = (r >> 4) * 2 + (c >> 5), rr = r & 15, cc = c & 31, ob = rr * 64 + cc * 2; return st * 1024 + (ob ^ (((ob >> 9) & 1) << 5)); }
__host__ __device__ __forceinline__ void stage_rc(int b, int& R, int& C) { const int st = b / 1024, sb = b % 1024, swz = sb ^ (((sb >> 9) & 1) << 5); R = (st >> 1) * 16 + swz / 64; C = (st & 1) * 32 + (swz % 64) / 2; }
__host__ __device__ __forceinline__ int perm32(int rho) { const int n = rho >> 4, i = rho & 15; return 8 * (i >> 2) + 4 * n + (i & 3); }

struct Unit { int pm, pn; };
struct Gemm { const bf16_t* A; const bf16_t* Bt; int M, N, K; };

struct StaticOrder {
    int nM, nN, nwg, G, c;
    __host__ __device__ void init(int M, int N, int G_, int c_) { nM = M / BM; nN = N / BM; nwg = nM * nN; G = G_; c = c_; }
    __host__ __device__ bool next(int i, Unit& u) const {
        const long L = (long)i * G + c; if (L >= nwg) return false;
        int wgid = (int)L; { const int q = nwg / NXCD, r = nwg % NXCD, xcd = wgid % NXCD, off = wgid / NXCD; wgid = (xcd < r ? xcd * (q + 1) : r * (q + 1) + (xcd - r) * q) + off; }
        const int nig = WGM * nN, gid = wgid / nig, fm = gid * WGM, gsz = (nM - fm) < WGM ? (nM - fm) : WGM;
        u.pm = fm + ((wgid % nig) % gsz); u.pn = (wgid % nig) / gsz; return true;
    }
    __device__ __forceinline__ void a_ready(const Unit&) const {}
    __device__ __forceinline__ void done(const Unit&) const {}
};

__device__ __forceinline__ unsigned cvt_pk_bf16(float lo, float hi) { unsigned r; asm volatile("v_cvt_pk_bf16_f32 %0, %1, %2" : "=v"(r) : "v"(lo), "v"(hi)); return r; }
typedef float f32x2 __attribute__((ext_vector_type(2)));
template <class Epi, class Sched, bool ALIGN_EPI = false, bool SP2 = false>
__device__ __forceinline__ void gemm_phase(PG8_LAS unsigned char* lds, const Gemm g, const Sched& S, const Epi& E, const int tid_in) {
    const int tid = tid_in, wid = __builtin_amdgcn_readfirstlane(tid >> 6), lane = tid & 63, wr = wid >> 2, wc = wid & 3, fr = lane & 15, fq = lane >> 4;
    const int K = g.K, nt = K / BK;
    unsigned voffA[2], voffB[2];
#pragma unroll
    for (int i = 0; i < 2; ++i) { int R, C; stage_rc(tid * 16 + i * 8192, R, C); const int Rb = Epi::PERM ? ((R & ~31) + perm32(R & 31)) : R;
        voffA[i] = (unsigned)(R * K + C) * 2u; voffB[i] = (unsigned)(Rb * K + C) * 2u; }
    const size_t kstep = (size_t)(BK * 2);
    const size_t hstep = (size_t)HALF * K * 2;
    const size_t tstep = 2 * hstep;
    const unsigned ldsw = (unsigned)wid * 1024u;
    const int aoff = lds_byte(wr * 64 + fr, fq * 8), boff = lds_byte(wc * 32 + fr, fq * 8);
#define PG8_SA(b, h) (((b) * 2 + (h)) * HTB)
#define PG8_SB(b, h) ((4 + (b) * 2 + (h)) * HTB)
#define PG8_STAGE(bufoff, gbase, voff) do { _Pragma("unroll") for (int _i = 0; _i < 2; ++_i) \
        __builtin_amdgcn_global_load_lds((const unsigned*)((const char*)(gbase) + (voff)[_i]), (PG8_LAS unsigned*)(lds + (bufoff) + ldsw + _i * 8192), 16, 0, 0); } while (0)
#define PG8_LDA(dst, b, h) do { _Pragma("unroll") for (int m = 0; m < 4; ++m) _Pragma("unroll") for (int k = 0; k < 2; ++k) dst[m][k] = *(const PG8_LAS bf16x8*)(lds + PG8_SA(b, h) + aoff + m * 2048 + k * 1024); } while (0)
#define PG8_LDB(dst, b, h) do { _Pragma("unroll") for (int n = 0; n < 2; ++n) _Pragma("unroll") for (int k = 0; k < 2; ++k) dst[n][k] = *(const PG8_LAS bf16x8*)(lds + PG8_SB(b, h) + boff + n * 2048 + k * 1024); } while (0)
#define PG8_MMA(ai, bj, At, Bt) do { __builtin_amdgcn_s_setprio(1); _Pragma("unroll") for (int m = 0; m < 4; ++m) _Pragma("unroll") for (int n = 0; n < 2; ++n) _Pragma("unroll") for (int k = 0; k < 2; ++k) \
        acc[ai][bj][m][n] = __builtin_amdgcn_mfma_f32_16x16x32_bf16(Bt[n][k], At[m][k], acc[ai][bj][m][n], 0, 0, 0); __builtin_amdgcn_s_setprio(0); } while (0)
#define PG8_WAIT_V(n) asm volatile("s_waitcnt vmcnt(" #n ")" ::: "memory")
#define PG8_WAIT_L(n) asm volatile("s_waitcnt lgkmcnt(" #n ")" ::: "memory")
#define PG8_BAR __builtin_amdgcn_s_barrier()
#define PG8_SCHED __builtin_amdgcn_sched_barrier(0)
    Unit cur, nxt; int ui = 0;
    if (!S.next(0, cur)) return;
    f32x4 acc[2][2][4][2];
#pragma unroll
    for (int a = 0; a < 2; ++a)
#pragma unroll
        for (int b = 0; b < 2; ++b)
#pragma unroll
            for (int m = 0; m < 4; ++m)
#pragma unroll
                for (int n = 0; n < 2; ++n) acc[a][b][m][n] = (f32x4){0.f, 0.f, 0.f, 0.f};
    bf16x8 At[4][2], B0[2][2], B1[2][2];
    const char* cA = (const char*)g.A + (size_t)cur.pm * tstep; const char* cB = (const char*)g.Bt + (size_t)cur.pn * tstep;
    S.a_ready(cur);
    if constexpr (SP2) {
        PG8_STAGE(PG8_SB(0, 0), cB, voffB); PG8_STAGE(PG8_SB(0, 1), cB + hstep, voffB); PG8_STAGE(PG8_SA(0, 0), cA, voffA); PG8_STAGE(PG8_SA(0, 1), cA + hstep, voffA);
        if (wr == 1) PG8_BAR;
        PG8_WAIT_V(2); PG8_BAR;
        PG8_STAGE(PG8_SB(1, 0), cB + kstep, voffB); PG8_STAGE(PG8_SA(1, 0), cA + kstep, voffA); PG8_STAGE(PG8_SB(1, 1), cB + hstep + kstep, voffB);
        PG8_WAIT_V(6); PG8_BAR;
    } else {
        PG8_STAGE(PG8_SB(0, 0), cB, voffB); PG8_STAGE(PG8_SA(0, 0), cA, voffA); PG8_STAGE(PG8_SB(0, 1), cB + hstep, voffB); PG8_STAGE(PG8_SA(0, 1), cA + hstep, voffA);
        if (wr == 1) PG8_BAR;
        PG8_WAIT_V(4); PG8_BAR;
        PG8_STAGE(PG8_SB(1, 0), cB + kstep, voffB); PG8_STAGE(PG8_SA(1, 0), cA + kstep, voffA); PG8_STAGE(PG8_SB(1, 1), cB + hstep + kstep, voffB);
        PG8_WAIT_V(6); PG8_BAR;
    }
    for (;;) {
        const bool has_next = S.next(ui + 1, nxt);
        const char* nA = has_next ? (const char*)g.A + (size_t)nxt.pm * tstep : cA; const char* nB = has_next ? (const char*)g.Bt + (size_t)nxt.pn * tstep : cB;
        for (int t = 0; t < nt; t += 2) {
            const bool last = (t == nt - 2);
            const char* a1 = cA + (size_t)(t + 1) * kstep;
            const char* a2 = last ? nA : cA + (size_t)(t + 2) * kstep; const char* b2 = last ? nB : cB + (size_t)(t + 2) * kstep;
            const char* a3 = a2 + kstep; const char* b3 = b2 + kstep;
            if (last && has_next) S.a_ready(nxt);
            if constexpr (SP2) {
            PG8_LDB(B0, 0, 0); PG8_LDB(B1, 0, 1); PG8_SCHED; PG8_LDA(At, 0, 0); PG8_STAGE(PG8_SA(1, 1), a1 + hstep, voffA);
            PG8_WAIT_V(8); PG8_WAIT_L(0); PG8_BAR; PG8_MMA(0, 0, At, B0); PG8_MMA(0, 1, At, B1); PG8_BAR; PG8_SCHED;
            PG8_LDA(At, 0, 1); PG8_STAGE(PG8_SB(0, 0), b2, voffB); PG8_STAGE(PG8_SB(0, 1), b2 + hstep, voffB); PG8_STAGE(PG8_SA(0, 0), a2, voffA);
            PG8_WAIT_V(8); PG8_WAIT_L(0); PG8_BAR; PG8_MMA(1, 0, At, B0); PG8_MMA(1, 1, At, B1); PG8_BAR; PG8_SCHED;
            PG8_LDB(B0, 1, 0); PG8_LDB(B1, 1, 1); PG8_SCHED; PG8_LDA(At, 1, 0); PG8_STAGE(PG8_SA(0, 1), a2 + hstep, voffA);
            PG8_WAIT_V(8); PG8_WAIT_L(0); PG8_BAR; PG8_MMA(0, 0, At, B0); PG8_MMA(0, 1, At, B1); PG8_BAR; PG8_SCHED;
            PG8_LDA(At, 1, 1); PG8_STAGE(PG8_SB(1, 0), b3, voffB); PG8_STAGE(PG8_SB(1, 1), b3 + hstep, voffB); PG8_STAGE(PG8_SA(1, 0), a3, voffA);
            PG8_WAIT_V(8); PG8_WAIT_L(0); PG8_BAR; PG8_MMA(1, 0, At, B0); PG8_MMA(1, 1, At, B1); PG8_BAR; PG8_SCHED;
            } else {
            PG8_LDB(B0, 0, 0); PG8_SCHED; PG8_LDA(At, 0, 0); PG8_STAGE(PG8_SA(1, 1), a1 + hstep, voffA);
            PG8_WAIT_L(8); PG8_BAR; PG8_WAIT_L(0); PG8_MMA(0, 0, At, B0); PG8_BAR; PG8_SCHED;
            PG8_LDB(B1, 0, 1); PG8_STAGE(PG8_SB(0, 0), b2, voffB);
            PG8_BAR; PG8_WAIT_L(0); PG8_MMA(0, 1, At, B1); PG8_BAR;
            PG8_LDA(At, 0, 1); PG8_STAGE(PG8_SA(0, 0), a2, voffA);
            PG8_BAR; PG8_WAIT_L(0); PG8_MMA(1, 0, At, B0); PG8_BAR; PG8_SCHED;
            PG8_STAGE(PG8_SB(0, 1), b2 + hstep, voffB);
            PG8_WAIT_V(6); PG8_BAR; PG8_MMA(1, 1, At, B1); PG8_BAR;
            PG8_LDB(B0, 1, 0); PG8_SCHED; PG8_LDA(At, 1, 0); PG8_STAGE(PG8_SA(0, 1), a2 + hstep, voffA);
            PG8_WAIT_L(8); PG8_BAR; PG8_WAIT_L(0); PG8_MMA(0, 0, At, B0); PG8_BAR; PG8_SCHED;
            PG8_LDB(B1, 1, 1); PG8_STAGE(PG8_SB(1, 0), b3, voffB);
            PG8_BAR; PG8_WAIT_L(0); PG8_MMA(0, 1, At, B1); PG8_BAR;
            PG8_LDA(At, 1, 1); PG8_STAGE(PG8_SA(1, 0), a3, voffA);
            PG8_BAR; PG8_WAIT_L(0); PG8_MMA(1, 0, At, B0); PG8_BAR; PG8_SCHED;
            PG8_STAGE(PG8_SB(1, 1), b3 + hstep, voffB);
            PG8_WAIT_V(6); PG8_BAR; PG8_MMA(1, 1, At, B1); PG8_BAR;
            }
        }
        if constexpr (ALIGN_EPI) { if (wr == 0) PG8_BAR; }
        if constexpr (!Epi::AFTER_DRAIN) { E(acc, cur, wr, wc, fr, fq); S.done(cur); }
        if (!has_next) break;
#pragma unroll
        for (int a = 0; a < 2; ++a)
#pragma unroll
            for (int b = 0; b < 2; ++b)
#pragma unroll
                for (int m = 0; m < 4; ++m)
#pragma unroll
                    for (int n = 0; n < 2; ++n) acc[a][b][m][n] = (f32x4){0.f, 0.f, 0.f, 0.f};
        cur = nxt; cA = nA; cB = nB; ++ui;
        if constexpr (ALIGN_EPI) { if (wr == 1) PG8_BAR; }
    }
    PG8_WAIT_V(0);
    if constexpr (!ALIGN_EPI) { if (wr == 0) PG8_BAR; }
    PG8_BAR;
    if constexpr (Epi::AFTER_DRAIN) { E.fused(acc, cur, wr, wc, fr, fq, lds, wid, lane); S.done(cur); }
#undef PG8_SA
#undef PG8_SB
#undef PG8_STAGE
#undef PG8_LDA
#undef PG8_LDB
#undef PG8_MMA
#undef PG8_WAIT_V
#undef PG8_WAIT_L
#undef PG8_BAR
#undef PG8_SCHED
}
}
using pg8::bf16_t; using pg8::bf16x8; using pg8::f32x4; using pg8::u32x4; using pg8::cvt_pk_bf16; using pg8::f32x2;
#define LAS __attribute__((address_space(3)))
typedef unsigned u32x2 __attribute__((ext_vector_type(2)));
#define XB_TMO      128
#define XB_XCNT(j)  (256  + 64 * (j))
#define XB_XSUB(j)  (1280 + 64 * (j))
#define XB_XGEN(j)  (2304 + 64 * (j))
#define XB_TOP      3328
#define XB_TOPGEN   3392
#define XCD_BAR_WORDS 3456
#define XB_SPIN_CAP (1u << 18)

__device__ __forceinline__ unsigned xb_ld(unsigned* p)              { return __hip_atomic_load(p, __ATOMIC_RELAXED, __HIP_MEMORY_SCOPE_AGENT); }
__device__ __forceinline__ unsigned xb_add(unsigned* p, unsigned v) { return __hip_atomic_fetch_add(p, v, __ATOMIC_RELAXED, __HIP_MEMORY_SCOPE_AGENT); }
__device__ __forceinline__ unsigned xb_xcc_id() { return (unsigned)__builtin_amdgcn_s_getreg((3 << 11) | 20) & 0xFu; }
#define XB_SPIN(cond, bar) do { unsigned _sp = 0; while (cond) { __builtin_amdgcn_s_sleep(1); \
    if ((++_sp & 255u) == 0u) { if (xb_ld(&(bar)[XB_TMO])) break; if (_sp > XB_SPIN_CAP) { atomicAdd(&(bar)[XB_TMO], 1u); break; } } } } while (0)

struct XcdBarrier {
    unsigned* bar; unsigned x;
    volatile LAS unsigned* st;
};

__device__ __forceinline__ XcdBarrier xcd_barrier_post(unsigned* bar, volatile LAS unsigned* st) {
    XcdBarrier b; b.bar = bar; b.x = xb_xcc_id(); b.st = st;
    if (threadIdx.x == 0) (void)xb_add(&bar[XB_XCNT(b.x)], 1u);
    return b;
}
__device__ __forceinline__ void xcd_barrier_complete(unsigned* bar, unsigned x, unsigned& nloc, unsigned& nx) {
    const unsigned G = gridDim.x * gridDim.y * gridDim.z;
    unsigned sum, cnt, mine, sp = 0u;
    for (;;) {
        sum = 0u; cnt = 0u; mine = 0u;
#pragma unroll
        for (unsigned j = 0; j < 16; ++j) { const unsigned c = xb_ld(&bar[XB_XCNT(j)]); sum += c; cnt += (c > 0u) ? 1u : 0u; mine = (j == x) ? c : mine; }
        if (sum == G) break;
        __builtin_amdgcn_s_sleep(1);
        if ((++sp & 255u) == 0u) { if (xb_ld(&bar[XB_TMO])) break; if (sp > XB_SPIN_CAP) { atomicAdd(&bar[XB_TMO], 1u); break; } }
    }
    nloc = mine > 0u ? mine : 1u; nx = cnt > 0u ? cnt : 1u;
}

__device__ __forceinline__ void xcd_barrier(const XcdBarrier& b) {
    asm volatile("s_waitcnt vmcnt(0)" ::: "memory");
    __syncthreads();
    if (threadIdx.x == 0) {
        unsigned* bar = b.bar;
        __builtin_amdgcn_s_waitcnt(0);
        unsigned nloc = b.st[0], nx = b.st[1];
        if (nloc == 0u) { xcd_barrier_complete(bar, b.x, nloc, nx); b.st[0] = nloc; b.st[1] = nx; }
        const unsigned old = xb_add(&bar[XB_XSUB(b.x)], 1u);
        const unsigned gen = old / nloc;
        if (old + 1u == (gen + 1u) * nloc) {
            __builtin_amdgcn_fence(__ATOMIC_RELEASE, "agent");
            asm volatile("s_waitcnt vmcnt(0)" ::: "memory");
            const unsigned og = xb_add(&bar[XB_TOP], 1u);
            const unsigned tg = og / nx;
            if (og + 1u == (tg + 1u) * nx) xb_add(&bar[XB_TOPGEN], 1u);
            else XB_SPIN(xb_ld(&bar[XB_TOPGEN]) == tg, bar);
            __builtin_amdgcn_fence(__ATOMIC_ACQUIRE, "agent");
            xb_add(&bar[XB_XGEN(b.x)], 1u);
            asm volatile("s_waitcnt vmcnt(0)" ::: "memory");
        } else {
            XB_SPIN(xb_ld(&bar[XB_XGEN(b.x)]) == gen, bar);
            __builtin_amdgcn_fence(__ATOMIC_ACQUIRE, "agent");
            asm volatile("s_waitcnt vmcnt(0)" ::: "memory");
        }
    }
    __syncthreads();
}


#ifndef MK_PER_PHASE
#define MK_PER_PHASE 0
#endif
#define PROBE_MASK 0u
#define PROBE_N 0
#define PROBE_SYNC 0

constexpr int T_ = 16384, D_ = 1024, DFF = 2816, SEQ = 2048;
constexpr float EPS = 1e-6f;
constexpr size_t MiB = 1u << 20;
constexpr size_t WS_MOD = 0, WS_BAR = 768 * 1024, WS_LAML = 1 * MiB, WS_MW = 2 * MiB, WS_V = 14 * MiB, WS_WIN = 18 * MiB, WS_WOUT = 62 * MiB, WS_ABIN = 84 * MiB,
                 WS_ABOUT = 87 * MiB, WS_SSMIN = 89 * MiB, WS_GLU = 91 * MiB, WS_SMALL = 95 * MiB, WS_H = 96 * MiB, WS_F = 128 * MiB, WS_ACT = 160 * MiB,
                 WS_XB = 248 * MiB, WS_END = 280 * MiB;
constexpr size_t WS_Z = WS_ACT, WS_YCAT = WS_ACT + 48 * MiB;
constexpr size_t WS_U = WS_ACT, WS_YI = WS_ACT + 32 * MiB, WS_XS = WS_ACT + 64 * MiB, WS_G = WS_H, WS_SST = WS_F;
constexpr int LDS_BYTES = 139264;
constexpr int NPH = 24;

struct Args { const float* in[26]; float* out; unsigned char* ws; int ph_lo, ph_hi; };

__device__ __forceinline__ float dpp_f(float v, const int ctrl) { return v; }
#define DPP_ADD(v, ctrl) ((v) + __builtin_bit_cast(float, __builtin_amdgcn_update_dpp(0, __builtin_bit_cast(int, (v)), (ctrl), 0xf, 0xf, true)))
__device__ __forceinline__ float wave_sum(float v) {
    v = DPP_ADD(v, 0xB1);
    v = DPP_ADD(v, 0x4E);
    v = DPP_ADD(v, 0x141);
    v = DPP_ADD(v, 0x140);
    const int iv = __builtin_bit_cast(int, v);
    return (__builtin_bit_cast(float, __builtin_amdgcn_readlane(iv, 0)) + __builtin_bit_cast(float, __builtin_amdgcn_readlane(iv, 16))) +
           (__builtin_bit_cast(float, __builtin_amdgcn_readlane(iv, 32)) + __builtin_bit_cast(float, __builtin_amdgcn_readlane(iv, 48)));
}
__device__ __forceinline__ float bf2f(unsigned b) { return __uint_as_float(b << 16); }
__device__ __forceinline__ unsigned f2bf(float f) { unsigned u = __float_as_uint(f); return (u + 0x7fffu + ((u >> 16) & 1u)) >> 16; }
__device__ __forceinline__ f32x4 ld4bf(const bf16_t* p) { const u32x2 v = *(const u32x2*)p; f32x4 r; r.x = __uint_as_float(v.x << 16); r.y = __uint_as_float(v.x & 0xffff0000u); r.z = __uint_as_float(v.y << 16); r.w = __uint_as_float(v.y & 0xffff0000u); return r; }
__device__ __forceinline__ void st4bf(bf16_t* p, f32x4 v) { u32x2 w; w.x = cvt_pk_bf16(v.x, v.y); w.y = cvt_pk_bf16(v.z, v.w); *(u32x2*)p = w; }
__device__ __forceinline__ float gelu_tanh(float x) { const float t = 1.5957691216f * (x + 0.044715f * x * x * x); return x * __builtin_amdgcn_rcpf(1.0f + __expf(-t)); }

template <int MODE> struct EpiGated {
    static constexpr bool PERM = true, AFTER_DRAIN = false;
    bf16_t* O; int ldc;
    __device__ __forceinline__ void operator()(const f32x4 (&acc)[2][2][4][2], const pg8::Unit& u, int wr, int wc, int fr, int fq) const {
        const int row0 = u.pm * 256 + wr * 64 + fr, col0 = u.pn * 128 + wc * 32 + 8 * fq;
#pragma unroll
        for (int ai = 0; ai < 2; ++ai)
#pragma unroll
            for (int m = 0; m < 4; ++m) {
                bf16_t* rowp = O + (size_t)(row0 + ai * 128 + m * 16) * ldc + col0;
                float v[8];
#pragma unroll
                for (int n = 0; n < 2; ++n)
#pragma unroll
                    for (int i = 0; i < 4; ++i) { const float a = acc[ai][0][m][n][i], b = acc[ai][1][m][n][i];
                        v[n * 4 + i] = (MODE == 0) ? a * b * __builtin_amdgcn_rcpf(1.0f + __expf(-a)) : a * __builtin_amdgcn_rcpf(1.0f + __expf(-b)); }
                u32x4 w; w.x = cvt_pk_bf16(v[0], v[1]); w.y = cvt_pk_bf16(v[2], v[3]); w.z = cvt_pk_bf16(v[4], v[5]); w.w = cvt_pk_bf16(v[6], v[7]);
                *(u32x4*)rowp = w;
            }
    }
};
struct EpiPlain {
    static constexpr bool PERM = true, AFTER_DRAIN = false;
    bf16_t* O; int ldc; int gelu_from;
    __device__ __forceinline__ void operator()(const f32x4 (&acc)[2][2][4][2], const pg8::Unit& u, int wr, int wc, int fr, int fq) const {
        const int row0 = u.pm * 256 + wr * 64 + fr, col0 = u.pn * 256 + wc * 32 + 8 * fq; const bool gl = u.pn >= gelu_from;
#pragma unroll
        for (int ai = 0; ai < 2; ++ai)
#pragma unroll
            for (int m = 0; m < 4; ++m) {
                bf16_t* rowp = O + (size_t)(row0 + ai * 128 + m * 16) * ldc + col0;
#pragma unroll
                for (int bj = 0; bj < 2; ++bj) { f32x4 v0 = acc[ai][bj][m][0], v1 = acc[ai][bj][m][1];
                    if (gl) {
#pragma unroll
                        for (int i = 0; i < 4; ++i) { v0[i] = gelu_tanh(v0[i]); v1[i] = gelu_tanh(v1[i]); } }
                    u32x4 w; w.x = cvt_pk_bf16(v0[0], v0[1]); w.y = cvt_pk_bf16(v0[2], v0[3]); w.z = cvt_pk_bf16(v1[0], v1[1]); w.w = cvt_pk_bf16(v1[2], v1[3]);
                    *(u32x4*)(rowp + bj * 128) = w; }
            }
    }
};

struct TItem { const float* src; bf16_t* dst; int N, K; };
__device__ __forceinline__ TItem t_decode(const Args& a, unsigned char* ws, int r) {
    constexpr int I_IN = 16 * 176, I_OUT = 44 * 32, I_ABIN = 16 * 48, I_SQ = 16 * 32;
    const float* W; bf16_t* WT; int K, N, mode = 0;
    if (r < 4 * I_IN) { const int w = r / I_IN; r -= w * I_IN; W = a.in[6] + (size_t)w * 1024 * 5632; K = 1024; N = 5632; WT = (bf16_t*)(ws + WS_WIN) + (size_t)w * 5632 * 1024; mode = 1; }
    else if ((r -= 4 * I_IN) < 4 * I_OUT) { const int w = r / I_OUT; r -= w * I_OUT; W = a.in[7] + (size_t)w * 2816 * 1024; K = 2816; N = 1024; WT = (bf16_t*)(ws + WS_WOUT) + (size_t)w * 1024 * 2816; }
    else if ((r -= 4 * I_OUT) < I_ABIN) { W = a.in[8]; K = 1024; N = 1536; WT = (bf16_t*)(ws + WS_ABIN); }
    else if ((r -= I_ABIN) < I_SQ) { W = a.in[15]; K = 1024; N = 1024; WT = (bf16_t*)(ws + WS_ABOUT); }
    else if ((r -= I_SQ) < I_SQ) { W = a.in[16]; K = 1024; N = 1024; WT = (bf16_t*)(ws + WS_SSMIN); }
    else { r -= I_SQ; W = a.in[25]; K = 1024; N = 2048; WT = (bf16_t*)(ws + WS_GLU); mode = 1; }
    const int nblk = N / 32, kb = r / nblk, nb = r % nblk, k0 = 64 * kb, n0 = 32 * nb;
    int r0 = n0;
    if (mode) { const int half = N >> 1, hf = (n0 >= half) ? 1 : 0, j = n0 - hf * half; r0 = (j >> 7) * 256 + hf * 128 + (j & 127); }
    TItem t; t.src = W + (size_t)k0 * N + n0; t.dst = WT + (size_t)r0 * K + k0; t.N = N; t.K = K; return t;
}
__device__ __forceinline__ int t_remap(const int set, const int d) {
    if (set == 0) return d < 2816 ? d : 11264 + (d - 2816);
    if (set == 1) return d < 2816 ? 2816 + d : (d < 4224 ? 11264 + 1408 + (d - 2816) : 16896 + (d - 4224));
    if (set == 2) return d < 2816 ? 5632 + d : (d < 4224 ? 11264 + 2816 + (d - 2816) : 18176 + (d - 4224));
    return d < 2816 ? 8448 + d : 11264 + 4224 + (d - 2816);
}
__device__ __forceinline__ void t_run(const Args& a, unsigned char* ws, LAS unsigned char* L, const int wave, const int lane, const int set, const int worker, const int nworkers) {
    const int NIT = (set == 0) ? 4224 : (set == 1) ? 5504 : (set == 2) ? 5760 : 4224;
    LAS float* scr = (LAS float*)(L + wave * 8448);
    int it = worker; TItem cur, nxt; float tv[32];
    if (it < NIT) { cur = t_decode(a, ws, t_remap(set, it));
#pragma unroll
        for (int i = 0; i < 32; ++i) tv[i] = cur.src[(size_t)(2 * i + (lane >> 5)) * cur.N + (lane & 31)]; }
    while (it < NIT) {
#pragma unroll
        for (int i = 0; i < 32; ++i) scr[(2 * i + (lane >> 5)) * 33 + (lane & 31)] = tv[i];
        const int itn = it + nworkers;
        if (itn < NIT) { nxt = t_decode(a, ws, t_remap(set, itn));
#pragma unroll
            for (int i = 0; i < 32; ++i) tv[i] = nxt.src[(size_t)(2 * i + (lane >> 5)) * nxt.N + (lane & 31)]; }
        asm volatile("s_waitcnt lgkmcnt(0)" ::: "memory");
        const int cc = lane & 7;
#pragma unroll
        for (int j = 0; j < 4; ++j) { const int n = (lane >> 3) + 8 * j; const LAS float* s = scr + (8 * cc) * 33 + n;
            u32x4 o; o.x = cvt_pk_bf16(s[0 * 33], s[1 * 33]); o.y = cvt_pk_bf16(s[2 * 33], s[3 * 33]); o.z = cvt_pk_bf16(s[4 * 33], s[5 * 33]); o.w = cvt_pk_bf16(s[6 * 33], s[7 * 33]);
            *(u32x4*)(cur.dst + (size_t)n * cur.K + 8 * cc) = o; }
        asm volatile("s_waitcnt lgkmcnt(0)" ::: "memory");
        cur = nxt; it = itn; }
}

__device__ __forceinline__ void ssm_precompute(const int tidv, int g, const int part, const float* lam_re, const float* lam_im, const float* b_re, const float* b_im, const float* c_re, const float* c_im,
                                               const float* log_dt, const float* dskip, bf16_t* MW, bf16_t* V, float* lamL, LAS unsigned char* L) {
    LAS float* pw = (LAS float*)L;
    LAS float* Bb = pw + 17 * 64 * 2;
    LAS float* Cc = Bb + 2048;
    LAS float* Kk = Cc + 2080;
    const int tid = tidv;
    const float dt = expf(log_dt[g]);
    for (int idx = tid; idx < 17 * 64; idx += 512) { const int j = idx >> 6, p = idx & 63; const float lr = lam_re[g * 64 + p], li = lam_im[g * 64 + p];
        const float mag = expf((float)j * dt * lr); double rev = (double)j * (double)dt * (double)li * 0.15915494309189535; rev -= rint(rev);
        const float ang = (float)(rev * 6.283185307179586); pw[idx * 2] = mag * __cosf(ang); pw[idx * 2 + 1] = mag * __sinf(ang); }
    for (int idx = tid; idx < 1024; idx += 512) { const int p = idx >> 4; const float lr = lam_re[g * 64 + p], li = lam_im[g * 64 + p];
        const float mag = expf(dt * lr); double rev = (double)dt * (double)li * 0.15915494309189535; rev -= rint(rev); const float ang = (float)(rev * 6.283185307179586);
        const float er = mag * __cosf(ang) - 1.0f, ei = mag * __sinf(ang);
        const float den = 1.0f / (lr * lr + li * li); const float qr = (er * lr + ei * li) * den, qi = (ei * lr - er * li) * den;
        const float br = b_re[g * 1024 + idx], bi = b_im[g * 1024 + idx];
        Bb[idx * 2] = qr * br - qi * bi; Bb[idx * 2 + 1] = qr * bi + qi * br; }
    for (int idx = tid; idx < 1024; idx += 512) { const int n = idx >> 6, p = idx & 63; Cc[(n * 65 + p) * 2] = c_re[g * 1024 + idx]; Cc[(n * 65 + p) * 2 + 1] = c_im[g * 1024 + idx]; }
    __syncthreads();
    { const int j = tid >> 5, n = (tid >> 1) & 15, mh = tid & 1; float s[8];
#pragma unroll
      for (int e2 = 0; e2 < 8; ++e2) s[e2] = 0.f;
      for (int p = 0; p < 64; ++p) { const f32x2 cv = *(const LAS f32x2*)(Cc + (n * 65 + p) * 2), pv = *(const LAS f32x2*)(pw + (j * 64 + p) * 2);
          const float xr = cv.x * pv.x - cv.y * pv.y, xi = cv.x * pv.y + cv.y * pv.x;
#pragma unroll
          for (int e2 = 0; e2 < 4; ++e2) { const f32x4 bb = *(const LAS f32x4*)(Bb + (p * 16 + mh * 8 + 2 * e2) * 2); s[2 * e2] += xr * bb.x - xi * bb.y; s[2 * e2 + 1] += xr * bb.z - xi * bb.w; } }
#pragma unroll
      for (int e2 = 0; e2 < 8; ++e2) Kk[(j * 16 + n) * 16 + mh * 8 + e2] = s[e2]; }
    __syncthreads();
    bf16_t* MVg = MW + (size_t)g * 256 * 384; bf16_t* Wg = V + (size_t)g * 128 * 256;
    for (int q = part * 8192 + tid; q < (part + 1) * 8192; q += 512) { const int row = q >> 7, c2 = (q & 127) * 2; const int t = row >> 4, n = row & 15, s = c2 >> 4, m = c2 & 15;
        float v0 = 0.f, v1 = 0.f; if (s <= t) { v0 = Kk[((t - s) * 16 + n) * 16 + m]; v1 = Kk[((t - s) * 16 + n) * 16 + m + 1]; }
        if (s == t) { if (m == n) v0 += dskip[g * 16 + n]; if (m + 1 == n) v1 += dskip[g * 16 + n]; }
        *(unsigned*)(MVg + row * 384 + c2) = cvt_pk_bf16(v0, v1); }
    for (int q = part * 4096 + tid; q < (part + 1) * 4096; q += 512) { const int r = q >> 7, c2 = (q & 127) * 2; const int p = r >> 1, ri = r & 1, s = c2 >> 4, m = c2 & 15;
        const float pr = pw[((15 - s) * 64 + p) * 2], pi = pw[((15 - s) * 64 + p) * 2 + 1]; float v[2];
#pragma unroll
        for (int e = 0; e < 2; ++e) { const float br = Bb[(p * 16 + m + e) * 2], bi = Bb[(p * 16 + m + e) * 2 + 1]; v[e] = ri ? (pr * bi + pi * br) : (pr * br - pi * bi); }
        *(unsigned*)(Wg + r * 256 + c2) = cvt_pk_bf16(v[0], v[1]); }
    for (int q = part * 4096 + tid; q < (part + 1) * 4096; q += 512) { const int row = q >> 6, p = q & 63; const int t = row >> 4, n = row & 15;
        const float cr = Cc[(n * 65 + p) * 2], ci = Cc[(n * 65 + p) * 2 + 1], pr = pw[((t + 1) * 64 + p) * 2], pi = pw[((t + 1) * 64 + p) * 2 + 1];
        *(unsigned*)(MVg + row * 384 + 256 + 2 * p) = cvt_pk_bf16(cr * pr - ci * pi, -(cr * pi + ci * pr)); }
    if (part == 0 && tid < 64) { lamL[(g * 64 + tid) * 2] = pw[(16 * 64 + tid) * 2]; lamL[(g * 64 + tid) * 2 + 1] = pw[(16 * 64 + tid) * 2 + 1]; }
}

__device__ __forceinline__ void p0_phase(const int tidv, const Args& a, LAS unsigned char* L, const bool do_mod) {
    const int tid = tidv, lane = tid & 63, wave = __builtin_amdgcn_readfirstlane(tid >> 6), G = gridDim.x, bx = blockIdx.x;
    unsigned char* ws = a.ws;
    for (int gi = bx; gi < 256; gi += G) { const int g = gi >> 2;
        ssm_precompute(tidv, g, gi & 3, a.in[17], a.in[18], a.in[19], a.in[20], a.in[21], a.in[22], a.in[24], a.in[23], (bf16_t*)(ws + WS_MW), (bf16_t*)(ws + WS_V), (float*)(ws + WS_LAML), L);
        __syncthreads(); }
    { bf16_t* pwt = (bf16_t*)(ws + WS_SMALL); bf16_t* sgw = pwt + 65536; const float* pool_w = a.in[9]; const float* sgu_w = a.in[13];
      for (int i = bx * 512 + tid; i < 65536; i += G * 512) { const int gg = i >> 14, o = (i >> 7) & 127, ii = i & 127;
          pwt[i] = (bf16_t)f2bf(pool_w[(gg * 128 + ii) * 128 + o]); sgw[i] = (ii <= o) ? (bf16_t)f2bf(sgu_w[i]) : (bf16_t)0; } }
    { LAS float* cond = (LAS float*)L; const float* c = a.in[1];
      for (int i = tid; i < 8192; i += 512) { const float v = c[i]; cond[i] = v / (1.0f + __expf(-v)); }
      __syncthreads();
      float* mod = (float*)(ws + WS_MOD); const float* ada_w = a.in[2]; const float* ada_b = a.in[3];
      LAS float* red = cond + 8192;
      if (do_mod) for (int it = bx; it < 256; it += G) { const int l = it >> 7, col0 = (it & 127) * 72, c4 = tid % 18, ks = tid / 18;
          f32x4 acc[8];
#pragma unroll
          for (int b = 0; b < 8; ++b) acc[b] = (f32x4){0.f, 0.f, 0.f, 0.f};
          if (ks < 28) {
              const float* wp = ada_w + (size_t)l * 1024 * 9216 + col0 + 4 * c4;
#pragma unroll 4
              for (int k = ks; k < 1024; k += 28) { const f32x4 w = *(const f32x4*)(wp + (size_t)k * 9216);
#pragma unroll
                  for (int b = 0; b < 8; ++b) acc[b] = acc[b] + w * cond[b * 1024 + k]; }
#pragma unroll
              for (int b = 0; b < 8; ++b) *(LAS f32x4*)(red + (ks * 8 + b) * 72 + 4 * c4) = acc[b]; }
          __syncthreads();
          for (int o = tid; o < 576; o += 512) { const int b = o / 72, cc = o % 72; float s = ada_b[l * 9216 + col0 + cc];
              for (int k2 = 0; k2 < 28; ++k2) s += red[(k2 * 8 + b) * 72 + cc];
              mod[((size_t)l * 8 + b) * 9216 + col0 + cc] = s; }
          __syncthreads(); }
      __syncthreads(); }
    t_run(a, ws, L, wave, lane, 0, bx * 8 + wave, G * 8);
}

template <bool HAS_PREV, bool HAS_NEXT, bool XIN_BF, bool XOUT_BF>
__device__ __forceinline__ void r_phase(const int tidv, const void* xin_, const bf16_t* f, void* xout_, bf16_t* h, const float* gpost, const float* modprev, float rw, const float* gpre, const float* modnext) {
    const int tid = tidv, lane = tid & 63, wave = tid >> 6; const int gw = blockIdx.x * 8 + wave, NGW = gridDim.x * 8;
    for (int rb = gw; rb < T_ / 8; rb += NGW) {
        const int r0 = rb * 8, b = r0 / SEQ;
        f32x4 A1[4], A2[4], A3[4];
#pragma unroll
        for (int c = 0; c < 4; ++c) { const int col = c * 256 + lane * 4;
            if (HAS_PREV) { const f32x4 gp = *(const f32x4*)(gpost + col), gt = *(const f32x4*)(modprev + (size_t)b * 9216 + 2048 + col); A1[c] = gp * gt * rw; }
            if (HAS_NEXT) { const f32x4 gq = *(const f32x4*)(gpre + col), sc = *(const f32x4*)(modnext + (size_t)b * 9216 + 1024 + col); A2[c] = gq * (sc + 1.0f); A3[c] = *(const f32x4*)(modnext + (size_t)b * 9216 + col); } }
        for (int r = r0; r < r0 + 8; ++r) {
            f32x4 xv[4];
#pragma unroll
            for (int c = 0; c < 4; ++c) { if (XIN_BF) xv[c] = ld4bf((const bf16_t*)xin_ + (size_t)r * D_ + c * 256 + lane * 4); else xv[c] = *(const f32x4*)((const float*)xin_ + (size_t)r * D_ + c * 256 + lane * 4); }
            if (HAS_PREV) { f32x4 fv[4]; float ss = 0.f;
#pragma unroll
                for (int c = 0; c < 4; ++c) { fv[c] = ld4bf(f + (size_t)r * D_ + c * 256 + lane * 4); ss += fv[c].x * fv[c].x + fv[c].y * fv[c].y + fv[c].z * fv[c].z + fv[c].w * fv[c].w; }
                const float rs = rsqrtf(wave_sum(ss) * (1.0f / D_) + EPS);
#pragma unroll
                for (int c = 0; c < 4; ++c) { xv[c] = xv[c] + A1[c] * fv[c] * rs;
                    if (XOUT_BF) st4bf((bf16_t*)xout_ + (size_t)r * D_ + c * 256 + lane * 4, xv[c]); else *(f32x4*)((float*)xout_ + (size_t)r * D_ + c * 256 + lane * 4) = xv[c]; } }
            if (HAS_NEXT) { float ss = 0.f;
#pragma unroll
                for (int c = 0; c < 4; ++c) ss += xv[c].x * xv[c].x + xv[c].y * xv[c].y + xv[c].z * xv[c].z + xv[c].w * xv[c].w;
                const float rs = rsqrtf(wave_sum(ss) * (1.0f / D_) + EPS);
#pragma unroll
                for (int c = 0; c < 4; ++c) st4bf(h + (size_t)r * D_ + c * 256 + lane * 4, xv[c] * rs * A2[c] + A3[c]); }
        }
    }
}

template <int W> __device__ __forceinline__ void pool_prep(const int tid, const int q, const bf16_t* z, const int row0, const int g, LAS unsigned char* As) {
    const int i4 = tid & 31, t0 = (tid >> 5) * 8, pos0 = (q & 15) * 128 + t0;
    const bf16_t* zp = z + (size_t)(row0 + t0) * 1536 + g * 128 + 4 * i4;
    u32x2 raw[W + 7];
#pragma unroll
    for (int i = 0; i < W + 7; ++i) { const int rel = i - (W - 1); const bool valid = (pos0 + rel) >= 0; raw[i] = *(const u32x2*)(zp + (ptrdiff_t)(valid ? rel : 0) * 1536); if (!valid) { raw[i].x = 0u; raw[i].y = 0u; } }
    f32x4 sum = {0.f, 0.f, 0.f, 0.f};
#define UNPK(v) ((f32x4){__uint_as_float((v).x << 16), __uint_as_float((v).x & 0xffff0000u), __uint_as_float((v).y << 16), __uint_as_float((v).y & 0xffff0000u)})
#pragma unroll
    for (int i = 0; i < W - 1; ++i) sum = sum + UNPK(raw[i]);
#pragma unroll
    for (int r = 0; r < 8; ++r) { const f32x4 cur = UNPK(raw[W - 1 + r]); sum = sum + cur; if (r > 0) sum = sum - UNPK(raw[r - 1]);
        const float inv = 1.0f / (float)min(pos0 + r + 1, W); const f32x4 d = sum * inv - cur;
        u32x2 o; o.x = cvt_pk_bf16(d.x, d.y); o.y = cvt_pk_bf16(d.z, d.w); *(LAS u32x2*)(As + (t0 + r) * 272 + 8 * i4) = o; }
#undef UNPK
}
__device__ __forceinline__ void mix0_phase(const int tidv, const bf16_t* z, const bf16_t* pool_wt, const float* pool_scale, const float* ln_g, const float* ln_b, const bf16_t* sguw, const float* sgu_b,
                                           bf16_t* ycat, LAS unsigned char* L) {
    LAS unsigned char* As = L; LAS unsigned char* Bs = L + 34816; LAS float* st = (LAS float*)(L + 69632);
    const int tid = tidv, lane = tid & 63, wave = __builtin_amdgcn_readfirstlane(tid >> 6), fr = lane & 15, fq = lane >> 4;
    for (int it = blockIdx.x; it < 1024; it += gridDim.x) {
        const int q = it >> 3, unit = (it & 7) ^ (((it / (int)gridDim.x) & 1) << 2), row0 = q * 128;
        __syncthreads();
        if (unit < 4) {
            const int g = unit;
            if (g == 0) pool_prep<2>(tid, q, z, row0, g, As); else if (g == 1) pool_prep<4>(tid, q, z, row0, g, As); else if (g == 2) pool_prep<8>(tid, q, z, row0, g, As); else pool_prep<16>(tid, q, z, row0, g, As);
#pragma unroll
            for (int e = 0; e < 4; ++e) { const int idx = tid + e * 512, r = idx >> 4, c = idx & 15; *(LAS u32x4*)(Bs + r * 272 + c * 16) = *(const u32x4*)(pool_wt + g * 16384 + r * 128 + c * 8); }
        } else {
            const int hh = unit - 4;
#pragma unroll
            for (int e = 0; e < 4; ++e) { const int idx = tid + e * 512, r = idx >> 4, c = idx & 15; *(LAS u32x4*)(As + r * 272 + c * 16) = *(const u32x4*)(sguw + hh * 16384 + r * 128 + c * 8); }
            unsigned vraw[16];
#pragma unroll
            for (int i = 0; i < 16; ++i) vraw[i] = *(const unsigned*)(z + (size_t)(row0 + wave * 16 + i) * 1536 + 1024 + hh * 128 + 2 * lane);
#pragma unroll
            for (int i = 0; i < 16; ++i) { const int s = wave * 16 + i; const unsigned vv = vraw[i];
                const float v0 = __uint_as_float(vv << 16), v1 = __uint_as_float(vv & 0xffff0000u); const float mean = wave_sum(v0 + v1) * (1.0f / 128.0f);
                const float d0 = v0 - mean, d1 = v1 - mean; const float var = wave_sum(d0 * d0 + d1 * d1) * (1.0f / 128.0f);
                if (lane == 0) { st[s * 2] = mean; st[s * 2 + 1] = rsqrtf(var + EPS); } }
            __syncthreads();
            const int d = tid & 127, sg = tid >> 7; const float gln = ln_g[hh * 128 + d], bln = ln_b[hh * 128 + d];
#pragma unroll
            for (int sb = 0; sb < 4; ++sb) { const int s0 = sg * 32 + sb * 8; float vn[8];
#pragma unroll
                for (int k = 0; k < 8; ++k) { const float v = bf2f(z[(size_t)(row0 + s0 + k) * 1536 + 1024 + hh * 128 + d]); vn[k] = (v - st[(s0 + k) * 2]) * st[(s0 + k) * 2 + 1] * gln + bln; }
                u32x4 o; o.x = cvt_pk_bf16(vn[0], vn[1]); o.y = cvt_pk_bf16(vn[2], vn[3]); o.z = cvt_pk_bf16(vn[4], vn[5]); o.w = cvt_pk_bf16(vn[6], vn[7]);
                *(LAS u32x4*)(Bs + d * 272 + s0 * 2) = o; }
        }
        __syncthreads();
        const int wr = wave >> 1, wc = wave & 1;
        f32x4 acc[2][4];
#pragma unroll
        for (int m = 0; m < 2; ++m)
#pragma unroll
            for (int n = 0; n < 4; ++n) acc[m][n] = (f32x4){0.f, 0.f, 0.f, 0.f};
#pragma unroll
        for (int kk = 0; kk < 4; ++kk) { bf16x8 Af[2];
#pragma unroll
            for (int m = 0; m < 2; ++m) Af[m] = *(const LAS bf16x8*)(As + (32 * wr + 16 * m + fr) * 272 + kk * 64 + fq * 16);
#pragma unroll
            for (int n = 0; n < 4; ++n) { const bf16x8 Bf = *(const LAS bf16x8*)(Bs + (64 * wc + 16 * n + fr) * 272 + kk * 64 + fq * 16);
#pragma unroll
                for (int m = 0; m < 2; ++m) acc[m][n] = __builtin_amdgcn_mfma_f32_16x16x32_bf16(Bf, Af[m], acc[m][n], 0, 0, 0); } }
#pragma unroll
        for (int m = 0; m < 2; ++m) { const int row = 32 * wr + 16 * m + fr;
#pragma unroll
            for (int n = 0; n < 4; ++n) { const int col = 64 * wc + 16 * n + 4 * fq;
                if (unit < 4) { const f32x4 sc = *(const f32x4*)(pool_scale + unit * 128 + col); st4bf(ycat + (size_t)(row0 + row) * 1024 + unit * 128 + col, acc[m][n] * sc); }
                else { const int hh = unit - 4; const f32x4 uu = ld4bf(z + (size_t)(row0 + row) * 1536 + 512 + hh * 128 + col); const float bs = sgu_b[hh * 128 + row];
                    st4bf(ycat + (size_t)(row0 + row) * 1024 + 512 + hh * 128 + col, uu * (acc[m][n] + bs)); } } }
    }
}

__device__ __forceinline__ void s1_phase(const int tidv, const bf16_t* u, const bf16_t* Wm, float* Sst, LAS unsigned char* L) {
    const int tid = tidv, lane = tid & 63, wave = __builtin_amdgcn_readfirstlane(tid >> 6), fr = lane & 15, fq = lane >> 4;
    for (int it = blockIdx.x; it < 256; it += gridDim.x) {
        const int g = it >> 2, cb = it & 3, colw = cb * 256 + wave * 32;
        bf16x8 Bf[2][8];
#pragma unroll
        for (int nt = 0; nt < 2; ++nt)
#pragma unroll
            for (int kk = 0; kk < 8; ++kk) { const int col = colw + nt * 16 + fr; Bf[nt][kk] = *(const bf16x8*)(u + ((size_t)col * 16 + 2 * kk + (fq >> 1)) * 1024 + g * 16 + (fq & 1) * 8); }
        __syncthreads();
#pragma unroll
        for (int e = 0; e < 8; ++e) { const int idx = tid + e * 512, r = idx >> 5, c = idx & 31; *(LAS u32x4*)(L + r * 528 + c * 16) = *(const u32x4*)(Wm + ((size_t)g * 128 + r) * 256 + c * 8); }
        __syncthreads();
        f32x4 acc[8][2];
#pragma unroll
        for (int mt = 0; mt < 8; ++mt) { acc[mt][0] = (f32x4){0.f, 0.f, 0.f, 0.f}; acc[mt][1] = (f32x4){0.f, 0.f, 0.f, 0.f}; }
#pragma unroll
        for (int mt = 0; mt < 8; ++mt)
#pragma unroll
            for (int kk = 0; kk < 8; ++kk) { const bf16x8 Af = *(const LAS bf16x8*)(L + (mt * 16 + fr) * 528 + kk * 64 + fq * 16);
                acc[mt][0] = __builtin_amdgcn_mfma_f32_16x16x32_bf16(Af, Bf[0][kk], acc[mt][0], 0, 0, 0);
                acc[mt][1] = __builtin_amdgcn_mfma_f32_16x16x32_bf16(Af, Bf[1][kk], acc[mt][1], 0, 0, 0); }
#pragma unroll
        for (int mt = 0; mt < 8; ++mt)
#pragma unroll
            for (int nt = 0; nt < 2; ++nt) { const int col = colw + nt * 16 + fr; *(f32x4*)(Sst + ((size_t)col * 64 + g) * 128 + mt * 16 + fq * 4) = acc[mt][nt]; }
    }
}
__device__ __forceinline__ void s2_phase(const int tidv, const float* Sst, const float* lamL, bf16_t* Xs) {
    if (tidv < 128) for (int gt = blockIdx.x * 128 + tidv; gt < 32768; gt += gridDim.x * 128) {
        const int b = gt >> 12, gp = gt & 4095; const float lr = lamL[gp * 2], li = lamL[gp * 2 + 1]; float xr = 0.f, xi = 0.f;
        for (int cb = 0; cb < 4; ++cb) { f32x2 sv[32];
#pragma unroll
            for (int c = 0; c < 32; ++c) sv[c] = *(const f32x2*)(Sst + ((size_t)(b * 128 + cb * 32 + c) * 4096 + gp) * 2);
#pragma unroll
            for (int c = 0; c < 32; ++c) { const size_t idx = ((size_t)(b * 128 + cb * 32 + c) * 4096 + gp) * 2; *(unsigned*)(Xs + idx) = cvt_pk_bf16(xr, xi);
                const float nr = lr * xr - li * xi + sv[c].x, ni = lr * xi + li * xr + sv[c].y; xr = nr; xi = ni; } }
    }
}
template <int HF> __device__ __forceinline__ void s3_half(const int tid, const int fr, const int fq, const int g, const int colw, const bf16_t* MV, const bf16x8 (&Bu)[2][8], const bf16x8 (&Bx)[2][4], bf16_t* gout, LAS unsigned char* L) {
    __syncthreads();
#pragma unroll
    for (int eb = 0; eb < 3; ++eb) {
#pragma unroll
        for (int e = 0; e < 4; ++e) { const int idx = tid + (eb * 4 + e) * 512, r = idx / 48, c = idx % 48; *(LAS u32x4*)(L + r * 784 + c * 16) = *(const u32x4*)(MV + ((size_t)g * 256 + HF * 128 + r) * 384 + c * 8); }
        asm volatile("" ::: "memory"); }
    __syncthreads();
#pragma unroll
    for (int mg = 0; mg < 2; ++mg) {
        f32x4 acc[4][2];
#pragma unroll
        for (int mt = 0; mt < 4; ++mt) { acc[mt][0] = (f32x4){0.f, 0.f, 0.f, 0.f}; acc[mt][1] = (f32x4){0.f, 0.f, 0.f, 0.f}; }
#pragma unroll
        for (int mt = 0; mt < 4; ++mt) {
#pragma unroll
            for (int kk = 0; kk < 12; ++kk) { if (kk < 8 && kk > ((HF * 8 + mg * 4 + mt) >> 1)) continue;
                const bf16x8 Af = *(const LAS bf16x8*)(L + ((mg * 4 + mt) * 16 + fr) * 784 + kk * 64 + fq * 16);
                if (kk < 8) { acc[mt][0] = __builtin_amdgcn_mfma_f32_16x16x32_bf16(Af, Bu[0][kk < 8 ? kk : 0], acc[mt][0], 0, 0, 0); acc[mt][1] = __builtin_amdgcn_mfma_f32_16x16x32_bf16(Af, Bu[1][kk < 8 ? kk : 0], acc[mt][1], 0, 0, 0); }
                else { acc[mt][0] = __builtin_amdgcn_mfma_f32_16x16x32_bf16(Af, Bx[0][kk >= 8 ? kk - 8 : 0], acc[mt][0], 0, 0, 0); acc[mt][1] = __builtin_amdgcn_mfma_f32_16x16x32_bf16(Af, Bx[1][kk >= 8 ? kk - 8 : 0], acc[mt][1], 0, 0, 0); } } }
#pragma unroll
        for (int mt = 0; mt < 4; ++mt)
#pragma unroll
            for (int nt = 0; nt < 2; ++nt) { const int col = colw + nt * 16 + fr, t = HF * 8 + mg * 4 + mt; const size_t o = ((size_t)col * 16 + t) * 1024 + g * 16 + fq * 4; f32x4 r;
#pragma unroll
                for (int i = 0; i < 4; ++i) r[i] = gelu_tanh(acc[mt][nt][i]);
                st4bf(gout + o, r); }
    }
}
__device__ __forceinline__ void s3_half_rt(const int HF, const int tid, const int fr, const int fq, const int g, const int colw, const bf16_t* MV, const bf16x8 (&Bu)[2][8], const bf16x8 (&Bx)[2][4], bf16_t* gout, LAS unsigned char* L) {
    __syncthreads();
#pragma unroll
    for (int eb = 0; eb < 3; ++eb) {
#pragma unroll
        for (int e = 0; e < 4; ++e) { const int idx = tid + (eb * 4 + e) * 512, r = idx / 48, c = idx % 48; *(LAS u32x4*)(L + r * 784 + c * 16) = *(const u32x4*)(MV + ((size_t)g * 256 + HF * 128 + r) * 384 + c * 8); }
        asm volatile("" ::: "memory"); }
    __syncthreads();
#pragma unroll
    for (int mg = 0; mg < 2; ++mg) {
        f32x4 acc[4][2];
#pragma unroll
        for (int mt = 0; mt < 4; ++mt) { acc[mt][0] = (f32x4){0.f, 0.f, 0.f, 0.f}; acc[mt][1] = (f32x4){0.f, 0.f, 0.f, 0.f}; }
#pragma unroll
        for (int mt = 0; mt < 4; ++mt) {
#pragma unroll
            for (int kk = 0; kk < 12; ++kk) { if (kk < 8 && kk > ((HF * 8 + mg * 4 + mt) >> 1)) continue;
                const bf16x8 Af = *(const LAS bf16x8*)(L + ((mg * 4 + mt) * 16 + fr) * 784 + kk * 64 + fq * 16);
                if (kk < 8) { acc[mt][0] = __builtin_amdgcn_mfma_f32_16x16x32_bf16(Af, Bu[0][kk < 8 ? kk : 0], acc[mt][0], 0, 0, 0); acc[mt][1] = __builtin_amdgcn_mfma_f32_16x16x32_bf16(Af, Bu[1][kk < 8 ? kk : 0], acc[mt][1], 0, 0, 0); }
                else { acc[mt][0] = __builtin_amdgcn_mfma_f32_16x16x32_bf16(Af, Bx[0][kk >= 8 ? kk - 8 : 0], acc[mt][0], 0, 0, 0); acc[mt][1] = __builtin_amdgcn_mfma_f32_16x16x32_bf16(Af, Bx[1][kk >= 8 ? kk - 8 : 0], acc[mt][1], 0, 0, 0); } } }
#pragma unroll
        for (int mt = 0; mt < 4; ++mt)
#pragma unroll
            for (int nt = 0; nt < 2; ++nt) { const int col = colw + nt * 16 + fr, t = HF * 8 + mg * 4 + mt; const size_t o = ((size_t)col * 16 + t) * 1024 + g * 16 + fq * 4; f32x4 r;
#pragma unroll
                for (int i = 0; i < 4; ++i) r[i] = gelu_tanh(acc[mt][nt][i]);
                st4bf(gout + o, r); }
    }
}
__device__ __forceinline__ void s3_phase(const int tidv, const bf16_t* Xs, const bf16_t* MV, const bf16_t* u, bf16_t* gout, LAS unsigned char* L) {
    const int tid = tidv, lane = tid & 63, wave = __builtin_amdgcn_readfirstlane(tid >> 6), fr = lane & 15, fq = lane >> 4;
    for (int it = blockIdx.x; it < 256; it += gridDim.x) {
        const int g = it >> 2, cb = it & 3, colw = cb * 256 + wave * 32;
        bf16x8 Bu[2][8], Bx[2][4];
#pragma unroll
        for (int nt = 0; nt < 2; ++nt) { const int col = colw + nt * 16 + fr;
#pragma unroll
            for (int kk = 0; kk < 8; ++kk) Bu[nt][kk] = *(const bf16x8*)(u + ((size_t)col * 16 + 2 * kk + (fq >> 1)) * 1024 + g * 16 + (fq & 1) * 8);
#pragma unroll
            for (int kk = 0; kk < 4; ++kk) Bx[nt][kk] = *(const bf16x8*)(Xs + ((size_t)col * 64 + g) * 128 + kk * 32 + fq * 8); }
        s3_half<0>(tid, fr, fq, g, colw, MV, Bu, Bx, gout, L);
        s3_half<1>(tid, fr, fq, g, colw, MV, Bu, Bx, gout, L);
    }
}

__device__ __forceinline__ void ssm_phase(const int tidv, const bf16_t* u, const bf16_t* Wm, const bf16_t* MV, const float* lamL, bf16_t* gout, LAS unsigned char* L) {
    const int tid = tidv, lane = tid & 63, wave = __builtin_amdgcn_readfirstlane(tid >> 6), fr = lane & 15, fq = lane >> 4;
    for (int it = blockIdx.x; it < 256; it += gridDim.x) {
        const int g = it >> 2, cb = it & 3, colw = cb * 256 + wave * 32;
        bf16x8 Bu[2][8], Bx[2][4];
#pragma unroll
        for (int nt = 0; nt < 2; ++nt) { const int col = colw + nt * 16 + fr;
#pragma unroll
            for (int kk = 0; kk < 8; ++kk) Bu[nt][kk] = *(const bf16x8*)(u + ((size_t)col * 16 + 2 * kk + (fq >> 1)) * 1024 + g * 16 + (fq & 1) * 8); }
        __syncthreads();
#pragma unroll
        for (int e = 0; e < 8; ++e) { const int idx = tid + e * 512, r = idx >> 5, c = idx & 31; *(LAS u32x4*)(L + r * 528 + c * 16) = *(const u32x4*)(Wm + ((size_t)g * 128 + r) * 256 + c * 8); }
        __syncthreads();
#pragma unroll
        for (int nt = 0; nt < 2; ++nt) {
            f32x4 acc[8];
#pragma unroll
            for (int mt = 0; mt < 8; ++mt) acc[mt] = (f32x4){0.f, 0.f, 0.f, 0.f};
#pragma unroll
            for (int mt = 0; mt < 8; ++mt)
#pragma unroll
                for (int kk = 0; kk < 8; ++kk) { const bf16x8 Af = *(const LAS bf16x8*)(L + (mt * 16 + fr) * 528 + kk * 64 + fq * 16);
                    acc[mt] = __builtin_amdgcn_mfma_f32_16x16x32_bf16(Af, Bu[nt][kk], acc[mt], 0, 0, 0); }
            if (nt == 1) __syncthreads();
            const int slot = (1 - nt) * 128 + wave * 16 + fr;
#pragma unroll
            for (int mt = 0; mt < 8; ++mt) *(LAS f32x4*)(L + slot * 528 + (mt * 16 + fq * 4) * 4) = acc[mt];
        }
        __syncthreads();
        if (tid < 128) {
            const int bl = tid >> 6, p = tid & 63; const float lr = lamL[(g * 64 + p) * 2], li = lamL[(g * 64 + p) * 2 + 1]; float xr = 0.f, xi = 0.f;
#pragma unroll 8
            for (int c = 0; c < 128; ++c) { const int slot = (1 - ((c >> 4) & 1)) * 128 + (bl * 4 + (c >> 5)) * 16 + (c & 15);
                LAS unsigned char* sp = L + slot * 528 + p * 8; const f32x2 s = *(const LAS f32x2*)sp; *(LAS unsigned*)sp = cvt_pk_bf16(xr, xi);
                const float nr = lr * xr - li * xi + s.x, ni = lr * xi + li * xr + s.y; xr = nr; xi = ni; }
        }
        __syncthreads();
#pragma unroll
        for (int nt = 0; nt < 2; ++nt) { const int slot = (1 - nt) * 128 + wave * 16 + fr;
#pragma unroll
            for (int kk = 0; kk < 4; ++kk) { u32x4 w;
                w.x = *(const LAS unsigned*)(L + slot * 528 + (kk * 16 + fq * 4 + 0) * 8); w.y = *(const LAS unsigned*)(L + slot * 528 + (kk * 16 + fq * 4 + 1) * 8);
                w.z = *(const LAS unsigned*)(L + slot * 528 + (kk * 16 + fq * 4 + 2) * 8); w.w = *(const LAS unsigned*)(L + slot * 528 + (kk * 16 + fq * 4 + 3) * 8);
                Bx[nt][kk] = __builtin_bit_cast(bf16x8, w); } }
#pragma unroll 1
        for (int hf = 0; hf < 2; ++hf) s3_half_rt(hf, tid, fr, fq, g, colw, MV, Bu, Bx, gout, L);
    }
}

__global__ void __launch_bounds__(512, 2) mega(Args a) {
    extern __shared__ __attribute__((aligned(16))) unsigned char lds_raw[];
    LAS unsigned char* L = (LAS unsigned char*)lds_raw;
    cg::grid_group grid = cg::this_grid();
    volatile LAS unsigned* stw = (volatile LAS unsigned*)(L + LDS_BYTES - 64);
    if (threadIdx.x < 2) stw[threadIdx.x] = 0u;
    __syncthreads();
    const XcdBarrier xbar = xcd_barrier_post((unsigned*)(a.ws + WS_BAR), stw);
    if (a.ph_lo > a.ph_hi) grid.sync();
    unsigned char* ws = a.ws;
    const float* x_in = a.in[0]; float* out = a.out;
    const float* norm_pre = a.in[4]; const float* norm_post = a.in[5];
    const float* mod = (const float*)(ws + WS_MOD);
    bf16_t* XB = (bf16_t*)(ws + WS_XB); bf16_t* H = (bf16_t*)(ws + WS_H); bf16_t* F = (bf16_t*)(ws + WS_F); bf16_t* ACT = (bf16_t*)(ws + WS_ACT);
    const int G = gridDim.x, bx = blockIdx.x;
#define MODP(l, s) (mod + (size_t)(l) * 8 * 9216 + (s) * 3072)
#define NPRE(l, s) (norm_pre + ((l) * 3 + (s)) * 1024)
#define NPOST(l, s) (norm_post + ((l) * 3 + (s)) * 1024)
    for (int ph = a.ph_lo; ph < a.ph_hi; ++ph) {
        if (ph == 17 || ph == 18) continue;
        int nrep = 1; if ((PROBE_MASK >> ph) & 1u) nrep += PROBE_N;
        for (int rep = 0; rep < nrep; ++rep) {
        int tidv = threadIdx.x; asm volatile("" : "+v"(tidv));
        switch (ph) {
        case 0: p0_phase(tidv, a, L, rep == 0); break;
        case 1: r_phase<false, true, false, false>(tidv, x_in, nullptr, nullptr, H, nullptr, nullptr, 0.f, NPRE(0, 0), MODP(0, 0)); break;
        case 4: r_phase<true, true, false, true>(tidv, x_in, F, XB, H, NPOST(0, 0), MODP(0, 0), 0.5f, NPRE(0, 1), MODP(0, 1)); break;
        case 8: case 11: case 14: case 20: {
            int lp, sp, ln, sn; float rw;
            if (ph == 8) { lp = 0; sp = 1; ln = 0; sn = 2; rw = 1.0f; } else if (ph == 11) { lp = 0; sp = 2; ln = 1; sn = 0; rw = 0.5f; }
            else if (ph == 14) { lp = 1; sp = 0; ln = 1; sn = 1; rw = 0.5f; } else { lp = 1; sp = 1; ln = 1; sn = 2; rw = 1.0f; }
            r_phase<true, true, true, true>(tidv, XB, F, XB, H, NPOST(lp, sp), MODP(lp, sp), rw, NPRE(ln, sn), MODP(ln, sn)); } break;
        case 23: r_phase<true, false, true, false>(tidv, XB, F, out, nullptr, NPOST(1, 2), MODP(1, 2), 0.5f, nullptr, nullptr); break;
        case 2: case 9: case 12: case 21: {
            const int w = (ph == 2) ? 0 : (ph == 9) ? 1 : (ph == 12) ? 2 : 3;
            pg8::Gemm g{H, (const bf16_t*)(ws + WS_WIN) + (size_t)w * 5632 * 1024, T_, 2 * DFF, D_}; pg8::StaticOrder S; S.init(T_, 2 * DFF, G, bx);
            EpiGated<0> E{ACT, DFF}; pg8::gemm_phase<EpiGated<0>, pg8::StaticOrder, true, true>(L, g, S, E, tidv); } break;
        case 3: case 10: case 13: case 22: case 5: case 7: case 15: {
            pg8::Gemm g; EpiPlain E;
            if (ph == 5) { g = pg8::Gemm{H, (const bf16_t*)(ws + WS_ABIN), T_, 1536, D_}; E = EpiPlain{(bf16_t*)(ws + WS_Z), 1536, 2}; }
            else if (ph == 7) { g = pg8::Gemm{(const bf16_t*)(ws + WS_YCAT), (const bf16_t*)(ws + WS_ABOUT), T_, D_, D_}; E = EpiPlain{F, D_, 1 << 30}; }
            else if (ph == 15) { g = pg8::Gemm{H, (const bf16_t*)(ws + WS_SSMIN), T_, D_, D_}; E = EpiPlain{(bf16_t*)(ws + WS_U), D_, 1 << 30}; }
            else { const int w = (ph == 3) ? 0 : (ph == 10) ? 1 : (ph == 13) ? 2 : 3;
                g = pg8::Gemm{ACT, (const bf16_t*)(ws + WS_WOUT) + (size_t)w * 1024 * 2816, T_, D_, DFF}; E = EpiPlain{F, D_, 1 << 30}; }
            pg8::StaticOrder S; S.init(g.M, g.N, G, bx);
            pg8::gemm_phase<EpiPlain, pg8::StaticOrder, true, true>(L, g, S, E, tidv); } break;
        case 6: mix0_phase(tidv, (const bf16_t*)(ws + WS_Z), (const bf16_t*)(ws + WS_SMALL), a.in[10], a.in[11], a.in[12], (const bf16_t*)(ws + WS_SMALL) + 65536, a.in[14], (bf16_t*)(ws + WS_YCAT), L); break;
        case 16: ssm_phase(tidv, (const bf16_t*)(ws + WS_U), (const bf16_t*)(ws + WS_V), (const bf16_t*)(ws + WS_MW), (const float*)(ws + WS_LAML), (bf16_t*)(ws + WS_G), L); break;
        case 19: { pg8::Gemm g{(const bf16_t*)(ws + WS_G), (const bf16_t*)(ws + WS_GLU), T_, 2 * D_, D_}; pg8::StaticOrder S; S.init(T_, 2 * D_, G, bx);
            EpiGated<1> E{F, D_}; pg8::gemm_phase<EpiGated<1>, pg8::StaticOrder, true, true>(L, g, S, E, tidv); } break;
        default: break;
        }
        }
        if (ph == 2 || ph == 9 || ph == 12) {
            int first = 1408 - 5 * G; if (first < 0 || first >= G) first = 0;
            if (bx >= first) { int t2 = threadIdx.x; asm volatile("" : "+v"(t2)); const int wv = __builtin_amdgcn_readfirstlane(t2 >> 6);
                t_run(a, ws, L, wv, t2 & 63, ph == 2 ? 1 : (ph == 9 ? 2 : 3), (bx - first) * 8 + wv, (G - first) * 8); } }
        if (ph + 1 < a.ph_hi) { xcd_barrier(xbar); for (int s = 0; s < PROBE_SYNC; ++s) xcd_barrier(xbar); }
    }
}

extern "C" void kernel_launch(void* const* d_in, const int* in_sizes, int n_in, void* d_out, int out_size, void* d_ws, size_t ws_size, hipStream_t stream) {
    static int grid = 0;
    if (grid == 0) {
        if (n_in != 26 || in_sizes[0] != T_ * D_ || out_size != T_ * D_ || ws_size < WS_END) { fprintf(stderr, "kernel_launch: unexpected shapes (n_in %d, in0 %d, out %d, ws %zu)\n", n_in, n_in > 0 ? in_sizes[0] : -1, out_size, ws_size); grid = -1; return; }
        int dev = 0, cus = 0, per_cu = 0;
        if (hipGetDevice(&dev) != hipSuccess || hipDeviceGetAttribute(&cus, hipDeviceAttributeMultiprocessorCount, dev) != hipSuccess) { grid = -1; return; }
        if (hipFuncSetAttribute((const void*)mega, hipFuncAttributeMaxDynamicSharedMemorySize, LDS_BYTES) != hipSuccess) { fprintf(stderr, "kernel_launch: hipFuncSetAttribute failed\n"); grid = -1; return; }
        if (hipOccupancyMaxActiveBlocksPerMultiprocessor(&per_cu, (const void*)mega, 512, LDS_BYTES) != hipSuccess || per_cu < 1) { fprintf(stderr, "kernel_launch: occupancy query gave %d\n", per_cu); per_cu = 1; (void)hipGetLastError(); }
        grid = cus * per_cu;
    }
    if (grid < 0) return;
    (void)hipMemsetAsync((char*)d_ws, 0, 1 * MiB, stream);
    Args a{};
    for (int i = 0; i < 26; ++i) a.in[i] = (const float*)d_in[i];
    a.out = (float*)d_out; a.ws = (unsigned char*)d_ws;
#if MK_PER_PHASE
    for (int ph = 0; ph < NPH; ++ph) { a.ph_lo = ph; a.ph_hi = ph + 1; hipLaunchKernelGGL(mega, dim3(grid), dim3(512), LDS_BYTES, stream, a); }
#else
    a.ph_lo = 0; a.ph_hi = NPH;
    void* args[] = {&a};
    hipError_t e = hipLaunchCooperativeKernel((const void*)mega, dim3(grid), dim3(512), args, LDS_BYTES, stream);
    if (e != hipSuccess) fprintf(stderr, "kernel_launch: cooperative launch failed: %s (grid %d)\n", hipGetErrorString(e), grid);
#endif
}
```
